# Optimizing an MI355X kernel written in HIP

```python
import math
import jax, jax.numpy as jnp
from jax import lax
import numpy as np

D_MODEL = 2048
BATCH = 4
SEQ = 8192
DEPTH = 1

CHUNK = 64
Q_BLOCK = 128
POOL_WINDOWS = (2, 4, 8, 16)
POOL_GROUPS = 4
POOL_WIDTH = D_MODEL // 2
POOL_GROUP_DIM = POOL_WIDTH // POOL_GROUPS
N_HEADS = 8
HEAD_DIM = D_MODEL // 32
V_DIM = 2 * HEAD_DIM
QK_WIDTH = N_HEADS * 2 * HEAD_DIM
ATTN_WIDTH = N_HEADS * V_DIM
N_BRANCHES = 2
IN_COLS = POOL_WIDTH + 2 * QK_WIDTH + ATTN_WIDTH + N_BRANCHES * D_MODEL
NUM_BUCKETS = 32
MAX_DISTANCE = 128
PEER_HEADS = 8
N_KEYS = 128
N_EXPERTS = N_KEYS * N_KEYS
PEER_KEY_DIM = 256
PEER_HALF = PEER_KEY_DIM // 2
PEER_TOPK = 16
PEER_TOKEN_BLOCK = 128
PLE_DIM = 256
ALPHA = (2 * DEPTH) ** 0.25
BETA = (8 * DEPTH) ** -0.25
LN_EPS = 1e-5
MASK_VALUE = -1e30

kernel_name = "hybrid_pool_diffattn_peer_deepnorm"


def layer_norm(x, g, b):
    xf = x.astype(jnp.float32)
    mu = jnp.mean(xf, axis=-1, keepdims=True)
    var = jnp.mean(jnp.square(xf - mu), axis=-1, keepdims=True)
    y = (xf - mu) * lax.rsqrt(var + LN_EPS) * g.astype(jnp.float32) + b.astype(jnp.float32)
    return y.astype(x.dtype)


def rms_norm(x, g):
    xf = x.astype(jnp.float32)
    y = xf * lax.rsqrt(jnp.mean(jnp.square(xf), axis=-1, keepdims=True) + LN_EPS)
    return (y * g.astype(jnp.float32)).astype(x.dtype)


def t5_bucket(rel):
    nb = NUM_BUCKETS // 2
    ret = (rel > 0).astype(jnp.int32) * nb
    n = jnp.abs(rel)
    max_exact = nb // 2
    is_small = n < max_exact
    nf = jnp.maximum(n, 1).astype(jnp.float32)
    large = max_exact + (jnp.log(nf / max_exact) / math.log(MAX_DISTANCE / max_exact)
                         * (nb - max_exact)).astype(jnp.int32)
    large = jnp.minimum(large, nb - 1)
    return ret + jnp.where(is_small, n, large)


def causal_pool_mixer(xp, w_grp, scale):
    B, S, _ = xp.shape
    xf = xp.astype(jnp.float32)
    cs = jnp.pad(jnp.cumsum(xf, axis=1), ((0, 0), (1, 0), (0, 0)))
    t = jnp.arange(S)
    means = []
    for gi, w in enumerate(POOL_WINDOWS):
        lo, hi = gi * POOL_GROUP_DIM, (gi + 1) * POOL_GROUP_DIM
        start = jnp.maximum(t + 1 - w, 0)
        win = jnp.take(cs[..., lo:hi], t + 1, axis=1) - jnp.take(cs[..., lo:hi], start, axis=1)
        cnt = (t + 1 - start).astype(jnp.float32)
        means.append(win / cnt[None, :, None])
    mixed = (jnp.concatenate(means, axis=-1) - xf).astype(xp.dtype)
    grp = mixed.reshape(B, S, POOL_GROUPS, POOL_GROUP_DIM)
    y = jnp.einsum('bsgc,gcd->bsgd', grp, w_grp).reshape(B, S, POOL_WIDTH)
    return y * scale


def diff_attention(q1, q2, k1, k2, v, lam, bias_table):
    B, S = q1.shape[0], q1.shape[1]
    nblk = S // Q_BLOCK
    scale = HEAD_DIM ** -0.5
    kpos = jnp.arange(S)
    kchunk = kpos // CHUNK

    def to_blocks(q):
        return q.reshape(B, nblk, Q_BLOCK, N_HEADS, HEAD_DIM).transpose(1, 0, 2, 3, 4)

    def one_block(args):
        qa, qb, bi = args
        qpos = bi * Q_BLOCK + jnp.arange(Q_BLOCK)
        rel = kpos[None, :] - qpos[:, None]
        bias = jnp.transpose(bias_table[t5_bucket(rel)].astype(jnp.float32), (2, 0, 1))
        mask = kchunk[None, :] <= (qpos // CHUNK)[:, None]

        def probs(q, k):
            s = jnp.einsum('bqhd,bkhd->bhqk', q, k).astype(jnp.float32) * scale + bias
            s = jnp.where(mask, s, MASK_VALUE)
            return jax.nn.softmax(s, axis=-1)

        a = probs(qa, k1) - lam * probs(qb, k2)
        return jnp.einsum('bhqk,bkhe->bqhe', a.astype(v.dtype), v)

    out = lax.map(one_block, (to_blocks(q1), to_blocks(q2), jnp.arange(nblk)))
    return out.transpose(1, 0, 2, 3, 4).reshape(B, S, N_HEADS, V_DIM)


def peer_layer(x, wq, keys1, keys2, u_tab, v_tab):
    B, S, D = x.shape
    q = jnp.einsum('bsd,de->bse', x, wq).reshape(B, S, PEER_HEADS, 2, PEER_HALF)
    s1 = jnp.einsum('bshc,kc->bshk', q[..., 0, :], keys1).astype(jnp.float32)
    s2 = jnp.einsum('bshc,kc->bshk', q[..., 1, :], keys2).astype(jnp.float32)
    v1, i1 = lax.top_k(s1, PEER_TOPK)
    v2, i2 = lax.top_k(s2, PEER_TOPK)
    cand = (v1[..., :, None] + v2[..., None, :]).reshape(B, S, PEER_HEADS, PEER_TOPK * PEER_TOPK)
    cidx = (i1[..., :, None] * N_KEYS + i2[..., None, :]).reshape(B, S, PEER_HEADS, PEER_TOPK * PEER_TOPK)
    vals, pos = lax.top_k(cand, PEER_TOPK)
    ids = jnp.take_along_axis(cidx, pos, axis=-1)
    gates = jax.nn.softmax(vals, axis=-1)
    T = B * S
    nb = T // PEER_TOKEN_BLOCK
    xt = x.reshape(nb, PEER_TOKEN_BLOCK, D)
    ids_t = ids.reshape(nb, PEER_TOKEN_BLOCK, PEER_HEADS * PEER_TOPK)
    g_t = gates.reshape(nb, PEER_TOKEN_BLOCK, PEER_HEADS * PEER_TOPK)

    def one_block(args):
        xb, ib, gb = args
        ug = jnp.take(u_tab, ib, axis=0)
        vg = jnp.take(v_tab, ib, axis=0)
        h = jnp.einsum('td,tkd->tk', xb, ug)
        a = (jax.nn.gelu(h.astype(jnp.float32), approximate=False) * gb).astype(xb.dtype)
        return jnp.einsum('tk,tkd->td', a, vg)

    out = lax.map(one_block, (xt, ids_t, g_t))
    return out.reshape(B, S, D)


def setup_inputs(seed: int = 0) -> dict:
    key = jax.random.key(seed)
    ks = jax.random.split(key, 32)
    f32 = jnp.float32
    nrm = lambda k, shape, s: jax.random.normal(k, shape, f32) * s
    L, D = DEPTH, D_MODEL
    return {
        "x": nrm(ks[0], (BATCH, SEQ, D), 1.0),
        "p": nrm(ks[1], (DEPTH, BATCH, SEQ, PLE_DIM), 1.0),
        "ln_in_g": 1.0 + nrm(ks[2], (D,), 0.02),
        "ln_in_b": nrm(ks[3], (D,), 0.02),
        "w_in": nrm(ks[4], (L, D, IN_COLS), D ** -0.5),
        "pool_grp_w": nrm(ks[5], (L, POOL_GROUPS, POOL_GROUP_DIM, POOL_GROUP_DIM), POOL_GROUP_DIM ** -0.5),
        "pool_scale": 1.0 + nrm(ks[6], (L, POOL_WIDTH), 0.1),
        "lambda_q1": nrm(ks[7], (L, HEAD_DIM), 0.1),
        "lambda_k1": nrm(ks[8], (L, HEAD_DIM), 0.1),
        "lambda_q2": nrm(ks[9], (L, HEAD_DIM), 0.1),
        "lambda_k2": nrm(ks[10], (L, HEAD_DIM), 0.1),
        "subln_g": 1.0 + nrm(ks[11], (L, V_DIM), 0.02),
        "w_branch_pool": nrm(ks[12], (L, POOL_WIDTH, D), POOL_WIDTH ** -0.5 * BETA),
        "w_branch_attn": nrm(ks[13], (L, ATTN_WIDTH, D), ATTN_WIDTH ** -0.5 * BETA),
        "gate_b": nrm(ks[14], (L, N_BRANCHES, D), 0.1),
        "w_out": nrm(ks[15], (L, D, D), D ** -0.5 * BETA),
        "ln1_g": 1.0 + nrm(ks[16], (L, D), 0.02),
        "ln1_b": nrm(ks[17], (L, D), 0.02),
        "peer_wq": nrm(ks[18], (L, D, PEER_HEADS * PEER_KEY_DIM), D ** -0.5),
        "peer_keys1": nrm(ks[19], (L, N_KEYS, PEER_HALF), PEER_HALF ** -0.5),
        "peer_keys2": nrm(ks[20], (L, N_KEYS, PEER_HALF), PEER_HALF ** -0.5),
        "peer_u": nrm(ks[21], (L, N_EXPERTS, D), D ** -0.5),
        "peer_v": nrm(ks[22], (L, N_EXPERTS, D), BETA),
        "ple_w": nrm(ks[23], (L, PLE_DIM, D), PLE_DIM ** -0.5 * BETA),
        "ple_gate_w": nrm(ks[24], (L, D, D), D ** -0.5),
        "ln2_g": 1.0 + nrm(ks[25], (L, D), 0.02),
        "ln2_b": nrm(ks[26], (L, D), 0.02),
        "rel_bias": nrm(ks[27], (NUM_BUCKETS, N_HEADS), 0.5),
    }


def reference(x, p, ln_in_g, ln_in_b, w_in, pool_grp_w, pool_scale,
              lambda_q1, lambda_k1, lambda_q2, lambda_k2, subln_g,
              w_branch_pool, w_branch_attn, gate_b, w_out, ln1_g, ln1_b,
              peer_wq, peer_keys1, peer_keys2, peer_u, peer_v,
              ple_w, ple_gate_w, ln2_g, ln2_b, rel_bias):
    B, S, D = x.shape
    c0 = POOL_WIDTH
    c1 = c0 + QK_WIDTH
    c2 = c1 + QK_WIDTH
    c3 = c2 + ATTN_WIDTH
    x = layer_norm(x, ln_in_g, ln_in_b)
    for i in range(DEPTH):
        h = jnp.einsum('bsd,de->bse', x, w_in[i])
        xp = h[..., :c0]
        q = h[..., c0:c1].reshape(B, S, N_HEADS, 2, HEAD_DIM)
        k = h[..., c1:c2].reshape(B, S, N_HEADS, 2, HEAD_DIM)
        v = h[..., c2:c3].reshape(B, S, N_HEADS, V_DIM)
        g_pre = h[..., c3:].reshape(B, S, N_BRANCHES, D)

        yp = causal_pool_mixer(xp, pool_grp_w[i], pool_scale[i])

        lam_init = 0.8 - 0.6 * math.exp(-0.3 * i)
        lam = (jnp.exp(jnp.sum(lambda_q1[i].astype(jnp.float32) * lambda_k1[i].astype(jnp.float32)))
               - jnp.exp(jnp.sum(lambda_q2[i].astype(jnp.float32) * lambda_k2[i].astype(jnp.float32)))
               + lam_init)
        att = diff_attention(q[..., 0, :], q[..., 1, :], k[..., 0, :], k[..., 1, :], v, lam, rel_bias)
        att = rms_norm(att, subln_g[i]) * (1.0 - lam_init)
        ya = att.reshape(B, S, ATTN_WIDTH)

        gates = jax.nn.sigmoid(g_pre + gate_b[i])
        merged = (gates[..., 0, :] * jnp.einsum('bsc,cd->bsd', yp, w_branch_pool[i])
                  + gates[..., 1, :] * jnp.einsum('bsc,cd->bsd', ya, w_branch_attn[i]))
        y = jnp.einsum('bsd,de->bse', merged, w_out[i])
        x = layer_norm(ALPHA * x + y, ln1_g[i], ln1_b[i])

        f = peer_layer(x, peer_wq[i], peer_keys1[i], peer_keys2[i], peer_u[i], peer_v[i])
        e = jax.nn.sigmoid(jnp.einsum('bsd,de->bse', x, ple_gate_w[i])) * jnp.einsum('bsc,cd->bsd', p[i], ple_w[i])
        x = layer_norm(ALPHA * x + f + e, ln2_g[i], ln2_b[i])
    return x
```

```cpp
#include <hip/hip_runtime.h>
#include <cstdio>
#include <cstdint>
#include <type_traits>

#ifndef MK_N_LAUNCHES
#define MK_N_LAUNCHES 1
#endif

namespace pg8 {
#define PG8_LAS __attribute__((address_space(3)))
typedef unsigned short bf16_t;
typedef short bf16x8 __attribute__((ext_vector_type(8)));
typedef float f32x4 __attribute__((ext_vector_type(4)));
typedef unsigned u32x4 __attribute__((ext_vector_type(4)));
typedef int i32x4 __attribute__((ext_vector_type(4)));
constexpr int BM = 256, BK = 64, HALF = 128, HTB = HALF * BK * 2  , STAGE_BYTES = 8 * HTB, NXCD = 8, WGM = 8;

__host__ __device__ __forceinline__ int lds_byte(int r, int c) { const int st = (r >> 4) * 2 + (c >> 5), rr = r & 15, cc = c & 31, ob = rr * 64 + cc * 2; return st * 1024 + (ob ^ (((ob >> 9) & 1) << 5)); }
__host__ __device__ __forceinline__ void stage_rc(int b, int& R, int& C) { const int st = b / 1024, sb = b % 1024, swz = sb ^ (((sb >> 9) & 1) << 5); R = (st >> 1) * 16 + swz / 64; C = (st & 1) * 32 + (swz % 64) / 2; }
__host__ __device__ __forceinline__ int perm32(int rho) { const int n = rho >> 4, i = rho & 15; return 8 * (i >> 2) + 4 * n + (i & 3); }

struct Unit { int pm, pn; };
struct Gemm { const bf16_t* A; const bf16_t* Bt; int lda, ldb, K; unsigned a_pn_off, b_pn_step; };

struct StaticOrder {
    int nM, nN, nwg, G, c;
    __host__ __device__ void init(int M, int N, int G_, int c_) { nM = M / BM; nN = N / BM; nwg = nM * nN; G = G_; c = c_; }
    __host__ __device__ bool next(int i, Unit& u) const {
        const long L = (long)i * G + c; if (L >= nwg) return false;
        int wgid = (int)L; { const int q = nwg / NXCD, r = nwg % NXCD, xcd = wgid % NXCD, off = wgid / NXCD; wgid = (xcd < r ? xcd * (q + 1) : r * (q + 1) + (xcd - r) * q) + off; }
        const int nig = WGM * nN, gid = wgid / nig, fm = gid * WGM, gsz = (nM - fm) < WGM ? (nM - fm) : WGM;
        u.pm = fm + ((wgid % nig) % gsz); u.pn = (wgid % nig) / gsz; return true;
    }
    __device__ __forceinline__ void a_ready(const Unit&) const {}
    __device__ __forceinline__ void done(const Unit&) const {}
};

__device__ __forceinline__ unsigned cvt_pk_bf16(float lo, float hi) { unsigned r; asm volatile("v_cvt_pk_bf16_f32 %0, %1, %2" : "=v"(r) : "v"(lo), "v"(hi)); return r; }
__device__ __forceinline__ float bf_lo(unsigned w) { return __uint_as_float(w << 16); }
__device__ __forceinline__ float bf_hi(unsigned w) { return __uint_as_float(w & 0xffff0000u); }
__device__ __forceinline__ float sigm(float x) { return __builtin_amdgcn_rcpf(1.f + __builtin_amdgcn_exp2f(-1.4426950408889634f * x)); }
typedef float f32x2 __attribute__((ext_vector_type(2)));
__device__ __forceinline__ f32x2 gelu_pk(f32x2 v) {
    const f32x2 av = __builtin_elementwise_abs(v), d = av * 0.2316418882f + 1.0f;
    f32x2 t; t.x = __builtin_amdgcn_rcpf(d.x); t.y = __builtin_amdgcn_rcpf(d.y);
    f32x2 q = t * 0.5307027145f + (-0.7265760135f); q = q * t + 0.7107068705f; q = q * t + (-0.142248368f); q = q * t + 0.127414796f; q = q * t;
    const f32x2 s = (v * v) * (-0.72134752044f);
    f32x2 e; e.x = __builtin_amdgcn_exp2f(s.x); e.y = __builtin_amdgcn_exp2f(s.y);
    const f32x2 m = v * (q * e), r = v - m;
    f32x2 o; o.x = v.x < 0.f ? m.x : r.x; o.y = v.y < 0.f ? m.y : r.y; return o;
}
__device__ __forceinline__ u32x4 pack8(const f32x4 a, const f32x4 b) { u32x4 w; w.x = cvt_pk_bf16(a[0], a[1]); w.y = cvt_pk_bf16(a[2], a[3]); w.z = cvt_pk_bf16(b[0], b[1]); w.w = cvt_pk_bf16(b[2], b[3]); return w; }
__device__ __forceinline__ void unpack8(const u32x4 w, f32x4& a, f32x4& b) { a = (f32x4){bf_lo(w.x), bf_hi(w.x), bf_lo(w.y), bf_hi(w.y)}; b = (f32x4){bf_lo(w.z), bf_hi(w.z), bf_lo(w.w), bf_hi(w.w)}; }

template <class F, bool I8 = false> struct Row8 {
    static constexpr bool PERM = true, AFTER_DRAIN = false, INT8 = I8; F f; const float* rowscale; float wscale;
    typedef typename std::conditional<I8, i32x4, f32x4>::type acc_t;
    __device__ __forceinline__ void operator()(const acc_t (&acc)[2][2][4][2], const Unit& u, int wr, int wc, int fr, int fq) const {
        const int row0 = u.pm * BM + wr * 64 + fr, col0 = u.pn * BM + wc * 32 + 8 * fq;
        float rs[2][4]; typename F::Pre pre[2][4][2];
#pragma unroll
        for (int ai = 0; ai < 2; ++ai)
#pragma unroll
            for (int m = 0; m < 4; ++m) { const int row = row0 + ai * HALF + m * 16; rs[ai][m] = 1.f; if (I8) rs[ai][m] = rowscale[row] * wscale;
#pragma unroll
                for (int bj = 0; bj < 2; ++bj) pre[ai][m][bj] = f.load(row, col0 + bj * HALF); }
#pragma unroll
        for (int ai = 0; ai < 2; ++ai)
#pragma unroll
            for (int m = 0; m < 4; ++m) { const int row = row0 + ai * HALF + m * 16; const float r_ = rs[ai][m];
#pragma unroll
                for (int bj = 0; bj < 2; ++bj) { f32x4 v0, v1;
                    if constexpr (I8) { v0 = __builtin_convertvector(acc[ai][bj][m][0], f32x4) * r_; v1 = __builtin_convertvector(acc[ai][bj][m][1], f32x4) * r_; } else { v0 = acc[ai][bj][m][0]; v1 = acc[ai][bj][m][1]; }
                    f(row, col0 + bj * HALF, v0, v1, pre[ai][m][bj]); } }
    }
};

template <class Epi, class Sched, bool ALIGN_EPI = false, bool SP2 = false>
__device__ __forceinline__ void gemm_phase(PG8_LAS unsigned char* lds, const Gemm g, const Sched& S, const Epi& E, const int tid_in) {
    const int tid = tid_in, wid = __builtin_amdgcn_readfirstlane(tid >> 6), lane = tid & 63, wr = wid >> 2, wc = wid & 3, fr = lane & 15, fq = lane >> 4;
    const int K = g.K, nt = K / BK;
    unsigned voffA[2], voffB[2];
#pragma unroll
    for (int i = 0; i < 2; ++i) { int R, C; stage_rc(tid * 16 + i * 8192, R, C); const int Rb = Epi::PERM ? ((R & ~31) + perm32(R & 31)) : R;
        voffA[i] = (unsigned)(R * g.lda + C) * 2u; voffB[i] = (unsigned)(Rb * g.ldb + C) * 2u; }
    const size_t kstep = (size_t)(BK * 2);
    const size_t hstepA = (size_t)HALF * g.lda * 2, hstepB = (size_t)HALF * g.ldb * 2;
    const size_t tstepA = 2 * hstepA;
    const unsigned ldsw = (unsigned)wid * 1024u;
    const int aoff = lds_byte(wr * 64 + fr, fq * 8), boff = lds_byte(wc * 32 + fr, fq * 8);
#define PG8_SA(b, h) (((b) * 2 + (h)) * HTB)
#define PG8_SB(b, h) ((4 + (b) * 2 + (h)) * HTB)
#define PG8_STAGE(bufoff, gbase, voff) do { _Pragma("unroll") for (int _i = 0; _i < 2; ++_i) \
        __builtin_amdgcn_global_load_lds((const unsigned*)((const char*)(gbase) + (voff)[_i]), (PG8_LAS unsigned*)(lds + (bufoff) + ldsw + _i * 8192), 16, 0, 0); } while (0)
#define PG8_LDA(dst, b, h) do { _Pragma("unroll") for (int m = 0; m < 4; ++m) _Pragma("unroll") for (int k = 0; k < 2; ++k) dst[m][k] = *(const PG8_LAS bf16x8*)(lds + PG8_SA(b, h) + aoff + m * 2048 + k * 1024); } while (0)
#define PG8_LDB(dst, b, h) do { _Pragma("unroll") for (int n = 0; n < 2; ++n) _Pragma("unroll") for (int k = 0; k < 2; ++k) dst[n][k] = *(const PG8_LAS bf16x8*)(lds + PG8_SB(b, h) + boff + n * 2048 + k * 1024); } while (0)
#define PG8_MMA(ai, bj, At, Bt) do { __builtin_amdgcn_s_setprio(1); _Pragma("unroll") for (int k = 0; k < 2; ++k) _Pragma("unroll") for (int m = 0; m < 4; ++m) _Pragma("unroll") for (int n = 0; n < 2; ++n) \
        { if constexpr (Epi::INT8) acc[ai][bj][m][n] = __builtin_amdgcn_mfma_i32_16x16x64_i8(__builtin_bit_cast(i32x4, Bt[n][k]), __builtin_bit_cast(i32x4, At[m][k]), acc[ai][bj][m][n], 0, 0, 0); \
          else acc[ai][bj][m][n] = __builtin_amdgcn_mfma_f32_16x16x32_bf16(Bt[n][k], At[m][k], acc[ai][bj][m][n], 0, 0, 0); } __builtin_amdgcn_s_setprio(0); } while (0)
#define PG8_WAIT_V(n) asm volatile("s_waitcnt vmcnt(" #n ")" ::: "memory")
#define PG8_WAIT_L(n) asm volatile("s_waitcnt lgkmcnt(" #n ")" ::: "memory")
#define PG8_BAR __builtin_amdgcn_s_barrier()
#define PG8_SCHED __builtin_amdgcn_sched_barrier(0)
#define PG8_UA(u) ((const char*)g.A + (size_t)(u).pm * tstepA + (size_t)(u).pn * g.a_pn_off * 2)
#define PG8_UB(u) ((const char*)g.Bt + (size_t)(u).pn * g.b_pn_step * 2)
    Unit cur, nxt; int ui = 0;
    if (!S.next(0, cur)) return;
    typename Epi::acc_t acc[2][2][4][2];
#pragma unroll
    for (int a = 0; a < 2; ++a)
#pragma unroll
        for (int b = 0; b < 2; ++b)
#pragma unroll
            for (int m = 0; m < 4; ++m)
#pragma unroll
                for (int n = 0; n < 2; ++n) acc[a][b][m][n] = (typename Epi::acc_t){};
    bf16x8 At[4][2], B0[2][2], B1[2][2];
    const char* cA = PG8_UA(cur); const char* cB = PG8_UB(cur);
    S.a_ready(cur);
    if constexpr (SP2) {
        PG8_STAGE(PG8_SB(0, 0), cB, voffB); PG8_STAGE(PG8_SB(0, 1), cB + hstepB, voffB); PG8_STAGE(PG8_SA(0, 0), cA, voffA); PG8_STAGE(PG8_SA(0, 1), cA + hstepA, voffA);
        if (wr == 1) PG8_BAR;
        PG8_WAIT_V(2); PG8_BAR;
        PG8_STAGE(PG8_SB(1, 0), cB + kstep, voffB); PG8_STAGE(PG8_SA(1, 0), cA + kstep, voffA); PG8_STAGE(PG8_SB(1, 1), cB + hstepB + kstep, voffB);
        PG8_WAIT_V(6); PG8_BAR;
    } else {
        PG8_STAGE(PG8_SB(0, 0), cB, voffB); PG8_STAGE(PG8_SA(0, 0), cA, voffA); PG8_STAGE(PG8_SB(0, 1), cB + hstepB, voffB); PG8_STAGE(PG8_SA(0, 1), cA + hstepA, voffA);
        if (wr == 1) PG8_BAR;
        PG8_WAIT_V(4); PG8_BAR;
        PG8_STAGE(PG8_SB(1, 0), cB + kstep, voffB); PG8_STAGE(PG8_SA(1, 0), cA + kstep, voffA); PG8_STAGE(PG8_SB(1, 1), cB + hstepB + kstep, voffB);
        PG8_WAIT_V(6); PG8_BAR;
    }
    for (;;) {
        const bool has_next = S.next(ui + 1, nxt);
        const char* nA = has_next ? PG8_UA(nxt) : cA; const char* nB = has_next ? PG8_UB(nxt) : cB;
        for (int t = 0; t < nt; t += 2) {
            const bool last = (t == nt - 2);
            const char* a1 = cA + (size_t)(t + 1) * kstep;
            const char* a2 = last ? nA : cA + (size_t)(t + 2) * kstep; const char* b2 = last ? nB : cB + (size_t)(t + 2) * kstep;
            const char* a3 = a2 + kstep; const char* b3 = b2 + kstep;
            if (last && has_next) S.a_ready(nxt);
            if constexpr (SP2) {
            PG8_LDB(B0, 0, 0); PG8_LDB(B1, 0, 1); PG8_SCHED; PG8_LDA(At, 0, 0); PG8_STAGE(PG8_SA(1, 1), a1 + hstepA, voffA);
            PG8_WAIT_V(8); PG8_WAIT_L(0); PG8_BAR; PG8_MMA(0, 0, At, B0); PG8_MMA(0, 1, At, B1); PG8_BAR; PG8_SCHED;
            PG8_LDA(At, 0, 1); PG8_STAGE(PG8_SB(0, 0), b2, voffB); PG8_STAGE(PG8_SB(0, 1), b2 + hstepB, voffB); PG8_STAGE(PG8_SA(0, 0), a2, voffA);
            PG8_WAIT_V(8); PG8_WAIT_L(0); PG8_BAR; PG8_MMA(1, 0, At, B0); PG8_MMA(1, 1, At, B1); PG8_BAR; PG8_SCHED;
            PG8_LDB(B0, 1, 0); PG8_LDB(B1, 1, 1); PG8_SCHED; PG8_LDA(At, 1, 0); PG8_STAGE(PG8_SA(0, 1), a2 + hstepA, voffA);
            PG8_WAIT_V(8); PG8_WAIT_L(0); PG8_BAR; PG8_MMA(0, 0, At, B0); PG8_MMA(0, 1, At, B1); PG8_BAR; PG8_SCHED;
            PG8_LDA(At, 1, 1); PG8_STAGE(PG8_SB(1, 0), b3, voffB); PG8_STAGE(PG8_SB(1, 1), b3 + hstepB, voffB); PG8_STAGE(PG8_SA(1, 0), a3, voffA);
            PG8_WAIT_V(8); PG8_WAIT_L(0); PG8_BAR; PG8_MMA(1, 0, At, B0); PG8_MMA(1, 1, At, B1); PG8_BAR; PG8_SCHED;
            } else {
            PG8_LDB(B0, 0, 0); PG8_SCHED; PG8_LDA(At, 0, 0); PG8_STAGE(PG8_SA(1, 1), a1 + hstepA, voffA);
            PG8_WAIT_L(8); PG8_BAR; PG8_WAIT_L(0); PG8_MMA(0, 0, At, B0); PG8_BAR; PG8_SCHED;
            PG8_LDB(B1, 0, 1); PG8_STAGE(PG8_SB(0, 0), b2, voffB);
            PG8_BAR; PG8_WAIT_L(0); PG8_MMA(0, 1, At, B1); PG8_BAR;
            PG8_LDA(At, 0, 1); PG8_STAGE(PG8_SA(0, 0), a2, voffA);
            PG8_BAR; PG8_WAIT_L(0); PG8_MMA(1, 0, At, B0); PG8_BAR; PG8_SCHED;
            PG8_STAGE(PG8_SB(0, 1), b2 + hstepB, voffB);
            PG8_WAIT_V(6); PG8_BAR; PG8_MMA(1, 1, At, B1); PG8_BAR;
            PG8_LDB(B0, 1, 0); PG8_SCHED; PG8_LDA(At, 1, 0); PG8_STAGE(PG8_SA(0, 1), a2 + hstepA, voffA);
            PG8_WAIT_L(8); PG8_BAR; PG8_WAIT_L(0); PG8_MMA(0, 0, At, B0); PG8_BAR; PG8_SCHED;
            PG8_LDB(B1, 1, 1); PG8_STAGE(PG8_SB(1, 0), b3, voffB);
            PG8_BAR; PG8_WAIT_L(0); PG8_MMA(0, 1, At, B1); PG8_BAR;
            PG8_LDA(At, 1, 1); PG8_STAGE(PG8_SA(1, 0), a3, voffA);
            PG8_BAR; PG8_WAIT_L(0); PG8_MMA(1, 0, At, B0); PG8_BAR; PG8_SCHED;
            PG8_STAGE(PG8_SB(1, 1), b3 + hstepB, voffB);
            PG8_WAIT_V(6); PG8_BAR; PG8_MMA(1, 1, At, B1); PG8_BAR;
            }
        }
        if constexpr (ALIGN_EPI) { if (wr == 0) PG8_BAR; }
        if constexpr (!Epi::AFTER_DRAIN) { E(acc, cur, wr, wc, fr, fq); S.done(cur); }
        if (!has_next) break;
#pragma unroll
        for (int a = 0; a < 2; ++a)
#pragma unroll
            for (int b = 0; b < 2; ++b)
#pragma unroll
                for (int m = 0; m < 4; ++m)
#pragma unroll
                    for (int n = 0; n < 2; ++n) acc[a][b][m][n] = (typename Epi::acc_t){};
        cur = nxt; cA = nA; cB = nB; ++ui;
        if constexpr (ALIGN_EPI) { if (wr == 1) PG8_BAR; }
    }
    PG8_WAIT_V(0);
    if constexpr (!ALIGN_EPI) { if (wr == 0) PG8_BAR; }
    PG8_BAR;
#undef PG8_SA
#undef PG8_SB
#undef PG8_STAGE
#undef PG8_LDA
#undef PG8_LDB
#undef PG8_MMA
#undef PG8_WAIT_V
#undef PG8_WAIT_L
#undef PG8_BAR
#undef PG8_SCHED
#undef PG8_UA
#undef PG8_UB
}
}
namespace attn {
using bf16x8 = __attribute__((ext_vector_type(8))) short;
using s16x4  = __attribute__((ext_vector_type(4))) short;
using f32x16 = __attribute__((ext_vector_type(16))) float;
using f32x4  = __attribute__((ext_vector_type(4))) float;
using u32x4  = __attribute__((ext_vector_type(4))) unsigned;
constexpr int SEQ = 8192, LD = 1024, KVBLK = 64, QBLK = 32, NHEAD = 8, NQB = SEQ / 128;
constexpr float SC = 0.125f * 1.4426950408889634f;
constexpr float L2E = 1.4426950408889634f;
constexpr float THR = 8.f;
constexpr int SHM_V = 16384, SHM_K = 16384;
constexpr int OFF_V = 0, OFF_K = 2 * SHM_V, OFF_WS = OFF_K + 2 * SHM_K, OFF_TB = OFF_WS + 8 * 256 + 0, TB_N = 256;
constexpr int STG_LD = 132, STG_BYTES = 32 * STG_LD * 4;
constexpr int LDS_BYTES = OFF_TB + TB_N * 4;
static_assert(4 * STG_BYTES <= OFF_TB, "combine stage must not reach the bias table");
#define KSWZ(row, colB) ((row) * 256 + ((colB) ^ (((row) & 7) << 4)))
#define SBAR() __builtin_amdgcn_sched_barrier(0)
__device__ __forceinline__ int crow(int r, int hi) { return (r & 3) + 8 * (r >> 2) + 4 * hi; }
__device__ __forceinline__ unsigned cvtpk(float lo, float hi) { unsigned r; asm volatile("v_cvt_pk_bf16_f32 %0, %1, %2" : "=v"(r) : "v"(lo), "v"(hi)); return r; }

__device__ __forceinline__ int t5_bucket(int rel) {
  const int n = rel < 0 ? -rel : rel; int b;
  if (n < 8) b = n; else if (n < 12) b = 8; else if (n < 16) b = 9; else if (n < 23) b = 10; else if (n < 32) b = 11; else if (n < 46) b = 12; else if (n < 64) b = 13; else if (n < 91) b = 14; else b = 15;
  return b + (rel > 0 ? 16 : 0);
}

__device__ __forceinline__ void partialSM(f32x16& p0, f32x16& p1, float& m_reg, float& mn, float& alpha, int j, int c, float cb, const float* tq, int hi) {
  if (j >= c - 2) {
    if (j > c) {
#pragma unroll
      for (int r = 0; r < 16; ++r) { p0[r] = -1e30f; p1[r] = -1e30f; }
    } else {
      const float* t = tq + 64 * j;
#pragma unroll
      for (int r = 0; r < 16; ++r) { p0[r] = fmaf(p0[r], SC, t[crow(r, hi)]); p1[r] = fmaf(p1[r], SC, t[32 + crow(r, hi)]); }
    }
    float pmax = p0[0];
#pragma unroll
    for (int r = 1; r < 16; ++r) pmax = fmaxf(pmax, p0[r]);
#pragma unroll
    for (int r = 0; r < 16; ++r) pmax = fmaxf(pmax, p1[r]);
    { auto rr = __builtin_amdgcn_permlane32_swap(__float_as_uint(pmax), __float_as_uint(pmax), false, false); pmax = fmaxf(__uint_as_float(rr[0]), __uint_as_float(rr[1])); }
    if (__builtin_expect(__all(pmax - m_reg <= THR), 1)) { mn = m_reg; alpha = 1.f; }
    else { mn = fmaxf(m_reg, pmax); alpha = __builtin_amdgcn_exp2f(m_reg - mn); m_reg = mn; }
#pragma unroll
    for (int r = 0; r < 16; ++r) { p0[r] -= mn; p1[r] -= mn; }
  } else {
    float pmax = p0[0];
#pragma unroll
    for (int r = 1; r < 16; ++r) pmax = fmaxf(pmax, p0[r]);
#pragma unroll
    for (int r = 0; r < 16; ++r) pmax = fmaxf(pmax, p1[r]);
    { auto rr = __builtin_amdgcn_permlane32_swap(__float_as_uint(pmax), __float_as_uint(pmax), false, false); pmax = fmaxf(__uint_as_float(rr[0]), __uint_as_float(rr[1])); }
    pmax = fmaf(pmax, SC, cb);
    if (__builtin_expect(__all(pmax - m_reg <= THR), 1)) { mn = m_reg; alpha = 1.f; }
    else { mn = fmaxf(m_reg, pmax); alpha = __builtin_amdgcn_exp2f(m_reg - mn); m_reg = mn; }
    const float off = cb - mn;
#pragma unroll
    for (int r = 0; r < 16; ++r) { p0[r] = fmaf(p0[r], SC, off); p1[r] = fmaf(p1[r], SC, off); }
  }
#pragma unroll
  for (int r = 0; r < 16; ++r) p0[r] = __builtin_amdgcn_exp2f(p0[r]);
}
__device__ __forceinline__ void finishSM(f32x16& p0, f32x16& p1, float alpha, float& l_reg, bf16x8& pa0, bf16x8& pa1, bf16x8& pa2, bf16x8& pa3) {
#pragma unroll
  for (int r = 0; r < 16; ++r) p1[r] = __builtin_amdgcn_exp2f(p1[r]);
  float ps = 0;
#pragma unroll
  for (int r = 0; r < 16; ++r) ps += p0[r];
#pragma unroll
  for (int r = 0; r < 16; ++r) ps += p1[r];
  { auto rr = __builtin_amdgcn_permlane32_swap(__float_as_uint(ps), __float_as_uint(ps), false, false); ps = __uint_as_float(rr[0]) + __uint_as_float(rr[1]); }
  l_reg = l_reg * alpha + ps;
#define PK4(P, BASE, OUT) do { unsigned a0 = cvtpk(P[BASE + 0], P[BASE + 1]), a1 = cvtpk(P[BASE + 2], P[BASE + 3]);   \
    unsigned b0 = cvtpk(P[BASE + 4], P[BASE + 5]), b1 = cvtpk(P[BASE + 6], P[BASE + 7]);                              \
    auto r0 = __builtin_amdgcn_permlane32_swap(a0, b0, false, false); auto r1 = __builtin_amdgcn_permlane32_swap(a1, b1, false, false); \
    u32x4 w = {r0[0], r1[0], r0[1], r1[1]}; OUT = *reinterpret_cast<bf16x8*>(&w); } while (0)
  PK4(p0, 0, pa0); PK4(p0, 8, pa1); PK4(p1, 0, pa2); PK4(p1, 8, pa3);
#undef PK4
}
__device__ __forceinline__ void qkt(f32x16& p0, f32x16& p1, const char* Ks, const bf16x8* qr, int r32, int hi, int sm) {
  p0 = f32x16{}; p1 = f32x16{};
#pragma unroll
  for (int d0 = 0; d0 < 4; ++d0) { const int cb = (sm * 64 + d0 * 16 + hi * 8) * 2;
    const bf16x8 b0 = *reinterpret_cast<const bf16x8*>(Ks + KSWZ(r32, cb));
    const bf16x8 b1 = *reinterpret_cast<const bf16x8*>(Ks + KSWZ(32 + r32, cb));
    p0 = __builtin_amdgcn_mfma_f32_32x32x16_bf16(b0, qr[d0], p0, 0, 0, 0);
    p1 = __builtin_amdgcn_mfma_f32_32x32x16_bf16(b1, qr[d0], p1, 0, 0, 0); }
}
__device__ __forceinline__ int v_st(int k, int c) { const int kk = (k & ~0xC) | ((k & 4) << 1) | ((k & 8) >> 1); return ((kk >> 3) * 4 + (c >> 5)) * 512 + ((kk & 7) * 32 + (c & 31)) * 2; }
__device__ __forceinline__ int v_rd_base(int lane) { return ((lane & 3) << 3) | (((lane >> 2) & 3) << 6) | (((lane >> 4) & 1) << 5) | (((lane >> 5) & 1) << 8); }
constexpr int v_rd_off(int d0, int ks, int half) { return d0 * 512 + ks * 4096 + half * 2048; }
template <int OFF> __device__ __forceinline__ s16x4 tr_read(int vb) { s16x4 r; asm volatile("ds_read_b64_tr_b16 %0, %1 offset:%2" : "=&v"(r) : "v"(vb), "i"(OFF) : "memory"); return r; }
template <int D0> __device__ __forceinline__ void pv_one(f32x16& od, int vb, bf16x8 pa0, bf16x8 pa1, bf16x8 pa2, bf16x8 pa3) {
  const s16x4 l0 = tr_read<v_rd_off(D0, 0, 0)>(vb), h0 = tr_read<v_rd_off(D0, 0, 1)>(vb), l1 = tr_read<v_rd_off(D0, 1, 0)>(vb), h1 = tr_read<v_rd_off(D0, 1, 1)>(vb);
  const s16x4 l2 = tr_read<v_rd_off(D0, 2, 0)>(vb), h2 = tr_read<v_rd_off(D0, 2, 1)>(vb), l3 = tr_read<v_rd_off(D0, 3, 0)>(vb), h3 = tr_read<v_rd_off(D0, 3, 1)>(vb);
  asm volatile("s_waitcnt lgkmcnt(0)" ::: "memory"); SBAR();
#define PK(L, H) (bf16x8){L[0], L[1], L[2], L[3], H[0], H[1], H[2], H[3]}
  od = __builtin_amdgcn_mfma_f32_32x32x16_bf16(pa0, PK(l0, h0), od, 0, 0, 0);
  od = __builtin_amdgcn_mfma_f32_32x32x16_bf16(pa1, PK(l1, h1), od, 0, 0, 0);
  od = __builtin_amdgcn_mfma_f32_32x32x16_bf16(pa2, PK(l2, h2), od, 0, 0, 0);
  od = __builtin_amdgcn_mfma_f32_32x32x16_bf16(pa3, PK(l3, h3), od, 0, 0, 0);
#undef PK
}
__device__ __forceinline__ void pv_d0(f32x16* o, int vb, bf16x8 pa0, bf16x8 pa1, bf16x8 pa2, bf16x8 pa3) {
  pv_one<0>(o[0], vb, pa0, pa1, pa2, pa3); pv_one<1>(o[1], vb, pa0, pa1, pa2, pa3); pv_one<2>(o[2], vb, pa0, pa1, pa2, pa3); pv_one<3>(o[3], vb, pa0, pa1, pa2, pa3);
}

struct Params { const unsigned short* Q; const unsigned short* K; const unsigned short* V; unsigned char* O8; float* OS; const float* rel_bias; const float* subln_g; float lam; float inv_s, s; };

__device__ __forceinline__ void attn_unit(const Params& P, int b, int h, int qb, char* lds, int tid_in) {
  const int tid = tid_in, wid = __builtin_amdgcn_readfirstlane(tid >> 6), lane = tid & 63, r32 = lane & 31, hi = lane >> 5;
  const int sm = wid >> 2, wq = wid & 3;
  unsigned short* V_lds = (unsigned short*)(lds + OFF_V); unsigned short* K_lds = (unsigned short*)(lds + OFF_K);
  float* ws = (float*)(lds + OFF_WS) + wid * 64; float* li_l = ws; float* al_l = ws + 32;
  float* tb = (float*)(lds + OFF_TB);
  const long rowbase = (long)b * SEQ; const int q0 = qb * 128;
  const unsigned short* Kh = P.K + rowbase * LD + h * 128; const unsigned short* Vh = P.V + rowbase * LD + h * 128;
  if (tid < TB_N) tb[tid] = P.rel_bias[t5_bucket(tid - 191) * NHEAD + h] * L2E;
  const float cb = P.rel_bias[15 * NHEAD + h] * L2E;
  float m_reg = -1e30f, l_reg = 0; f32x16 o[4] = {}; bf16x8 qr[4];
  const int qpos = q0 + wq * QBLK + r32;
  const int c = (q0 + wq * QBLK) >> 6;
  const float* tq = tb + 191 - qpos;
  const unsigned short* Qw = P.Q + (rowbase + qpos) * LD + h * 128 + sm * 64 + hi * 8;
#pragma unroll
  for (int d0 = 0; d0 < 4; ++d0) qr[d0] = *reinterpret_cast<const bf16x8*>(Qw + d0 * 16);
  const int sr = tid >> 4, sc = (tid & 15) * 8, vst0 = v_st(sr, sc), vst1 = v_st(32 + sr, sc);
  const int vb0 = (int)(uintptr_t)V_lds + v_rd_base(lane);
  struct { bf16x8 vs0, vs1, ks0, ks1; } sr_[2];
#define SLOAD(i, k0) do { sr_[i].vs0 = *reinterpret_cast<const bf16x8*>(&Vh[(long)((k0) + sr) * LD + sc]); sr_[i].vs1 = *reinterpret_cast<const bf16x8*>(&Vh[(long)((k0) + 32 + sr) * LD + sc]); \
    sr_[i].ks0 = *reinterpret_cast<const bf16x8*>(&Kh[(long)((k0) + sr) * LD + sc]); sr_[i].ks1 = *reinterpret_cast<const bf16x8*>(&Kh[(long)((k0) + 32 + sr) * LD + sc]); } while (0)
#define SWRITE(bb, i) do { *(bf16x8*)((char*)V_lds + (bb) * SHM_V + vst0) = sr_[i].vs0;          \
    *(bf16x8*)((char*)V_lds + (bb) * SHM_V + vst1) = sr_[i].vs1; const int kc = sc * 2;               \
    *(bf16x8*)((char*)K_lds + (bb) * SHM_K + KSWZ(sr, kc)) = sr_[i].ks0;                       \
    *(bf16x8*)((char*)K_lds + (bb) * SHM_K + KSWZ(32 + sr, kc)) = sr_[i].ks1; } while (0)
#define SWAIT() asm volatile("s_waitcnt vmcnt(4)" ::: "memory")
#define RESC(a) do { if (__any((a) < 1.f)) { if (hi == 0) al_l[r32] = (a); asm volatile("s_waitcnt lgkmcnt(0)" ::: "memory"); \
    _Pragma("unroll") for (int d = 0; d < 4; ++d) _Pragma("unroll") for (int r = 0; r < 16; ++r) o[d][r] *= al_l[crow(r, hi)]; } } while (0)
  f32x16 pA0, pA1, pB0, pB1; float mnA, mnB, alA, alB; bf16x8 pa0, pa1, pa2, pa3; const int NT = 2 * qb + 2;
  constexpr int SE = 0, SO = 1;
  SLOAD(SE, 0); asm volatile("s_waitcnt vmcnt(0)" ::: "memory"); SWRITE(0, SE); __syncthreads();
  qkt(pA0, pA1, (const char*)K_lds, qr, r32, hi, sm); partialSM(pA0, pA1, m_reg, mnA, alA, 0, c, cb, tq, hi);
  SLOAD(SO, KVBLK); if (2 < NT) SLOAD(SE, 2 * KVBLK);
  SWAIT(); SWRITE(1, SO); __syncthreads();
  for (int j = 1; j + 1 < NT; j += 2) {
    SBAR(); qkt(pB0, pB1, (const char*)K_lds + SHM_K, qr, r32, hi, sm);
    finishSM(pA0, pA1, alA, l_reg, pa0, pa1, pa2, pa3); SBAR();
    SLOAD(SO, (j + 2) * KVBLK); SBAR();
    pv_d0(o, vb0, pa0, pa1, pa2, pa3); partialSM(pB0, pB1, m_reg, mnB, alB, j, c, cb, tq, hi);
    __syncthreads(); SWAIT(); SWRITE(0, SE);
    RESC(alB); __syncthreads();
    SBAR(); qkt(pA0, pA1, (const char*)K_lds, qr, r32, hi, sm);
    finishSM(pB0, pB1, alB, l_reg, pa0, pa1, pa2, pa3); SBAR();
    if (j + 3 < NT) SLOAD(SE, (j + 3) * KVBLK); SBAR();
    pv_d0(o, vb0 + SHM_V, pa0, pa1, pa2, pa3); partialSM(pA0, pA1, m_reg, mnA, alA, j + 1, c, cb, tq, hi);
    __syncthreads(); SWAIT(); SWRITE(1, SO);
    RESC(alA); __syncthreads();
  }
  SBAR(); qkt(pB0, pB1, (const char*)K_lds + SHM_K, qr, r32, hi, sm);
  finishSM(pA0, pA1, alA, l_reg, pa0, pa1, pa2, pa3); SBAR();
  pv_d0(o, vb0, pa0, pa1, pa2, pa3); partialSM(pB0, pB1, m_reg, mnB, alB, NT - 1, c, cb, tq, hi);
  __syncthreads(); RESC(alB);
  finishSM(pB0, pB1, alB, l_reg, pa0, pa1, pa2, pa3); SBAR();
  pv_d0(o, vb0 + SHM_V, pa0, pa1, pa2, pa3);
  if (hi == 0) li_l[r32] = l_reg; asm volatile("s_waitcnt lgkmcnt(0)" ::: "memory");
  float rli[16];
  const float fac = sm ? P.lam : 1.f;
#pragma unroll
  for (int r = 0; r < 16; ++r) rli[r] = __builtin_amdgcn_rcpf(li_l[crow(r, hi)]) * fac;
  __syncthreads();
  float* stg = (float*)lds + wq * (32 * STG_LD);
  if (sm == 1) {
#pragma unroll
    for (int d0 = 0; d0 < 4; ++d0)
#pragma unroll
      for (int r = 0; r < 16; ++r) stg[crow(r, hi) * STG_LD + d0 * 32 + r32] = o[d0][r] * rli[r];
  }
  __syncthreads();
  if (sm == 0) {
#pragma unroll
    for (int d0 = 0; d0 < 4; ++d0)
#pragma unroll
      for (int r = 0; r < 16; ++r) { float* p = &stg[crow(r, hi) * STG_LD + d0 * 32 + r32]; *p = o[d0][r] * rli[r] - *p; }
    asm volatile("s_waitcnt lgkmcnt(0)" ::: "memory");
    const float* rp = stg + r32 * STG_LD + hi * 64;
    f32x4 v[16]; float ss = 0.f;
#pragma unroll
    for (int i = 0; i < 16; ++i) { v[i] = *(const f32x4*)(rp + 4 * i); ss += (v[i].x * v[i].x + v[i].y * v[i].y) + (v[i].z * v[i].z + v[i].w * v[i].w); }
    { auto rr = __builtin_amdgcn_permlane32_swap(__float_as_uint(ss), __float_as_uint(ss), false, false); ss = __uint_as_float(rr[0]) + __uint_as_float(rr[1]); }
    const float rs = 0.8f / sqrtf(ss * (1.f / 128.f) + 1e-5f);
    unsigned char* Ow = P.O8 + (rowbase + q0 + wq * QBLK + r32) * LD + h * 128 + hi * 64;
    const float* gp = P.subln_g + hi * 64; const float rq = rs * P.inv_s;
#pragma unroll
    for (int i = 0; i < 4; ++i) { u32x4 w;
#pragma unroll
      for (int q = 0; q < 4; ++q) { const f32x4 g = *(const f32x4*)(gp + 16 * i + 4 * q); const f32x4 a = v[4 * i + q] * rq * g;
        w[q] = ((unsigned)((int)__builtin_rintf(a.x)) & 255u) | (((unsigned)((int)__builtin_rintf(a.y)) & 255u) << 8) | (((unsigned)((int)__builtin_rintf(a.z)) & 255u) << 16) | (((unsigned)((int)__builtin_rintf(a.w)) & 255u) << 24); }
      *(u32x4*)(Ow + 16 * i) = w; }
    if (h == 0 && hi == 0) P.OS[rowbase + q0 + wq * QBLK + r32] = P.s;
  }
  __syncthreads();
#undef SLOAD
#undef SWRITE
#undef SWAIT
#undef RESC
}

constexpr int SLOT2 = 16384, L2_K = 0, L2_V = 3 * SLOT2, L2_WS = 6 * SLOT2, L2_TB = L2_WS + 8 * 256, LDS_BYTES2 = L2_TB + TB_N * 4;
static_assert(4 * STG_BYTES <= L2_WS && LDS_BYTES2 <= 131072, "combine stage must stay below the per-wave words; the body's LDS must fit the ring");
#define PIN(x) asm volatile("" : "+v"(x))
#define MFMA32(a, b, c) __builtin_amdgcn_mfma_f32_32x32x16_bf16(a, b, c, 0, 0, 0)
#define WAIT_BAR(N) asm volatile("s_waitcnt vmcnt(" #N ") lgkmcnt(0)\n\ts_barrier" ::: "memory")
__device__ __forceinline__ void glds16(unsigned voff, const void* sbase, unsigned lds_base) {
    unsigned sv; asm volatile("s_mov_b32 %0, m0\n\ts_mov_b32 m0, %2\n\ts_nop 0\n\tglobal_load_lds_dwordx4 %1, %3\n\ts_mov_b32 m0, %0" : "=&s"(sv) : "v"(voff), "s"(lds_base), "s"(sbase) : "memory"); }
typedef __attribute__((address_space(3))) const char* lds_cptr;
typedef short v4i16_t __attribute__((ext_vector_type(4)));
__device__ __forceinline__ void kload2(bf16x8* kf, lds_cptr kp, int d0) { kf[2 * d0] = *(const __attribute__((address_space(3))) bf16x8*)(kp + d0 * 2048); kf[2 * d0 + 1] = *(const __attribute__((address_space(3))) bf16x8*)(kp + d0 * 2048 + 512); }
__device__ __forceinline__ s16x4 vtr(lds_cptr p) { return __builtin_bit_cast(s16x4, __builtin_amdgcn_ds_read_tr16_b64_v4i16((__attribute__((address_space(3))) v4i16_t*)p)); }
#define MX3(a, b, c) __builtin_fmaxf(__builtin_fmaxf((a), (b)), (c))
__device__ __forceinline__ float rowmax(const f32x16& p0, const f32x16& p1) {
    float a = MX3(p0[0], p0[1], p1[0]), b = MX3(p0[2], p0[3], p1[1]); a = MX3(a, p1[2], p1[3]);
#pragma unroll
    for (int r = 4; r < 16; r += 4) { a = MX3(a, p0[r], p0[r + 1]); b = MX3(b, p0[r + 2], p0[r + 3]); a = MX3(a, p1[r], p1[r + 1]); b = MX3(b, p1[r + 2], p1[r + 3]); }
    float m = __builtin_fmaxf(a, b); auto rr = __builtin_amdgcn_permlane32_swap(__float_as_uint(m), __float_as_uint(m), false, false);
    return __builtin_fmaxf(__uint_as_float(rr[0]), __uint_as_float(rr[1])); }
template <bool REL> __device__ __forceinline__ void band_xform(f32x16& p0, f32x16& p1, int j, int c, float cb, const __attribute__((address_space(3))) float* tq, int hi) {
  if (j > c) {
#pragma unroll
    for (int r = 0; r < 16; ++r) { p0[r] = -INFINITY; p1[r] = -INFINITY; }
  } else if (j >= c - 2) { const __attribute__((address_space(3))) float* t = tq + 64 * j; const float sub = REL ? cb : 0.f;
#pragma unroll
    for (int r = 0; r < 16; ++r) { p0[r] += t[crow(r, hi)] - sub; p1[r] += t[32 + crow(r, hi)] - sub; }
  } else if (!REL) {
#pragma unroll
    for (int r = 0; r < 16; ++r) { p0[r] += cb; p1[r] += cb; }
  }
}
__device__ __forceinline__ void attn_unit2(const Params& P, int b, int h, int qb, char* lds, int tid_in) {
  const int tid = tid_in, wid = __builtin_amdgcn_readfirstlane(tid >> 6), lane = tid & 63, r32 = lane & 31, hi = lane >> 5;
  const int sm = wid >> 2, wq = wid & 3;
  const long rowbase = (long)b * SEQ; const int q0 = qb * 128, NT = 2 * qb + 2;
  const int qpos = q0 + wq * QBLK + r32, c = (q0 + wq * QBLK) >> 6;
  float* wsf = (float*)(lds + L2_WS) + wid * 64; float* tb = (float*)(lds + L2_TB);
  if (tid < TB_N) tb[tid] = P.rel_bias[t5_bucket(tid - 191) * NHEAD + h] * L2E;
  const float cb = P.rel_bias[15 * NHEAD + h] * L2E;
  const __attribute__((address_space(3))) float* tq = (const __attribute__((address_space(3))) float*)tb + 191 - qpos;
  const unsigned short* Qw = P.Q + (rowbase + qpos) * LD + h * 128 + sm * 64 + hi * 8;
  const unsigned lds0 = (unsigned)(uintptr_t)lds;
  const char* kbase = (const char*)(P.K + rowbase * LD + h * 128 + wid * 16);
  const char* vbase = (const char*)(P.V + rowbase * LD + h * 128 + (long)(32 * (wid & 1)) * LD + (wid >> 1) * 32);
  const unsigned koff = (unsigned)lane * (LD * 2), voff = (unsigned)(lane >> 2) * (LD * 2) + (lane & 3) * 16;
  const unsigned kdst = lds0 + L2_K + wid * 2048, vdst = lds0 + L2_V + wid * 2048;
#define RFL(x) ((unsigned)__builtin_amdgcn_readfirstlane((int)(x)))
#define DMA_K(t, slot) do { const char* g_ = kbase + (long)(t) * (KVBLK * LD * 2); glds16(koff, g_, RFL(kdst + (slot))); glds16(koff, g_ + 16, RFL(kdst + (slot) + 1024)); } while (0)
#define DMA_V(t, slot) do { const char* g_ = vbase + (long)(t) * (KVBLK * LD * 2); glds16(voff, g_, RFL(vdst + (slot))); glds16(voff, g_ + 16 * LD * 2, RFL(vdst + (slot) + 1024)); } while (0)
  const lds_cptr vp0 = (lds_cptr)lds + L2_V + ((lane >> 4) & 1) * 32 + (lane & 3) * 8 + (4 * hi + ((lane & 15) >> 2)) * 64;
  const lds_cptr kp0 = (lds_cptr)lds + L2_K + (8 * sm + hi) * 1024 + r32 * 16;
  DMA_K(0, 0); DMA_V(0, 0); DMA_K(1, SLOT2);
  bf16x8 qr[4];
#pragma unroll
  for (int d0 = 0; d0 < 4; ++d0) qr[d0] = *reinterpret_cast<const bf16x8*>(Qw + d0 * 16);
  float mhat = 0.f, l_reg = 0.f; f32x16 o[4] = {}; const f32x16 zero16 = {};
  bool resc = false;
  f32x16 pA0, pA1, pB0, pB1; bf16x8 kf[8]; s16x4 vlo[4], vhi[4]; u32x4 pw0, pw1, pw2, pw3;
  int sl_prev = 0, sl_cur = 0, sl_next = SLOT2;
#define ROT() do { sl_prev = sl_cur; sl_cur = sl_next; sl_next = (sl_next == 2 * SLOT2) ? 0 : sl_next + SLOT2; } while (0)
#define RESC2() do { if (resc) { _Pragma("unroll") for (int d_ = 0; d_ < 4; ++d_) _Pragma("unroll") for (int r = 0; r < 16; ++r) o[d_][r] *= wsf[crow(r, hi)]; } } while (0)
  DMA_K(2, 2 * SLOT2);
  WAIT_BAR(6);
#pragma unroll
  for (int d0 = 0; d0 < 4; ++d0) kload2(kf, kp0, d0);
  pA0 = MFMA32(kf[0], qr[0], zero16); pA1 = MFMA32(kf[1], qr[0], zero16); pA0 = MFMA32(kf[2], qr[1], pA0); pA1 = MFMA32(kf[3], qr[1], pA1);
  pA0 = MFMA32(kf[4], qr[2], pA0); pA1 = MFMA32(kf[5], qr[2], pA1); pA0 = MFMA32(kf[6], qr[3], pA0); pA1 = MFMA32(kf[7], qr[3], pA1);
  band_xform<false>(pA0, pA1, 0, c, cb, tq, hi);
  { mhat = rowmax(pA0, pA1); const float nmh = -mhat;
#pragma unroll
    for (int r = 0; r < 16; ++r) { pA0[r] = __builtin_amdgcn_exp2f(pA0[r] + nmh); pA1[r] = __builtin_amdgcn_exp2f(pA1[r] + nmh); } }
  f32x16 negm;
#pragma unroll
  for (int r = 0; r < 16; ++r) negm[r] = cb - mhat;
  PIN(negm);
  WAIT_BAR(0);
  DMA_K(3, 0); DMA_V(1, SLOT2); ROT();
#pragma unroll
  for (int d0 = 0; d0 < 4; ++d0) kload2(kf, kp0 + sl_cur, d0);
  if (NT == 2) { WAIT_BAR(0); } else { WAIT_BAR(4); }
#define PKW(P_, i) cvtpk(P_[i], P_[i + 1])
#define PAF(k) __builtin_bit_cast(bf16x8, pw##k)
#define VFR(i) (bf16x8){vlo[i][0], vlo[i][1], vlo[i][2], vlo[i][3], vhi[i][0], vhi[i][1], vhi[i][2], vhi[i][3]}
#define VRDS(slot, qd, ks) do { vlo[slot] = vtr(vp_ + ((qd) * 4096 + (ks) * 1024)); vhi[slot] = vtr(vp_ + ((qd) * 4096 + (ks) * 1024 + 512)); } while (0)
#define KRD(G, d0) do { if (G) { kload2(kf, kp0 + sl_next, d0); SBAR(); } } while (0)
#define GAPA(MF, a0, a1, a2, a3, W0, W1, PW) do { MF; sacc += a0; sacc += a1; sacc += a2; sacc += a3; W0; W1; PIN(PW); PIN(sacc); SBAR(); } while (0)
#define EX(BAND_, v) __builtin_amdgcn_exp2f(v)
#define GAPB(BAND_, MF, X, i) do { MF; X[i] = EX(BAND_, X[i]); X[i + 1] = EX(BAND_, X[i + 1]); PIN(X); SBAR(); } while (0)
#define STEP(C0, C1, P0, P1, t, BAND_, GK, GV, GL) do { SBAR(); \
    const lds_cptr vp_ = vp0 + sl_prev; \
    float sacc = P0[0] + P0[1]; \
                          GAPA(C0 = MFMA32(kf[0], qr[0], negm), P0[2], P0[3], P0[4], P0[5],     pw0[0] = PKW(P0, 0),  pw0[1] = PKW(P0, 2),  pw0); \
                          GAPA(C1 = MFMA32(kf[1], qr[0], negm), P0[6], P0[7], P0[8], P0[9],     pw0[2] = PKW(P0, 4),  pw0[3] = PKW(P0, 6),  pw0); \
                          GAPA(C0 = MFMA32(kf[2], qr[1], C0),    P0[10], P0[11], P0[12], P0[13], pw1[0] = PKW(P0, 8),  pw1[1] = PKW(P0, 10), pw1); \
                          GAPA(C1 = MFMA32(kf[3], qr[1], C1),    P0[14], P0[15], P1[0], P1[1],   pw1[2] = PKW(P0, 12), pw1[3] = PKW(P0, 14), pw1); \
    VRDS(0, 0, 0); SBAR(); GAPA(C0 = MFMA32(kf[4], qr[2], C0),    P1[2], P1[3], P1[4], P1[5],     pw2[0] = PKW(P1, 0),  pw2[1] = PKW(P1, 2),  pw2); \
    VRDS(1, 1, 0); SBAR(); GAPA(C1 = MFMA32(kf[5], qr[2], C1),    P1[6], P1[7], P1[8], P1[9],     pw2[2] = PKW(P1, 4),  pw2[3] = PKW(P1, 6),  pw2); \
    VRDS(2, 2, 0); SBAR(); GAPA(C0 = MFMA32(kf[6], qr[3], C0),    P1[10], P1[11], P1[12], P1[13], pw3[0] = PKW(P1, 8),  pw3[1] = PKW(P1, 10), pw3); \
    VRDS(3, 3, 0); SBAR(); GAPA(C1 = MFMA32(kf[7], qr[3], C1),    P1[14], P1[15], 0.f, 0.f,       pw3[2] = PKW(P1, 12), pw3[3] = PKW(P1, 14), pw3); \
    l_reg += sacc; \
    if (GK) DMA_K((t) + 3, sl_cur); if (GV) DMA_V((t) + 1, sl_next); \
    if (BAND_) band_xform<true>(C0, C1, (t), c, cb, tq, hi); \
    { const float rm = rowmax(C0, C1); resc = false;                                                             \
      if (__builtin_expect(__any(rm > THR), 0)) { const float dl = __builtin_fmaxf(rm, 0.f); mhat += dl;            \
          _Pragma("unroll") for (int r = 0; r < 16; ++r) { C0[r] -= dl; C1[r] -= dl; } \
          _Pragma("unroll") for (int r = 0; r < 16; ++r) negm[r] = cb - mhat; PIN(negm); \
          const float f = __builtin_amdgcn_exp2f(-dl); l_reg *= f; if (hi == 0) wsf[r32] = f; resc = true; } } \
    SBAR(); \
      \
    GAPB(BAND_, o[0] = MFMA32(PAF(0), VFR(0), o[0]), C0, 0);  VRDS(0, 0, 1); SBAR(); \
    GAPB(BAND_, o[1] = MFMA32(PAF(0), VFR(1), o[1]), C0, 2);  VRDS(1, 1, 1); SBAR(); \
    GAPB(BAND_, o[2] = MFMA32(PAF(0), VFR(2), o[2]), C0, 4);  VRDS(2, 2, 1); SBAR(); \
    GAPB(BAND_, o[3] = MFMA32(PAF(0), VFR(3), o[3]), C0, 6);  VRDS(3, 3, 1); SBAR(); \
    GAPB(BAND_, o[0] = MFMA32(PAF(1), VFR(0), o[0]), C0, 8);  VRDS(0, 0, 2); SBAR(); \
    GAPB(BAND_, o[1] = MFMA32(PAF(1), VFR(1), o[1]), C0, 10); VRDS(1, 1, 2); SBAR(); \
    GAPB(BAND_, o[2] = MFMA32(PAF(1), VFR(2), o[2]), C0, 12); VRDS(2, 2, 2); SBAR(); \
    GAPB(BAND_, o[3] = MFMA32(PAF(1), VFR(3), o[3]), C0, 14); VRDS(3, 3, 2); SBAR(); \
    GAPB(BAND_, o[0] = MFMA32(PAF(2), VFR(0), o[0]), C1, 0);  VRDS(0, 0, 3); SBAR(); \
    GAPB(BAND_, o[1] = MFMA32(PAF(2), VFR(1), o[1]), C1, 2);  VRDS(1, 1, 3); SBAR(); \
    GAPB(BAND_, o[2] = MFMA32(PAF(2), VFR(2), o[2]), C1, 4);  VRDS(2, 2, 3); SBAR(); \
    GAPB(BAND_, o[3] = MFMA32(PAF(2), VFR(3), o[3]), C1, 6);  VRDS(3, 3, 3); SBAR(); \
    KRD(GL, 0); GAPB(BAND_, o[0] = MFMA32(PAF(3), VFR(0), o[0]), C1, 8); \
    KRD(GL, 1); GAPB(BAND_, o[1] = MFMA32(PAF(3), VFR(1), o[1]), C1, 10); \
    KRD(GL, 2); GAPB(BAND_, o[2] = MFMA32(PAF(3), VFR(2), o[2]), C1, 12); \
    KRD(GL, 3); GAPB(BAND_, o[3] = MFMA32(PAF(3), VFR(3), o[3]), C1, 14); \
    } while (0)
  int t = 1;
  for (; t + 5 < NT; t += 2) {
    STEP(pB0, pB1, pA0, pA1, t, false, true, true, true);     WAIT_BAR(4); RESC2(); ROT();
    STEP(pA0, pA1, pB0, pB1, t + 1, false, true, true, true); WAIT_BAR(4); RESC2(); ROT();
  }
#define ENDW(tt) do { if ((tt) + 3 < NT) { WAIT_BAR(4); } else if ((tt) + 2 < NT) { WAIT_BAR(2); } else { WAIT_BAR(0); } } while (0)
  for (; t + 1 < NT; t += 2) {
    STEP(pB0, pB1, pA0, pA1, t, true, (t + 3 < NT), (t + 1 < NT), (t + 1 < NT));         ENDW(t);     RESC2(); ROT();
    STEP(pA0, pA1, pB0, pB1, t + 1, true, (t + 4 < NT), (t + 2 < NT), (t + 2 < NT));     ENDW(t + 1); RESC2(); ROT();
  }
  STEP(pB0, pB1, pA0, pA1, NT - 1, true, false, false, false); RESC2();
  { float sacc = pB0[0] + pB0[1];
#pragma unroll
    for (int r = 2; r < 16; ++r) sacc += pB0[r];
#pragma unroll
    for (int r = 0; r < 16; ++r) sacc += pB1[r];
    l_reg += sacc;
    pw0 = (u32x4){PKW(pB0, 0), PKW(pB0, 2), PKW(pB0, 4), PKW(pB0, 6)}; pw1 = (u32x4){PKW(pB0, 8), PKW(pB0, 10), PKW(pB0, 12), PKW(pB0, 14)};
    pw2 = (u32x4){PKW(pB1, 0), PKW(pB1, 2), PKW(pB1, 4), PKW(pB1, 6)}; pw3 = (u32x4){PKW(pB1, 8), PKW(pB1, 10), PKW(pB1, 12), PKW(pB1, 14)};
    const lds_cptr vp_ = vp0 + sl_cur;
#pragma unroll
    for (int ks = 0; ks < 4; ++ks) {
      VRDS(0, 0, ks); VRDS(1, 1, ks); VRDS(2, 2, ks); VRDS(3, 3, ks);
      const bf16x8 pa = ks == 0 ? PAF(0) : ks == 1 ? PAF(1) : ks == 2 ? PAF(2) : PAF(3);
      o[0] = MFMA32(pa, VFR(0), o[0]); o[1] = MFMA32(pa, VFR(1), o[1]); o[2] = MFMA32(pa, VFR(2), o[2]); o[3] = MFMA32(pa, VFR(3), o[3]); } }
  { auto rr = __builtin_amdgcn_permlane32_swap(__float_as_uint(l_reg), __float_as_uint(l_reg), false, false); l_reg = __uint_as_float(rr[0]) + __uint_as_float(rr[1]); }
  float* li_l = wsf + 32;
  if (hi == 0) li_l[r32] = l_reg; asm volatile("s_waitcnt lgkmcnt(0)" ::: "memory");
  float rli[16];
  const float fac = sm ? P.lam : 1.f;
#pragma unroll
  for (int r = 0; r < 16; ++r) rli[r] = __builtin_amdgcn_rcpf(li_l[crow(r, hi)]) * fac;
  WAIT_BAR(0);
  float* stg = (float*)lds + wq * (32 * STG_LD);
  if (sm == 1) {
#pragma unroll
    for (int d0 = 0; d0 < 4; ++d0)
#pragma unroll
      for (int r = 0; r < 16; ++r) stg[crow(r, hi) * STG_LD + d0 * 32 + r32] = o[d0][r] * rli[r];
  }
  __syncthreads();
  if (sm == 0) {
#pragma unroll
    for (int d0 = 0; d0 < 4; ++d0)
#pragma unroll
      for (int r = 0; r < 16; ++r) { float* p = &stg[crow(r, hi) * STG_LD + d0 * 32 + r32]; *p = o[d0][r] * rli[r] - *p; }
    asm volatile("s_waitcnt lgkmcnt(0)" ::: "memory");
    const float* rp = stg + r32 * STG_LD + hi * 64;
    f32x4 v[16]; float ss = 0.f;
#pragma unroll
    for (int i = 0; i < 16; ++i) { v[i] = *(const f32x4*)(rp + 4 * i); ss += (v[i].x * v[i].x + v[i].y * v[i].y) + (v[i].z * v[i].z + v[i].w * v[i].w); }
    { auto rr = __builtin_amdgcn_permlane32_swap(__float_as_uint(ss), __float_as_uint(ss), false, false); ss = __uint_as_float(rr[0]) + __uint_as_float(rr[1]); }
    const float rs = 0.8f / sqrtf(ss * (1.f / 128.f) + 1e-5f);
    unsigned char* Ow = P.O8 + (rowbase + q0 + wq * QBLK + r32) * LD + h * 128 + hi * 64;
    const float* gp = P.subln_g + hi * 64; const float rq = rs * P.inv_s;
#pragma unroll
    for (int i = 0; i < 4; ++i) { u32x4 w;
#pragma unroll
      for (int q = 0; q < 4; ++q) { const f32x4 g = *(const f32x4*)(gp + 16 * i + 4 * q); const f32x4 a = v[4 * i + q] * rq * g;
        w[q] = ((unsigned)((int)__builtin_rintf(a.x)) & 255u) | (((unsigned)((int)__builtin_rintf(a.y)) & 255u) << 8) | (((unsigned)((int)__builtin_rintf(a.z)) & 255u) << 16) | (((unsigned)((int)__builtin_rintf(a.w)) & 255u) << 24); }
      *(u32x4*)(Ow + 16 * i) = w; }
    if (h == 0 && hi == 0) { float sv; asm volatile("v_mov_b32 %0, %1" : "=v"(sv) : "s"(P.s)); P.OS[rowbase + q0 + wq * QBLK + r32] = sv; }
  }
  __syncthreads();
#undef RFL
#undef DMA_K
#undef DMA_V
#undef ROT
#undef RESC2
#undef PKW
#undef PAF
#undef VFR
#undef VRDS
#undef KRD
#undef GAPA
#undef EX
#undef GAPB
#undef STEP
#undef ENDW
}
#undef SBAR
}
constexpr int NWAVES = 8;
constexpr int BATCH = 4, SEQ = 8192, DM = 2048, T = BATCH * SEQ;
constexpr int IN_COLS = 8192, PW_ = 1024, NEXP = 16384, PLE = 256;
constexpr float LN_EPS = 1e-5f;
constexpr float ALPHA = 1.189207115002721f;
constexpr int N_PHASES = 14;
constexpr int N_LAUNCHES = MK_N_LAUNCHES;
static_assert(N_LAUNCHES == 1, "one launch only (the prologue has an internal grid barrier)");

constexpr size_t MiB = 1u << 20;
constexpr size_t WS_CTL = 0, CTL_ZERO_BYTES = 64 * 1024;
constexpr size_t WS_WBP = 2 * MiB, WS_WBA = 6 * MiB, WS_WOUT = 10 * MiB, WS_WQG = 18 * MiB, WS_PLEW = 34 * MiB, WS_POOLW = 35 * MiB;
constexpr size_t WS_WIN = 36 * MiB, WS_U = 68 * MiB, WS_V = 92 * MiB, WS_X6 = 116 * MiB;
constexpr size_t WS_XN = 196 * MiB, WS_XN8 = WS_XN, WS_YP8 = WS_XN + 64 * MiB;
constexpr size_t WS_PB = 324 * MiB;
constexpr size_t WS_XP = 340 * MiB, WS_Q = 404 * MiB, WS_YP = 532 * MiB;
constexpr size_t WS_K = 596 * MiB, WS_VV = 660 * MiB;
constexpr size_t WS_G0 = 724 * MiB, WS_G1 = 852 * MiB;
constexpr size_t WS_END = 980 * MiB;
constexpr size_t WS_YA = WS_XP  , WS_MERGED = WS_K  , WS_MERGED2 = WS_K  , WS_Z1 = WS_Q  , WS_X1 = WS_G0, WS_PWB = WS_G1, WS_QP = WS_XN, WS_ZE = WS_K;
constexpr size_t WS_WFOLD = WS_YP  ;
constexpr size_t WS_IDS = WS_YP, WS_GATES = WS_YP + 16 * MiB, WS_IDS16 = WS_YP + 32 * MiB  , WS_AW16 = WS_YP + 40 * MiB  , WS_IDT = WS_YP + 48 * MiB  ;
constexpr size_t WS_WIN8 = WS_WIN  , WS_SXN = WS_WIN + 16 * MiB  , WS_SX1 = WS_WIN + 17 * MiB  , WS_WG8 = WS_WQG + 8 * MiB  ;
constexpr size_t WS_MIX = WS_G1 + 64 * MiB  , WS_X18 = WS_XP  ;
constexpr size_t WS_YA8 = WS_G0 + 64 * MiB  , WS_M28 = WS_XP  ;
constexpr size_t WS_SYP = WS_WIN + 18 * MiB, WS_SYA = WS_WIN + 19 * MiB, WS_SM2 = WS_WIN + 20 * MiB;
constexpr int CW_WMAX_IN = 8192, CW_WMAX_G = 8256, CW_WMAX_BP = 8320, CW_WMAX_BA = 8384, CW_WMAX_O = 8448, CW_WMAX_Q = 8512, CW_WMAX_F = 8576;
constexpr size_t WS_HP = WS_XN  , WS_AW = WS_XP  , WS_Z = WS_Q  ;
constexpr int CW_TMO = 0, CW_CODE = 1, CW_BAR = 4096;

constexpr int RING_OFF = 0, RING_BYTES = 131072;
constexpr int LDSCTL_OFF = RING_BYTES, MISC_OFF = LDSCTL_OFF + 320;
constexpr int LDS_BYTES = 147456;
static_assert(MISC_OFF + 128 <= LDS_BYTES && attn::LDS_BYTES <= RING_BYTES, "LDS map");

#define GAS __attribute__((address_space(1)))
#define LAS __attribute__((address_space(3)))
typedef unsigned short bf16;
typedef unsigned v4u __attribute__((ext_vector_type(4)));
typedef float f32x4 __attribute__((ext_vector_type(4)));
typedef float f32x16 __attribute__((ext_vector_type(16)));
typedef short bf16x8 __attribute__((ext_vector_type(8)));
typedef __bf16 bf16x2_t __attribute__((ext_vector_type(2)));
typedef GAS unsigned gu32;
#define RLX_AGENT __ATOMIC_RELAXED, __HIP_MEMORY_SCOPE_AGENT
#define LDS_WAIT() asm volatile("s_waitcnt lgkmcnt(0)" ::: "memory")
#define VM_WAIT() asm volatile("s_waitcnt vmcnt(0)" ::: "memory")
__device__ __forceinline__ unsigned f2bf(float f) { unsigned u = __builtin_bit_cast(unsigned, f); return (u + 0x7fffu + ((u >> 16) & 1u)) >> 16; }
__device__ __forceinline__ unsigned pk2(float lo, float hi) { return f2bf(lo) | (f2bf(hi) << 16); }
using pg8::bf_lo; using pg8::bf_hi;

#define XB_TMO      128
#define XB_XCNT(j)  (256  + 64 * (j))
#define XB_XSUB(j)  (1280 + 64 * (j))
#define XB_XGEN(j)  (2304 + 64 * (j))
#define XB_TOP      3328
#define XB_TOPGEN   3392
#define XCD_BAR_WORDS 3456
#define XB_SPIN_CAP (1u << 18)

__device__ __forceinline__ unsigned xb_ld(unsigned* p)              { return __hip_atomic_load(p, __ATOMIC_RELAXED, __HIP_MEMORY_SCOPE_AGENT); }
__device__ __forceinline__ unsigned xb_add(unsigned* p, unsigned v) { return __hip_atomic_fetch_add(p, v, __ATOMIC_RELAXED, __HIP_MEMORY_SCOPE_AGENT); }
__device__ __forceinline__ unsigned xb_xcc_id() { return (unsigned)__builtin_amdgcn_s_getreg((3 << 11) | 20) & 0xFu; }
#define XB_SPIN(cond, bar) do { unsigned _sp = 0; while (cond) { __builtin_amdgcn_s_sleep(1); \
    if ((++_sp & 255u) == 0u) { if (xb_ld(&(bar)[XB_TMO])) break; if (_sp > XB_SPIN_CAP) { atomicAdd(&(bar)[XB_TMO], 1u); break; } } } } while (0)

struct XcdBarrier {
    unsigned* bar; unsigned x;
    volatile LAS unsigned* st;
};
__device__ __forceinline__ XcdBarrier xcd_barrier_post(unsigned* bar, volatile LAS unsigned* st) {
    XcdBarrier b; b.bar = bar; b.x = xb_xcc_id(); b.st = st;
    if (threadIdx.x == 0) (void)xb_add(&bar[XB_XCNT(b.x)], 1u);
    return b;
}
__device__ __forceinline__ void xcd_barrier_complete(unsigned* bar, unsigned x, unsigned& nloc, unsigned& nx) {
    const unsigned G = gridDim.x * gridDim.y * gridDim.z;
    unsigned sum, cnt, mine, sp = 0u;
    for (;;) {
        sum = 0u; cnt = 0u; mine = 0u;
#pragma unroll
        for (unsigned j = 0; j < 16; ++j) { const unsigned c = xb_ld(&bar[XB_XCNT(j)]); sum += c; cnt += (c > 0u) ? 1u : 0u; mine = (j == x) ? c : mine; }
        if (sum == G) break;
        __builtin_amdgcn_s_sleep(1);
        if ((++sp & 255u) == 0u) { if (xb_ld(&bar[XB_TMO])) break; if (sp > XB_SPIN_CAP) { atomicAdd(&bar[XB_TMO], 1u); break; } }
    }
    nloc = mine > 0u ? mine : 1u; nx = cnt > 0u ? cnt : 1u;
}
__device__ __forceinline__ void xcd_barrier(const XcdBarrier& b, const bool is_t0  ) {
    asm volatile("s_waitcnt vmcnt(0)" ::: "memory");
    __syncthreads();
    if (is_t0) {
        unsigned* bar = b.bar;
        __builtin_amdgcn_s_waitcnt(0);
        unsigned nloc = b.st[0], nx = b.st[1];
        if (nloc == 0u) { xcd_barrier_complete(bar, b.x, nloc, nx); b.st[0] = nloc; b.st[1] = nx; }
        const unsigned old = xb_add(&bar[XB_XSUB(b.x)], 1u);
        const unsigned gen = old / nloc;
        if (old + 1u == (gen + 1u) * nloc) {
            __builtin_amdgcn_fence(__ATOMIC_RELEASE, "agent");
            asm volatile("s_waitcnt vmcnt(0)" ::: "memory");
            const unsigned og = xb_add(&bar[XB_TOP], 1u);
            const unsigned tg = og / nx;
            if (og + 1u == (tg + 1u) * nx) xb_add(&bar[XB_TOPGEN], 1u);
            else XB_SPIN(xb_ld(&bar[XB_TOPGEN]) == tg, bar);
            __builtin_amdgcn_fence(__ATOMIC_ACQUIRE, "agent");
            xb_add(&bar[XB_XGEN(b.x)], 1u);
            asm volatile("s_waitcnt vmcnt(0)" ::: "memory");
        } else {
            XB_SPIN(xb_ld(&bar[XB_XGEN(b.x)]) == gen, bar);
            __builtin_amdgcn_fence(__ATOMIC_ACQUIRE, "agent");
            asm volatile("s_waitcnt vmcnt(0)" ::: "memory");
        }
    }
    __syncthreads();
}

__device__ __forceinline__ void xcd_barrier_arrive(const XcdBarrier& b, const bool is_t0) {
    asm volatile("s_waitcnt vmcnt(0)" ::: "memory");
    __syncthreads();
    if (is_t0) {
        unsigned* bar = b.bar;
        __builtin_amdgcn_s_waitcnt(0);
        unsigned nloc = b.st[0], nx = b.st[1];
        if (nloc == 0u) { xcd_barrier_complete(bar, b.x, nloc, nx); b.st[0] = nloc; b.st[1] = nx; }
        const unsigned old = xb_add(&bar[XB_XSUB(b.x)], 1u);
        const unsigned gen = old / nloc;
        b.st[2] = gen;
        if (old + 1u == (gen + 1u) * nloc) {
            __builtin_amdgcn_fence(__ATOMIC_RELEASE, "agent");
            asm volatile("s_waitcnt vmcnt(0)" ::: "memory");
            xb_add(&bar[XB_XGEN(b.x)], 1u);
            const unsigned og = xb_add(&bar[XB_TOP], 1u);
            const unsigned tg = og / nx;
            if (og + 1u == (tg + 1u) * nx) xb_add(&bar[XB_TOPGEN], 1u);
        }
    }
}
__device__ __forceinline__ void xcd_barrier_wait(const XcdBarrier& b, const bool is_t0) {
    if (is_t0) {
        unsigned* bar = b.bar; const unsigned gen = b.st[2];
        XB_SPIN(xb_ld(&bar[XB_TOPGEN]) <= gen, bar);
        __builtin_amdgcn_fence(__ATOMIC_ACQUIRE, "agent");
        asm volatile("s_waitcnt vmcnt(0)" ::: "memory");
    }
    __syncthreads();
}

__device__ __forceinline__ int lane_id_now() { int l; asm volatile("v_mbcnt_lo_u32_b32 %0, -1, 0\n\tv_mbcnt_hi_u32_b32 %0, -1, %0" : "=v"(l)); return l; }
struct Frame {
    LAS unsigned char* lds;
    volatile LAS unsigned* MISC;
    gu32* ctl;
    int tid, lane, wave;
    int vcu, G;
};
__device__ __forceinline__ float wave_sum(float v) {
#pragma unroll
    for (int o = 1; o < 64; o <<= 1) v += __shfl_xor(v, o);
    return v;
}
__device__ __forceinline__ void p0_transpose_item(const float* W, int K, int N, bf16* WT, int row_off, LAS float* scr, int item, int lane) {
    const int nblk = N / 32, kb = item / nblk, nb = item % nblk, k0 = 64 * kb, n0 = 32 * nb;
    { float v[32];
#pragma unroll
      for (int i = 0; i < 32; ++i) { const int kk = 2 * i + (lane >> 5); v[i] = ((const GAS float*)W)[(size_t)(k0 + kk) * N + n0 + (lane & 31)]; }
#pragma unroll
      for (int i = 0; i < 32; ++i) { const int kk = 2 * i + (lane >> 5); scr[kk * 33 + (lane & 31)] = v[i]; } }
    LDS_WAIT(); asm volatile("" ::: "memory");
    const int c = lane & 7;
#pragma unroll
    for (int j = 0; j < 4; ++j) { const int n = (lane >> 3) + 8 * j; const LAS float* s = scr + (8 * c) * 33 + n;
        v4u o; o.x = pk2(s[0 * 33], s[1 * 33]); o.y = pk2(s[2 * 33], s[3 * 33]); o.z = pk2(s[4 * 33], s[5 * 33]); o.w = pk2(s[6 * 33], s[7 * 33]);
        *(GAS v4u*)(WT + (size_t)(row_off + n0 + n) * K + k0 + 8 * c) = o; }
    LDS_WAIT(); asm volatile("" ::: "memory");
}
__device__ __forceinline__ float wave_max(float v) {
#pragma unroll
    for (int o = 1; o < 64; o <<= 1) v = fmaxf(v, __shfl_xor(v, o));
    return v;
}
__device__ __forceinline__ unsigned q8(float v) { return (unsigned)((int)__builtin_rintf(v)) & 0xFFu; }
__device__ __forceinline__ void ln0_rows(int lane, const float* x, const float* g, const float* bta, unsigned char* o8, float* oscale, int gw, int ngw) {
    int m = gw; if (m >= T) return;
    f32x4 gg[8], bb[8], v[8];
#pragma unroll
    for (int j = 0; j < 8; ++j) { gg[j] = ((const GAS f32x4*)g)[lane + 64 * j]; bb[j] = ((const GAS f32x4*)bta)[lane + 64 * j]; v[j] = ((const GAS f32x4*)(x + (size_t)m * DM))[lane + 64 * j]; }
#pragma unroll 1
    for (;;) {
        const int mn = m + ngw; const bool has = mn < T; f32x4 nv[8];
        { const GAS f32x4* xr = (const GAS f32x4*)(x + (size_t)(has ? mn : m) * DM) + lane;
#pragma unroll
          for (int j = 0; j < 8; ++j) nv[j] = xr[64 * j]; }
        float s = 0.f;
#pragma unroll
        for (int j = 0; j < 8; ++j) s += (v[j].x + v[j].y) + (v[j].z + v[j].w);
        const float mean = wave_sum(s) * (1.f / DM); float s2 = 0.f;
#pragma unroll
        for (int j = 0; j < 8; ++j) { v[j] = v[j] - mean; s2 += (v[j].x * v[j].x + v[j].y * v[j].y) + (v[j].z * v[j].z + v[j].w * v[j].w); }
        const float rstd = 1.f / sqrtf(wave_sum(s2) * (1.f / DM) + LN_EPS);
        float am = 0.f;
#pragma unroll
        for (int j = 0; j < 8; ++j) { v[j] = v[j] * rstd * gg[j] + bb[j];
            am = fmaxf(fmaxf(am, fmaxf(fabsf(v[j].x), fabsf(v[j].y))), fmaxf(fabsf(v[j].z), fabsf(v[j].w))); }
        am = fmaxf(wave_max(am), 1e-20f); const float inv = 127.f / am;
        GAS unsigned* q = (GAS unsigned*)(o8 + (size_t)m * DM) + lane;
#pragma unroll
        for (int j = 0; j < 8; ++j) q[64 * j] = q8(v[j].x * inv) | (q8(v[j].y * inv) << 8) | (q8(v[j].z * inv) << 16) | (q8(v[j].w * inv) << 24);
        if (lane == 0) oscale[m] = am * (1.f / 127.f);
        if (!has) break;
#pragma unroll
        for (int j = 0; j < 8; ++j) v[j] = nv[j];
        m = mn;
    }
}
__device__ __forceinline__ void p0_transpose_item_i8(const float* W, int K, int N, unsigned char* WT, LAS float* scr, int item, int lane, float inv) {
    const int nblk = N / 32, kb = item / nblk, nb = item % nblk, k0 = 64 * kb, n0 = 32 * nb;
    { float v[32];
#pragma unroll
      for (int i = 0; i < 32; ++i) { const int kk = 2 * i + (lane >> 5); v[i] = ((const GAS float*)W)[(size_t)(k0 + kk) * N + n0 + (lane & 31)]; }
#pragma unroll
      for (int i = 0; i < 32; ++i) { const int kk = 2 * i + (lane >> 5); scr[kk * 33 + (lane & 31)] = v[i]; } }
    LDS_WAIT(); asm volatile("" ::: "memory");
    const int c = lane & 7;
#pragma unroll
    for (int j = 0; j < 4; ++j) { const int n = (lane >> 3) + 8 * j; const LAS float* sp = scr + (8 * c) * 33 + n;
        const unsigned lo = q8(sp[0 * 33] * inv) | (q8(sp[1 * 33] * inv) << 8) | (q8(sp[2 * 33] * inv) << 16) | (q8(sp[3 * 33] * inv) << 24);
        const unsigned hi = q8(sp[4 * 33] * inv) | (q8(sp[5 * 33] * inv) << 8) | (q8(sp[6 * 33] * inv) << 16) | (q8(sp[7 * 33] * inv) << 24);
        *(GAS unsigned long long*)(WT + (size_t)(n0 + n) * K + k0 + 8 * c) = (unsigned long long)lo | ((unsigned long long)hi << 32); }
    LDS_WAIT(); asm volatile("" ::: "memory");
}
__device__ __forceinline__ void absmax_stream(const float* src, size_t n4, gu32* word, size_t gtid, size_t nthr, int lane) {
    float m = 0.f; size_t i = gtid;
    for (; i + 3 * nthr < n4; i += 4 * nthr) { f32x4 a[4];
#pragma unroll
        for (int u = 0; u < 4; ++u) a[u] = ((const GAS f32x4*)src)[i + u * nthr];
#pragma unroll
        for (int u = 0; u < 4; ++u) m = fmaxf(fmaxf(m, fmaxf(fabsf(a[u].x), fabsf(a[u].y))), fmaxf(fabsf(a[u].z), fabsf(a[u].w))); }
    for (; i < n4; i += nthr) { const f32x4 a = ((const GAS f32x4*)src)[i]; m = fmaxf(fmaxf(m, fmaxf(fabsf(a.x), fabsf(a.y))), fmaxf(fabsf(a.z), fabsf(a.w))); }
    m = wave_max(m);
    if (lane == 0) __hip_atomic_fetch_max(word, __float_as_uint(m), RLX_AGENT);
}
__device__ __forceinline__ void cvt_stream(const float* src, bf16* dst, size_t n8, size_t gtid, size_t nthr) {
    size_t i = gtid;
    for (; i + 3 * nthr < n8; i += 4 * nthr) { f32x4 a[4], b[4];
#pragma unroll
        for (int u = 0; u < 4; ++u) { a[u] = ((const GAS f32x4*)src)[2 * (i + u * nthr)]; b[u] = ((const GAS f32x4*)src)[2 * (i + u * nthr) + 1]; }
#pragma unroll
        for (int u = 0; u < 4; ++u) { v4u o; o.x = pk2(a[u].x, a[u].y); o.y = pk2(a[u].z, a[u].w); o.z = pk2(b[u].x, b[u].y); o.w = pk2(b[u].z, b[u].w); ((GAS v4u*)dst)[i + u * nthr] = o; } }
    for (; i < n8; i += nthr) { const f32x4 a = ((const GAS f32x4*)src)[2 * i], b = ((const GAS f32x4*)src)[2 * i + 1];
        v4u o; o.x = pk2(a.x, a.y); o.y = pk2(a.z, a.w); o.z = pk2(b.x, b.y); o.w = pk2(b.z, b.w); ((GAS v4u*)dst)[i] = o; }
}

struct Args { const float* in[28]; float* out; unsigned char* ws; int ph_lo, ph_hi, li, pad; };
constexpr float F8_F = 16.f, F8_PW = 8.f, F8_M = 32.f;
typedef float f32x2c __attribute__((ext_vector_type(2)));
__device__ __forceinline__ unsigned pack_fp8x4(float a, float b, float c, float d) { int w = 0; w = __builtin_amdgcn_cvt_pk_fp8_f32(a, b, w, false); w = __builtin_amdgcn_cvt_pk_fp8_f32(c, d, w, true); return (unsigned)w; }
__device__ __forceinline__ f32x4 unpack_fp8x4(unsigned w) { const f32x2c lo = __builtin_amdgcn_cvt_pk_f32_fp8((int)w, false), hi = __builtin_amdgcn_cvt_pk_f32_fp8((int)w, true); return (f32x4){lo.x, lo.y, hi.x, hi.y}; }
__device__ __forceinline__ void pool_mix_quant_phase(const bf16* XP, unsigned char* M8, float* SM, LAS float* xch  , int bstart, int bstride, int tid) {
    const int wv = __builtin_amdgcn_readfirstlane(tid >> 6), lane = tid & 63, sb = wv >> 1, ch = (wv & 1) * 64 + lane, g = ch >> 5, w = 2 << g;
    int par = 0;
    for (int b = bstart; b < T / 128; b += bstride) {
        const int t0 = b * 128 + sb * 32, tt0 = t0 & (SEQ - 1);
        const GAS v4u* p = (const GAS v4u*)(XP + (size_t)t0 * PW_ + ch * 8);
        f32x4 s0 = {0.f, 0.f, 0.f, 0.f}, s1 = s0;
        v4u rin[8], rout[8];
#define PMQ_LOAD(c4_) _Pragma("unroll") for (int k = 0; k < 8; ++k) { const int r = 8 * (c4_) + k, tt = tt0 + r; rin[k] = p[(size_t)r * (PW_ / 8)]; \
            rout[k] = (tt - w + 1 >= 0) ? *(p + (ptrdiff_t)(r - w + 1) * (PW_ / 8)) : (v4u){0u, 0u, 0u, 0u}; }
        PMQ_LOAD(0)
        for (int k = 1; k < w; ++k) if (tt0 - k >= 0) { f32x4 a, bq; pg8::unpack8(*(p - (size_t)k * (PW_ / 8)), a, bq); s0 += a; s1 += bq; }
#pragma unroll 1
        for (int c4 = 0; c4 < 4; ++c4) {
            f32x4 o0[8], o1[8]; float m[8];
#pragma unroll
            for (int k = 0; k < 8; ++k) { const int r = 8 * c4 + k, tt = tt0 + r; f32x4 x0, x1; pg8::unpack8(rin[k], x0, x1); s0 += x0; s1 += x1;
                const int n = (tt + 1 < w) ? tt + 1 : w; const float inv = 1.f / (float)n;
                o0[k] = s0 * inv - x0; o1[k] = s1 * inv - x1;
                m[k] = fmaxf(fmaxf(fmaxf(fabsf(o0[k].x), fabsf(o0[k].y)), fmaxf(fabsf(o0[k].z), fabsf(o0[k].w))), fmaxf(fmaxf(fabsf(o1[k].x), fabsf(o1[k].y)), fmaxf(fabsf(o1[k].z), fabsf(o1[k].w))));
                { f32x4 a, bq; pg8::unpack8(rout[k], a, bq); s0 -= a; s1 -= bq; } }
            if (c4 < 3) { PMQ_LOAD(c4 + 1) }
#pragma unroll
            for (int k = 0; k < 8; ++k) m[k] = wave_max(m[k]);
            LAS float* mine = xch + (par * 8 + wv) * 8; const LAS float* other = xch + (par * 8 + (wv ^ 1)) * 8;
            if (lane == 0) { *(LAS f32x4*)mine = (f32x4){m[0], m[1], m[2], m[3]}; *(LAS f32x4*)(mine + 4) = (f32x4){m[4], m[5], m[6], m[7]}; }
            __syncthreads();
            const f32x4 pa = *(const LAS f32x4*)other, pb = *(const LAS f32x4*)(other + 4);
#pragma unroll
            for (int k = 0; k < 8; ++k) { const float am = fmaxf(fmaxf(m[k], k < 4 ? pa[k & 3] : pb[k & 3]), 1e-20f), inv = 127.f / am; const int r = 8 * c4 + k;
                const f32x4 a = o0[k] * inv, bq = o1[k] * inv;
                *(GAS unsigned long long*)(M8 + (size_t)(t0 + r) * PW_ + ch * 8) = (unsigned long long)(q8(a.x) | (q8(a.y) << 8) | (q8(a.z) << 16) | (q8(a.w) << 24)) | ((unsigned long long)(q8(bq.x) | (q8(bq.y) << 8) | (q8(bq.z) << 16) | (q8(bq.w) << 24)) << 32);
                if ((wv & 1) == 0 && lane == 0) SM[t0 + r] = am * (1.f / 127.f); }
            par ^= 1;
        }
#undef PMQ_LOAD
    }
}
template <int NC, int R> __device__ __forceinline__ void quant_rows(const bf16* X, unsigned char* X8, float* XS, int gw, int ngw, int lane) {
    constexpr int NV = NC / 512;
    for (int t0 = gw; t0 < T; t0 += R * ngw) {
        v4u raw[R][NV];
#pragma unroll
        for (int r = 0; r < R; ++r) { const int t = (t0 + r * ngw < T) ? t0 + r * ngw : t0; const GAS v4u* xr = (const GAS v4u*)(X + (size_t)t * NC) + lane;
#pragma unroll
            for (int j = 0; j < NV; ++j) raw[r][j] = xr[64 * j]; }
#pragma unroll
        for (int r = 0; r < R; ++r) { const int t = t0 + r * ngw; if (t >= T) break;
            f32x4 v[2 * NV]; float am = 0.f;
#pragma unroll
            for (int j = 0; j < NV; ++j) pg8::unpack8(raw[r][j], v[2 * j], v[2 * j + 1]);
#pragma unroll
            for (int j = 0; j < 2 * NV; ++j) am = fmaxf(fmaxf(am, fmaxf(fabsf(v[j].x), fabsf(v[j].y))), fmaxf(fabsf(v[j].z), fabsf(v[j].w)));
            am = fmaxf(wave_max(am), 1e-20f); const float inv = 127.f / am;
            GAS unsigned long long* qr = (GAS unsigned long long*)(X8 + (size_t)t * NC) + lane;
#pragma unroll
            for (int j = 0; j < NV; ++j) { const f32x4 a = v[2 * j] * inv, b = v[2 * j + 1] * inv;
                qr[64 * j] = (unsigned long long)(q8(a.x) | (q8(a.y) << 8) | (q8(a.z) << 16) | (q8(a.w) << 24)) | ((unsigned long long)(q8(b.x) | (q8(b.y) << 8) | (q8(b.z) << 16) | (q8(b.w) << 24)) << 32); }
            if (lane == 0) XS[t] = am * (1.f / 127.f); }
    }
}
typedef float v16f_t __attribute__((ext_vector_type(16)));
typedef unsigned v6u_t __attribute__((ext_vector_type(6)));
typedef unsigned v2u_t __attribute__((ext_vector_type(2)));
constexpr int SLICE_ROWB = 192;
template <int R> __device__ __forceinline__ void quant_rows_sum8(const unsigned char* A8, const unsigned char* B8, unsigned char* X8, float* XS, int gw, int ngw, int lane) {
    int t0 = gw; if (t0 >= T) return;
    v2u_t ra[R][4], rb[R][4];
#define QRS_LOAD(da, db, tb) _Pragma("unroll") for (int r = 0; r < R; ++r) { const int t = ((tb) + r * ngw < T) ? (tb) + r * ngw : (tb); \
        _Pragma("unroll") for (int j = 0; j < 4; ++j) { const size_t o = (size_t)t * DM + j * 512 + lane * 8; da[r][j] = *(const GAS v2u_t*)(A8 + o); db[r][j] = *(const GAS v2u_t*)(B8 + o); } }
    QRS_LOAD(ra, rb, t0)
#pragma unroll 1
    for (;;) {
        const int tn = t0 + R * ngw; const bool has = tn < T; const int tl = has ? tn : t0; v2u_t na[R][4], nb[R][4];
        QRS_LOAD(na, nb, tl)
#pragma unroll
        for (int r = 0; r < R; ++r) { const int t = t0 + r * ngw; if (t >= T) break;
            f32x4 v[8]; float am = 0.f;
#pragma unroll
            for (int j = 0; j < 4; ++j) { v[2 * j] = unpack_fp8x4(ra[r][j].x) + unpack_fp8x4(rb[r][j].x); v[2 * j + 1] = unpack_fp8x4(ra[r][j].y) + unpack_fp8x4(rb[r][j].y); }
#pragma unroll
            for (int j = 0; j < 8; ++j) am = fmaxf(fmaxf(am, fmaxf(fabsf(v[j].x), fabsf(v[j].y))), fmaxf(fabsf(v[j].z), fabsf(v[j].w)));
            am = fmaxf(wave_max(am), 1e-20f); const float inv = 127.f / am;
            GAS unsigned long long* qr = (GAS unsigned long long*)(X8 + (size_t)t * DM) + lane;
#pragma unroll
            for (int j = 0; j < 4; ++j) { const f32x4 a = v[2 * j] * inv, b = v[2 * j + 1] * inv;
                qr[64 * j] = (unsigned long long)(q8(a.x) | (q8(a.y) << 8) | (q8(a.z) << 16) | (q8(a.w) << 24)) | ((unsigned long long)(q8(b.x) | (q8(b.y) << 8) | (q8(b.z) << 16) | (q8(b.w) << 24)) << 32); }
            if (lane == 0) XS[t] = am * (1.f / (127.f * F8_M)); }
        if (!has) break;
#pragma unroll
        for (int r = 0; r < R; ++r)
#pragma unroll
            for (int j = 0; j < 4; ++j) { ra[r][j] = na[r][j]; rb[r][j] = nb[r][j]; }
        t0 = tn;
    }
#undef QRS_LOAD
}
__device__ __forceinline__ void ln_rows_bf16(const bf16* Z, unsigned char* X8, unsigned char* X6, float* XS, const float* g, const float* bta, int gw, int ngw, int lane) {
    int t = gw; if (t >= T) return;
    f32x4 gg[8], bb[8]; v4u zw[4];
    { const GAS f32x4* gp = (const GAS f32x4*)(g + lane * 32); const GAS f32x4* bp = (const GAS f32x4*)(bta + lane * 32); const GAS v4u* zr = (const GAS v4u*)(Z + (size_t)t * DM + lane * 32);
#pragma unroll
      for (int j = 0; j < 8; ++j) { gg[j] = gp[j]; bb[j] = bp[j]; }
#pragma unroll
      for (int j = 0; j < 4; ++j) zw[j] = zr[j]; }
#pragma unroll 1
    for (;;) {
        const int tn = t + ngw; const bool has = tn < T; v4u nz[4];
        { const GAS v4u* zr = (const GAS v4u*)(Z + (size_t)(has ? tn : t) * DM + lane * 32);
#pragma unroll
          for (int j = 0; j < 4; ++j) nz[j] = zr[j]; }
        f32x4 v[8]; float s = 0.f;
#pragma unroll
        for (int j = 0; j < 4; ++j) pg8::unpack8(zw[j], v[2 * j], v[2 * j + 1]);
#pragma unroll
        for (int j = 0; j < 8; ++j) s += (v[j].x + v[j].y) + (v[j].z + v[j].w);
        const float mean = wave_sum(s) * (1.f / DM); float s2 = 0.f;
#pragma unroll
        for (int j = 0; j < 8; ++j) { v[j] = v[j] - mean; s2 += (v[j].x * v[j].x + v[j].y * v[j].y) + (v[j].z * v[j].z + v[j].w * v[j].w); }
        const float rstd = 1.f / sqrtf(wave_sum(s2) * (1.f / DM) + LN_EPS);
        float am = 0.f;
#pragma unroll
        for (int j = 0; j < 8; ++j) v[j] = v[j] * rstd * gg[j] + bb[j];
#pragma unroll
        for (int j = 0; j < 8; ++j) am = fmaxf(fmaxf(am, fmaxf(fabsf(v[j].x), fabsf(v[j].y))), fmaxf(fabsf(v[j].z), fabsf(v[j].w)));
        am = fmaxf(wave_max(am), 1e-20f); const float inv = 127.f / am, inv6 = 7.5f / am;
        GAS v4u* qr = (GAS v4u*)(X8 + (size_t)t * DM + lane * 32);
#pragma unroll
        for (int j = 0; j < 2; ++j) { v4u o;
#pragma unroll
            for (int i = 0; i < 4; ++i) { const f32x4 a = v[4 * j + i] * inv; o[i] = q8(a.x) | (q8(a.y) << 8) | (q8(a.z) << 16) | (q8(a.w) << 24); }
            qr[j] = o; }
        v16f_t lo, hi;
#pragma unroll
        for (int j = 0; j < 8; ++j) { const f32x4 a = v[j] * inv6; lo[2 * j] = a.x; hi[2 * j] = a.y; lo[2 * j + 1] = a.z; hi[2 * j + 1] = a.w; }
        const v6u_t p6 = __builtin_amdgcn_cvt_scalef32_2xpk16_fp6_f32(lo, hi, 1.0f);
        { const int sl = lane >> 3, jb = lane & 7, cb = jb >> 2, gq = jb & 3; unsigned char* r6 = X6 + ((size_t)sl * T + t) * SLICE_ROWB + gq * 16;
          *(GAS v4u*)(r6 + cb * 64) = (v4u){p6[0], p6[1], p6[2], p6[3]}; *(GAS v2u_t*)(r6 + 128 + cb * 8) = (v2u_t){p6[4], p6[5]}; }
        if (lane == 0) XS[t] = am * (1.f / 127.f);
        if (!has) break;
#pragma unroll
        for (int j = 0; j < 4; ++j) zw[j] = nz[j];
        t = tn;
    }
}

namespace psel {
constexpr float NEG = -3.0e38f;
#define PKSWZ(row, colB) ((row) * 256 + ((colB) ^ (((row) & 7) << 4)))
__device__ __forceinline__ int crow(int r, int hi) { return (r & 3) + 8 * (r >> 2) + 4 * hi; }
#define CE_DESC(a, b) do { const float hi_ = fmaxf(a, b), lo_ = fminf(a, b); a = hi_; b = lo_; } while (0)
__device__ __forceinline__ void sort16_desc(float (&x)[16]) {
    CE_DESC(x[0], x[13]); CE_DESC(x[1], x[12]); CE_DESC(x[2], x[15]); CE_DESC(x[3], x[14]); CE_DESC(x[4], x[8]); CE_DESC(x[5], x[6]); CE_DESC(x[7], x[11]); CE_DESC(x[9], x[10]);
    CE_DESC(x[0], x[5]); CE_DESC(x[1], x[7]); CE_DESC(x[2], x[9]); CE_DESC(x[3], x[4]); CE_DESC(x[6], x[13]); CE_DESC(x[8], x[14]); CE_DESC(x[10], x[15]); CE_DESC(x[11], x[12]);
    CE_DESC(x[0], x[1]); CE_DESC(x[2], x[3]); CE_DESC(x[4], x[5]); CE_DESC(x[6], x[8]); CE_DESC(x[7], x[9]); CE_DESC(x[10], x[11]); CE_DESC(x[12], x[13]); CE_DESC(x[14], x[15]);
    CE_DESC(x[0], x[2]); CE_DESC(x[1], x[3]); CE_DESC(x[4], x[10]); CE_DESC(x[5], x[11]); CE_DESC(x[6], x[7]); CE_DESC(x[8], x[9]); CE_DESC(x[12], x[14]); CE_DESC(x[13], x[15]);
    CE_DESC(x[1], x[2]); CE_DESC(x[3], x[12]); CE_DESC(x[4], x[6]); CE_DESC(x[5], x[7]); CE_DESC(x[8], x[10]); CE_DESC(x[9], x[11]); CE_DESC(x[13], x[14]);
    CE_DESC(x[1], x[4]); CE_DESC(x[2], x[6]); CE_DESC(x[5], x[8]); CE_DESC(x[7], x[10]); CE_DESC(x[9], x[13]); CE_DESC(x[11], x[14]);
    CE_DESC(x[2], x[4]); CE_DESC(x[3], x[6]); CE_DESC(x[9], x[12]); CE_DESC(x[11], x[13]);
    CE_DESC(x[3], x[5]); CE_DESC(x[6], x[8]); CE_DESC(x[7], x[9]); CE_DESC(x[10], x[12]);
    CE_DESC(x[3], x[4]); CE_DESC(x[5], x[6]); CE_DESC(x[7], x[8]); CE_DESC(x[9], x[10]); CE_DESC(x[11], x[12]);
    CE_DESC(x[6], x[7]); CE_DESC(x[8], x[9]);
}
__device__ __forceinline__ void merge16_desc(float (&a)[16], const float (&b)[16]) {
#pragma unroll
    for (int i = 0; i < 16; ++i) a[i] = fmaxf(a[i], b[15 - i]);
#pragma unroll
    for (int j = 8; j > 0; j >>= 1)
#pragma unroll
        for (int i = 0; i < 16; ++i) { const int l = i ^ j; if (l > i) CE_DESC(a[i], a[l]); }
}
__device__ __forceinline__ void load_keys(char* lds, const float* k1, const float* k2, int tid) {
#pragma unroll
    for (int i = 0; i < 8; ++i) { const int e = tid + 512 * i, which = e >> 11, rem = e & 2047, row = rem >> 4, cg = rem & 15;
        const GAS f32x4* s = (const GAS f32x4*)((which ? k2 : k1) + row * 128 + cg * 8); const f32x4 a = s[0], b = s[1];
        *(v4u*)(lds + which * 32768 + PKSWZ(row, cg * 16)) = pg8::pack8(a, b); }
}
__device__ __forceinline__ void half_top16(const char* klds, const int (&kofs)[4], const bf16* qb, int hi, float (&out)[16]) {
    bf16x8 bq[8];
#pragma unroll
    for (int ks = 0; ks < 8; ++ks) bq[ks] = *(const GAS bf16x8*)(qb + ks * 16);
    f32x16 acc[4] = {};
#pragma unroll
    for (int ks = 0; ks < 8; ++ks)
#pragma unroll
        for (int rb = 0; rb < 4; ++rb) { const bf16x8 a = *reinterpret_cast<const bf16x8*>(klds + kofs[ks & 3] + rb * 8192 + (ks >> 2) * 128);
            acc[rb] = __builtin_amdgcn_mfma_f32_32x32x16_bf16(a, bq[ks], acc[rb], 0, 0, 0); }
    float g0[16], g1[16], g2[16], g3[16];
#pragma unroll
    for (int r = 0; r < 16; ++r) { const int kb = (r & 3) + 8 * (r >> 2);
        g0[r] = __uint_as_float((__float_as_uint(acc[0][r]) & 0xFFFFFF80u) | (unsigned)(127 ^ kb)); g1[r] = __uint_as_float((__float_as_uint(acc[1][r]) & 0xFFFFFF80u) | (unsigned)(127 ^ (32 + kb)));
        g2[r] = __uint_as_float((__float_as_uint(acc[2][r]) & 0xFFFFFF80u) | (unsigned)(127 ^ (64 + kb))); g3[r] = __uint_as_float((__float_as_uint(acc[3][r]) & 0xFFFFFF80u) | (unsigned)(127 ^ (96 + kb))); }
    sort16_desc(g0); sort16_desc(g1); sort16_desc(g2); sort16_desc(g3);
    merge16_desc(g0, g1); merge16_desc(g2, g3); merge16_desc(g0, g2);
    const unsigned hx = (unsigned)hi << 2; float pr[16];
#pragma unroll
    for (int i = 0; i < 16; ++i) { g0[i] = __uint_as_float(__float_as_uint(g0[i]) ^ hx); pr[i] = __shfl_xor(g0[i], 32); }
    merge16_desc(g0, pr);
#pragma unroll
    for (int i = 0; i < 16; ++i) out[i] = g0[i];
}
__device__ __forceinline__ void select_task(const char* lds, const bf16* QP, int t0, int lane, unsigned short* IDS16, unsigned short* GATES16, unsigned short* IDT) {
    const int r32 = lane & 31, hi = lane >> 5; const int tok = t0 + (r32 >> 3), head = r32 & 7;
    const bf16* qrow = QP + (size_t)tok * DM + head * 256 + hi * 8;
    float o1[16], o2[16];
    int kofs[4];
#pragma unroll
    for (int q = 0; q < 4; ++q) { kofs[q] = r32 * 256 + ((q * 32 + hi * 16) ^ ((r32 & 7) << 4)); asm volatile("" : "+v"(kofs[q])); }
    half_top16(lds, kofs, qrow, hi, o1);
    half_top16(lds + 32768, kofs, qrow + 128, hi, o2);
    float c1[16], c2[16]; unsigned k1p[4] = {0u, 0u, 0u, 0u}, k2p[4] = {0u, 0u, 0u, 0u};
#pragma unroll
    for (int a = 0; a < 16; ++a) { const unsigned b1 = __float_as_uint(o1[a]), b2 = __float_as_uint(o2[a]); c1[a] = __uint_as_float(b1 & 0xFFFFFF80u); c2[a] = __uint_as_float(b2 & 0xFFFFFF80u);
        k1p[a >> 2] |= (127u - (b1 & 0x7Fu)) << ((a & 3) * 8); k2p[a >> 2] |= (127u - (b2 & 0x7Fu)) << ((a & 3) * 8); }
#define CAND(a, b) __uint_as_float((__float_as_uint(c1[a] + c2[b]) & 0xFFFFFF00u) | (unsigned)(((15 - (a)) << 4) | (15 - (b))))
    float L0[16], L1[16], T2[16], S[16], T3[16], L4[16], T4[16], L6[16], L7[16];
#pragma unroll
    for (int b = 0; b < 16; ++b) { L0[b] = CAND(0, b); L1[b] = b < 8 ? CAND(1, b & 7) : NEG; T2[b] = b < 5 ? CAND(2, b < 5 ? b : 0) : NEG; S[b] = b < 8 ? CAND(8 + (b & 7), 0) : NEG;
        T3[b] = b < 4 ? CAND(3, b & 3) : NEG; L4[b] = b < 3 ? CAND(4, b < 3 ? b : 0) : NEG; T4[b] = b < 2 ? CAND(5, b & 1) : NEG; L6[b] = b < 2 ? CAND(6, b & 1) : NEG; L7[b] = b < 2 ? CAND(7, b & 1) : NEG; }
#undef CAND
    merge16_desc(L0, L1); merge16_desc(T2, S); merge16_desc(T3, L4); merge16_desc(T4, L6); merge16_desc(T3, T4); merge16_desc(T3, L7); merge16_desc(T2, T3); merge16_desc(L0, T2);
    int oid[16]; float e[16]; float sum = 0.f; const float mx = L0[0];
#pragma unroll
    for (int i = 0; i < 16; ++i) { const unsigned bits = __float_as_uint(L0[i]); const int a = 15 - (int)((bits >> 4) & 15u), b = 15 - (int)(bits & 15u);
        const unsigned w1 = (a >> 2) == 0 ? k1p[0] : (a >> 2) == 1 ? k1p[1] : (a >> 2) == 2 ? k1p[2] : k1p[3]; const unsigned w2 = (b >> 2) == 0 ? k2p[0] : (b >> 2) == 1 ? k2p[1] : (b >> 2) == 2 ? k2p[2] : k2p[3];
        oid[i] = (int)((w1 >> ((a & 3) * 8)) & 0xFFu) * 128 + (int)((w2 >> ((b & 3) * 8)) & 0xFFu);
        e[i] = __builtin_amdgcn_exp2f((L0[i] - mx) * 1.4426950408889634f); sum += e[i]; }
    const float inv = 1.f / sum;
    if (hi == 0) {
        GAS v4u* ip16 = (GAS v4u*)(IDS16 + (size_t)tok * 128 + head * 16); GAS v4u* gp16 = (GAS v4u*)(GATES16 + (size_t)tok * 128 + head * 16);
#pragma unroll
        for (int i = 0; i < 2; ++i) { v4u iw, gw_;
#pragma unroll
            for (int q = 0; q < 4; ++q) { const int a = 8 * i + 2 * q; iw[q] = (unsigned)oid[a] | ((unsigned)oid[a + 1] << 16);
                typedef _Float16 h2v __attribute__((ext_vector_type(2))); const h2v gh = {(_Float16)(e[a] * inv), (_Float16)(e[a + 1] * inv)}; gw_[q] = __builtin_bit_cast(unsigned, gh); }
            ip16[i] = iw; gp16[i] = gw_; }
        GAS unsigned short* it = (GAS unsigned short*)(IDT + (size_t)tok * 128 + head);
#pragma unroll
        for (int i = 0; i < 16; ++i) it[8 * i] = (unsigned short)oid[i]; }
}
}

#ifndef U_FP4
#define U_FP4 1
#endif
constexpr float U_SCALE = U_FP4 ? 96.f : 64.f, V_SCALE = 2.f;
constexpr size_t SLICE_BYTES = (size_t)NEXP * SLICE_ROWB;
constexpr int SLICE_ROWB_U = U_FP4 ? 128 : SLICE_ROWB;
constexpr size_t SLICE_BYTES_U = (size_t)NEXP * SLICE_ROWB_U;
typedef float v32f_t __attribute__((ext_vector_type(32)));
typedef __bf16 v32bf_t __attribute__((ext_vector_type(32)));
typedef unsigned v16u_t __attribute__((ext_vector_type(16)));
#define FP6_INTERLEAVED 1
template <int CTRL> __device__ __forceinline__ float dpp_add(float x) { return x + __uint_as_float(__builtin_amdgcn_update_dpp(0u, __float_as_uint(x), CTRL, 0xF, 0xF, true)); }
__device__ __forceinline__ size_t slice_off16(int id, int j) { return (size_t)id * SLICE_ROWB + j * 16; }
__device__ __forceinline__ size_t slice_off8(int id, int j) { return (size_t)id * SLICE_ROWB + 128 + j * 8; }
typedef int v8i_t __attribute__((ext_vector_type(8)));
typedef _Float16 h2_t __attribute__((ext_vector_type(2)));
constexpr int NPC = U_FP4 ? 2 : 3;
template <int H0> __device__ __forceinline__ void rows4_issue(v4u (&R)[4 * NPC]  , const unsigned char* Uq  , const int (&idv)[8]  ) {
#pragma unroll
    for (int h = 0; h < 4; ++h) { const GAS v4u* p = (const GAS v4u*)(Uq + (size_t)(unsigned)idv[H0 + h] * SLICE_ROWB_U);
#pragma unroll
        for (int k = 0; k < NPC; ++k) R[NPC * h + k] = p[4 * k]; }
}
__device__ __forceinline__ v8i_t fp6_operand(const v6u_t a) { return (v8i_t){(int)a[0], (int)a[1], (int)a[2], (int)a[3], (int)a[4], (int)a[5], 0, 0}; }
__device__ __forceinline__ unsigned bperm(int addr, unsigned v) { return (unsigned)__builtin_amdgcn_ds_bpermute(addr, (int)v); }
__device__ __forceinline__ void rows4_compute(const v4u (&R)[4 * NPC], const v6u_t (&b)[2], float scale, unsigned short* hp_tok  , int r, int g, int pa  ) {
    const v8i_t B0 = fp6_operand(b[0]), B1 = fp6_operand(b[1]);
    f32x4 C[4];
#pragma unroll
    for (int h = 0; h < 4; ++h) { unsigned d[4 * NPC];
#pragma unroll
        for (int k = 0; k < NPC; ++k) { const v4u w = R[NPC * h + k]; d[4 * k] = bperm(pa, w.x); d[4 * k + 1] = bperm(pa, w.y); d[4 * k + 2] = bperm(pa, w.z); d[4 * k + 3] = bperm(pa, w.w); }
#if U_FP4
        const v8i_t A0 = {(int)d[0], (int)d[1], (int)d[2], (int)d[3], 0, 0, 0, 0}, A1 = {(int)d[4], (int)d[5], (int)d[6], (int)d[7], 0, 0, 0, 0};
        C[h] = __builtin_amdgcn_mfma_scale_f32_16x16x128_f8f6f4(A0, B0, (f32x4){0.f, 0.f, 0.f, 0.f}, 4, 2, 0, 0, 0, 0);
        C[h] = __builtin_amdgcn_mfma_scale_f32_16x16x128_f8f6f4(A1, B1, C[h], 4, 2, 0, 0, 0, 0); }
#else
        const v8i_t A0 = {(int)d[0], (int)d[1], (int)d[2], (int)d[3], (int)d[8 % (4 * NPC)], (int)d[9 % (4 * NPC)], 0, 0}, A1 = {(int)d[4], (int)d[5], (int)d[6], (int)d[7], (int)d[10 % (4 * NPC)], (int)d[11 % (4 * NPC)], 0, 0};
        C[h] = __builtin_amdgcn_mfma_scale_f32_16x16x128_f8f6f4(A0, B0, (f32x4){0.f, 0.f, 0.f, 0.f}, 2, 2, 0, 0, 0, 0);
        C[h] = __builtin_amdgcn_mfma_scale_f32_16x16x128_f8f6f4(A1, B1, C[h], 2, 2, 0, 0, 0, 0); }
#endif
    f32x4 o = C[0]; o = (r == 1) ? C[1] : o; o = (r == 2) ? C[2] : o; o = (r == 3) ? C[3] : o;
    if (r < 4) { const f32x4 v = o * scale; const h2_t lo = {(_Float16)v.x, (_Float16)v.y}, hi = {(_Float16)v.z, (_Float16)v.w};
        *(GAS v2u_t*)(hp_tok + r * 16 + 4 * g) = (v2u_t){__builtin_bit_cast(unsigned, lo), __builtin_bit_cast(unsigned, hi)}; }
}
struct TokM { int idv[8]; v6u_t b[2]; float sc; };
__device__ __forceinline__ void tokm_load(TokM& k, const unsigned char* X6g  , const float* SX1, const unsigned short* IDS16, int t, int lane) {
    const GAS v4u* xb = (const GAS v4u*)(X6g + (size_t)t * SLICE_ROWB); { const v4u a = xb[0], b = xb[4], e = xb[8]; k.b[0] = (v6u_t){a.x, a.y, a.z, a.w, e.x, e.y}; k.b[1] = (v6u_t){b.x, b.y, b.z, b.w, e.z, e.w}; }
    const v4u iw = *(const GAS v4u*)(IDS16   + (size_t)t * 128 + (lane >> 2) * 8);
#pragma unroll
    for (int c = 0; c < 8; ++c) k.idv[c] = (int)((c & 1) ? iw[c >> 1] >> 16 : iw[c >> 1] & 0xFFFFu);
    k.sc = SX1[t] * (127.f / 7.5f);
}
__device__ __forceinline__ void peer_h_phase(const unsigned char* X6, const float* SX1, const unsigned char* U6s, const unsigned short* IDS, unsigned short* HP  , int s, int wv, int nwv, int lane) {
    const int r = lane & 15, g = lane >> 4, pa = 4 * (4 * r + g);
    const unsigned char* Uq = U6s + (size_t)s * SLICE_BYTES_U + (lane & 3) * 16; const unsigned char* X6g = X6 + (size_t)s * T * SLICE_ROWB + g * 16;
    int t = wv; if (t >= T) return;
    TokM cur; tokm_load(cur, X6g, SX1, IDS, t, lane);
    v4u ra[4 * NPC], rb[4 * NPC];
    rows4_issue<0>(ra, Uq, cur.idv);
#pragma unroll 1
    for (;;) {
        const int tn = t + nwv; const bool has = tn < T;
        TokM nxt = cur; if (has) tokm_load(nxt, X6g, SX1, IDS, tn, lane);
        rows4_issue<4>(rb, Uq, cur.idv);
        __builtin_amdgcn_sched_barrier(0);
        unsigned short* hp = HP + ((size_t)s * T + t) * 128;
        rows4_compute(ra, cur.b, cur.sc, hp, r, g, pa);
        __builtin_amdgcn_sched_barrier(0);
        if (has) rows4_issue<0>(ra, Uq, nxt.idv);
        __builtin_amdgcn_sched_barrier(0);
        rows4_compute(rb, cur.b, cur.sc, hp + 64, r, g, pa);
        if (!has) break;
        cur = nxt; t = tn;
    }
}
__device__ __forceinline__ void peer_a_phase(const unsigned* HP  , const unsigned* GATES16  , unsigned* AW16, size_t gtid, size_t nthr) {
    constexpr int UN = 16;
    for (size_t i0 = gtid; i0 < (size_t)T * 64; i0 += UN * nthr) {
        unsigned w[UN][8]; unsigned gw2[UN];
#pragma unroll
        for (int u = 0; u < UN; ++u) { const size_t i = (i0 + u * nthr < (size_t)T * 64) ? i0 + u * nthr : i0;
#pragma unroll
            for (int s = 0; s < 8; ++s) w[u][s] = *(const GAS unsigned*)(HP + (size_t)s * T * 64 + i);
            gw2[u] = *(const GAS unsigned*)(GATES16 + i); }
#pragma unroll
        for (int u = 0; u < UN; ++u) { const size_t i = i0 + u * nthr; if (i >= (size_t)T * 64) break;
            float h0 = 0.f, h1 = 0.f;
#pragma unroll
            for (int s = 0; s < 8; ++s) { const h2_t hw = __builtin_bit_cast(h2_t, w[u][s]); h0 += (float)hw.x; h1 += (float)hw.y; }
            const pg8::f32x2 ge = pg8::gelu_pk((pg8::f32x2){h0 * (1.f / U_SCALE), h1 * (1.f / U_SCALE)});
            const h2_t gt = __builtin_bit_cast(h2_t, gw2[u]); const h2_t o = {(_Float16)(ge.x * (float)gt.x * (1.f / V_SCALE)), (_Float16)(ge.y * (float)gt.y * (1.f / V_SCALE))};
            *(GAS unsigned*)(AW16 + i) = __builtin_bit_cast(unsigned, o); }
    }
}
constexpr int GF = 4;
typedef _Float16 v32h_t __attribute__((ext_vector_type(32)));
__device__ __forceinline__ v6u_t ld_slice_row(const unsigned char* slice, int id, int j) { const v4u a = *(const GAS v4u*)(slice + slice_off16(id, j)); const v2u_t b = *(const GAS v2u_t*)(slice + slice_off8(id, j));
    return (v6u_t){a.x, a.y, a.z, a.w, b.x, b.y}; }
template <int G0> __device__ __forceinline__ void rows_issue4(v6u_t (&r)[GF], const unsigned char* slice, const unsigned (&idp)[8], int j) {
#pragma unroll
    for (int q = 0; q < GF; ++q) { const int g = G0 + q; r[q] = ld_slice_row(slice, (int)((idp[g >> 1] >> (16 * (g & 1))) & 0xFFFFu), j); }
}
template <int G0> __device__ __forceinline__ void f_compute(const v6u_t (&r)[GF], const unsigned (&avp)[8], v32h_t& acc) {
#pragma unroll
    for (int q = 0; q < GF; ++q) { const int g = G0 + q; const v32h_t vf = __builtin_amdgcn_cvt_scalef32_pk32_f16_fp6(r[q], 1.0f); const unsigned aw = avp[g >> 1]; const _Float16 a = __builtin_bit_cast(_Float16, (unsigned short)((g & 1) ? (aw >> 16) : (aw & 0xFFFFu)));
        acc = __builtin_elementwise_fma(vf, (v32h_t)a, acc);
        __builtin_amdgcn_sched_barrier(0); }
}
__device__ __forceinline__ void ld8u(unsigned (&d)[8], const void* p) { const GAS v4u* r = (const GAS v4u*)p; const v4u a = r[0], b = r[1]; d[0] = a.x; d[1] = a.y; d[2] = a.z; d[3] = a.w; d[4] = b.x; d[5] = b.y; d[6] = b.z; d[7] = b.w; }
__device__ __forceinline__ void peer_f_phase(const unsigned char* V6s, const unsigned short* IDS16, const unsigned short* AW16, unsigned char* F8  , int s, int wv, int nwv, int lane) {
    const int e = lane >> 3, j = lane & 7; const unsigned char* Vs = V6s + (size_t)s * SLICE_BYTES;
    constexpr int n_oct = T >> 3; int oct = wv, c = 0; if (oct >= n_oct) return;
#define STEP_NEXT(oa, ca, ob, cb) do { ob = oa; cb = ca + 1; if (cb == 8) { cb = 0; ob = oa + nwv; } if (ob >= n_oct) { ob = oa; cb = ca; } } while (0)
#define STEP_OFS(o, cc) ((size_t)((o) * 8 + e) * 128 + (cc) * 16)
    int o1, c1; STEP_NEXT(oct, c, o1, c1);
    unsigned idn[8], idnn[8], avc[8], avn[8], avnn[8];
    { unsigned id0[8]; ld8u(id0, IDS16 + STEP_OFS(oct, c)); ld8u(avc, AW16 + STEP_OFS(oct, c)); ld8u(idn, IDS16 + STEP_OFS(o1, c1)); ld8u(avn, AW16 + STEP_OFS(o1, c1));
      v6u_t b0[GF], b1[GF], b2[GF], b3[GF];
      rows_issue4<0>(b0, Vs, id0, j); rows_issue4<4>(b1, Vs, id0, j); rows_issue4<8>(b2, Vs, id0, j); rows_issue4<12>(b3, Vs, id0, j);
      v32h_t acc = (v32h_t)(_Float16)0;
#pragma unroll 1
      for (;;) {
        const bool last = (o1 == oct && c1 == c);
        int o2, c2; STEP_NEXT(o1, c1, o2, c2);
        ld8u(idnn, IDS16 + STEP_OFS(o2, c2)); ld8u(avnn, AW16 + STEP_OFS(o2, c2));
        const size_t zoff = (size_t)(oct * 8 + e) * DM + s * 256 + j * 32;
        __builtin_amdgcn_sched_barrier(0);
        f_compute<0>(b0, avc, acc);
        __builtin_amdgcn_sched_barrier(0);
        rows_issue4<0>(b0, Vs, idn, j);
        __builtin_amdgcn_sched_barrier(0);
        f_compute<4>(b1, avc, acc);
        __builtin_amdgcn_sched_barrier(0);
        rows_issue4<4>(b1, Vs, idn, j);
        __builtin_amdgcn_sched_barrier(0);
        f_compute<8>(b2, avc, acc);
        __builtin_amdgcn_sched_barrier(0);
        rows_issue4<8>(b2, Vs, idn, j);
        __builtin_amdgcn_sched_barrier(0);
        f_compute<12>(b3, avc, acc);
        __builtin_amdgcn_sched_barrier(0);
        rows_issue4<12>(b3, Vs, idn, j);
        __builtin_amdgcn_sched_barrier(0);
        if (c == 7) {
            GAS v4u* fo = (GAS v4u*)(F8 + zoff);
#pragma unroll
            for (int q = 0; q < 2; ++q) { v4u o;
#pragma unroll
                for (int i = 0; i < 4; ++i) { const int b = 16 * q + 4 * i; o[i] = pack_fp8x4((float)acc[b] * F8_F, (float)acc[b + 1] * F8_F, (float)acc[b + 2] * F8_F, (float)acc[b + 3] * F8_F); }
                fo[q] = o; }
            acc = (v32h_t)(_Float16)0;
        }
        if (last) break;
#pragma unroll
        for (int i = 0; i < 8; ++i) { idn[i] = idnn[i]; avc[i] = avn[i]; avn[i] = avnn[i]; }
        oct = o1; c = c1; o1 = o2; c1 = c2;
      }
    }
#undef STEP_NEXT
#undef STEP_OFS
}
__device__ __forceinline__ void ln_rows_bf16_to_f32(const unsigned char* X8  , const float* SX, const unsigned char* GP8, const unsigned char* F8, float* out, const float* g, const float* bta, int gw, int ngw, int lane) {
    int t = gw; if (t >= T) return;
    f32x4 gg[8], bb[8]; v2u_t xw[4], gq[4], fw[4]; float sx;
#pragma unroll
    for (int q = 0; q < 4; ++q) { const GAS f32x4* gp = (const GAS f32x4*)(g + q * 512 + lane * 8); const GAS f32x4* bp = (const GAS f32x4*)(bta + q * 512 + lane * 8);
        gg[2 * q] = gp[0]; gg[2 * q + 1] = gp[1]; bb[2 * q] = bp[0]; bb[2 * q + 1] = bp[1];
        const size_t o = (size_t)t * DM + q * 512 + lane * 8; xw[q] = *(const GAS v2u_t*)(X8 + o); gq[q] = *(const GAS v2u_t*)(GP8 + o); fw[q] = *(const GAS v2u_t*)(F8 + o); }
    sx = SX[t];
#pragma unroll 1
    for (;;) {
        const int tn = t + ngw; const bool has = tn < T; const int tl = has ? tn : t; v2u_t nx[4], ng[4], nf[4];
#pragma unroll
        for (int q = 0; q < 4; ++q) { const size_t o = (size_t)tl * DM + q * 512 + lane * 8; nx[q] = *(const GAS v2u_t*)(X8 + o); ng[q] = *(const GAS v2u_t*)(GP8 + o); nf[q] = *(const GAS v2u_t*)(F8 + o); }
        const float nsx = SX[tl];
        f32x4 v[8]; float s = 0.f; const float sa = sx * ALPHA;
#pragma unroll
        for (int q = 0; q < 4; ++q) { const int xlo = (int)xw[q].x, xhi = (int)xw[q].y;
            const f32x4 g0 = unpack_fp8x4(gq[q].x), g1 = unpack_fp8x4(gq[q].y), f0 = unpack_fp8x4(fw[q].x), f1 = unpack_fp8x4(fw[q].y);
#pragma unroll
            for (int i = 0; i < 4; ++i) { v[2 * q][i] = (float)((xlo << (24 - 8 * i)) >> 24) * sa + g0[i] * (1.f / F8_PW) + f0[i] * (1.f / F8_F); v[2 * q + 1][i] = (float)((xhi << (24 - 8 * i)) >> 24) * sa + g1[i] * (1.f / F8_PW) + f1[i] * (1.f / F8_F); } }
#pragma unroll
        for (int q = 0; q < 8; ++q) s += (v[q].x + v[q].y) + (v[q].z + v[q].w);
        const float mean = wave_sum(s) * (1.f / DM); float s2 = 0.f;
#pragma unroll
        for (int q = 0; q < 8; ++q) { v[q] = v[q] - mean; s2 += (v[q].x * v[q].x + v[q].y * v[q].y) + (v[q].z * v[q].z + v[q].w * v[q].w); }
        const float rstd = 1.f / sqrtf(wave_sum(s2) * (1.f / DM) + LN_EPS);
#pragma unroll
        for (int q = 0; q < 4; ++q) { GAS f32x4* op = (GAS f32x4*)(out + (size_t)t * DM + q * 512 + lane * 8);
            op[0] = v[2 * q] * rstd * gg[2 * q] + bb[2 * q]; op[1] = v[2 * q + 1] * rstd * gg[2 * q + 1] + bb[2 * q + 1]; }
        if (!has) break;
#pragma unroll
        for (int q = 0; q < 4; ++q) { xw[q] = nx[q]; gq[q] = ng[q]; fw[q] = nf[q]; }
        sx = nsx; t = tn;
    }
}
template <bool MFMA_IMG> __device__ __forceinline__ void cvt_stream_fp6(const float* src, unsigned char* dst, float scale, size_t i0, size_t i1  , size_t gtid, size_t nthr) {
    for (size_t i = i0 + gtid; i < i1; i += nthr) { const GAS f32x4* sp = (const GAS f32x4*)src + 8 * i; v16f_t lo, hi;
#pragma unroll
        for (int q = 0; q < 8; ++q) { const f32x4 a = sp[q] * scale;
#pragma unroll
            for (int c = 0; c < 4; ++c) { const int el = 4 * q + c;
                if (FP6_INTERLEAVED) { if (el & 1) hi[el >> 1] = a[c]; else lo[el >> 1] = a[c]; } else { if (el < 16) lo[el] = a[c]; else hi[el - 16] = a[c]; } } }
        const v6u_t p = __builtin_amdgcn_cvt_scalef32_2xpk16_fp6_f32(lo, hi, 1.0f);
        const int row = (int)(i >> 6), blk = (int)(i & 63), sl = blk >> 3, jb = blk & 7; unsigned char* r = dst + (size_t)sl * SLICE_BYTES;
        if (MFMA_IMG) { unsigned char* rr = r + (size_t)row * SLICE_ROWB + (jb & 3) * 16; const int cb = jb >> 2;
            *(GAS v4u*)(rr + cb * 64) = (v4u){p[0], p[1], p[2], p[3]}; *(GAS v2u_t*)(rr + 128 + cb * 8) = (v2u_t){p[4], p[5]}; }
        else { *(GAS v4u*)(r + slice_off16(row, jb)) = (v4u){p[0], p[1], p[2], p[3]}; *(GAS v2u_t*)(r + slice_off8(row, jb)) = (v2u_t){p[4], p[5]}; } }
}
__device__ __forceinline__ void cvt_stream_fp4(const float* src, unsigned char* dst, float scale, size_t i0, size_t i1, size_t gtid, size_t nthr) {
    for (size_t i = i0 + gtid; i < i1; i += nthr) { const GAS f32x4* sp = (const GAS f32x4*)src + 8 * i; unsigned w[4] = {0u, 0u, 0u, 0u};
#pragma unroll
        for (int q = 0; q < 8; ++q) { const f32x4 a = sp[q] * scale;
            if (q & 1) { w[q >> 1] = __builtin_amdgcn_cvt_scalef32_pk_fp4_f32(w[q >> 1], a.x, a.y, 1.0f, 2); w[q >> 1] = __builtin_amdgcn_cvt_scalef32_pk_fp4_f32(w[q >> 1], a.z, a.w, 1.0f, 3); }
            else       { w[q >> 1] = __builtin_amdgcn_cvt_scalef32_pk_fp4_f32(w[q >> 1], a.x, a.y, 1.0f, 0); w[q >> 1] = __builtin_amdgcn_cvt_scalef32_pk_fp4_f32(w[q >> 1], a.z, a.w, 1.0f, 1); } }
        const int row = (int)(i >> 6), blk = (int)(i & 63), sl = blk >> 3, jb = blk & 7;
        *(GAS v4u*)(dst + (size_t)sl * SLICE_BYTES_U + (size_t)row * SLICE_ROWB_U + jb * 16) = (v4u){w[0], w[1], w[2], w[3]}; }
}

__device__ __forceinline__ void fold_pool_block(const float* WBP, const float* WG, const float* SCL, float* WF, gu32* amax_word, int blk, int lane) {
    const int g = blk >> 9, i0 = ((blk >> 6) & 7) * 32, n0 = (blk & 63) * 32, r = lane & 31, h = lane >> 5;
    const GAS float* ap = (const GAS float*)WBP + (size_t)(g * 256 + 8 * h) * DM + n0 + r;
    const GAS float* bp = (const GAS float*)WG + (size_t)g * 65536 + (size_t)(i0 + r) * 256 + 8 * h;
    const GAS float* sp = (const GAS float*)SCL + g * 256 + 8 * h;
    f32x16 acc = {};
#pragma unroll 4
    for (int ks = 0; ks < 16; ++ks) {
        f32x4 a0, a1;
#pragma unroll
        for (int jj = 0; jj < 4; ++jj) { a0[jj] = ap[(size_t)(16 * ks + jj) * DM]; a1[jj] = ap[(size_t)(16 * ks + 4 + jj) * DM]; }
        const f32x4 b0 = *(const GAS f32x4*)(bp + 16 * ks) * *(const GAS f32x4*)(sp + 16 * ks), b1 = *(const GAS f32x4*)(bp + 16 * ks + 4) * *(const GAS f32x4*)(sp + 16 * ks + 4);
        acc = __builtin_amdgcn_mfma_f32_32x32x16_bf16(__builtin_bit_cast(bf16x8, pg8::pack8(a0, a1)), __builtin_bit_cast(bf16x8, pg8::pack8(b0, b1)), acc, 0, 0, 0);
    }
    float m = 0.f;
#pragma unroll
    for (int q = 0; q < 16; ++q) { const int row = (q & 3) + 8 * (q >> 2) + 4 * h; *((GAS float*)WF + (size_t)(n0 + row) * PW_ + g * 256 + i0 + r) = acc[q]; m = fmaxf(m, fabsf(acc[q])); }
    m = wave_max(m);
    if (lane == 0) __hip_atomic_fetch_max(amax_word, __float_as_uint(m), RLX_AGENT);
}
__device__ __forceinline__ void quant_fold(const float* WF, unsigned char* W8, float inv, size_t gtid, size_t nthr) {
    for (size_t i = gtid; i < (size_t)DM * PW_ / 16; i += nthr) { const GAS f32x4* sp = (const GAS f32x4*)WF + 4 * i; v4u o;
#pragma unroll
        for (int q = 0; q < 4; ++q) { const f32x4 a = sp[q] * inv; o[q] = q8(a.x) | (q8(a.y) << 8) | (q8(a.z) << 16) | (q8(a.w) << 24); }
        ((GAS v4u*)W8)[i] = o; }
}

struct FInProj { bf16 *XP, *Q, *K, *V; unsigned char *G0, *G1; const float* gate_b; int col0;
    struct Pre { f32x4 b0, b1; };
    __device__ __forceinline__ Pre load(int, int col_) const { const int col = col_ + col0, gc = col >= 4096 ? col - 4096 : 0;
        const float* gb = gate_b + gc; Pre p; p.b0 = *(const GAS f32x4*)gb; p.b1 = *(const GAS f32x4*)(gb + 4); return p; }
    __device__ __forceinline__ void operator()(int row, int col_, const f32x4 v0, const f32x4 v1, const Pre& pr) const {
        const int col = col_ + col0, t = col >> 10;
        if (t < 4) { bf16* base = t == 0 ? XP : t == 1 ? Q : t == 2 ? K : V; const float qs = t == 1 ? attn::SC : 1.f;
            *(GAS v4u*)(base + (size_t)row * 1024 + (col & 1023)) = pg8::pack8(v0 * qs, v1 * qs); }
        else { unsigned char* base = t < 6 ? G0 : G1; const int c = col & 2047; const f32x4 b0 = pr.b0, b1 = pr.b1; unsigned lo = 0u, hi = 0u;
#pragma unroll
            for (int i = 0; i < 4; ++i) { lo |= ((unsigned)__builtin_rintf(pg8::sigm(v0[i] + b0[i]) * 255.f)) << (8 * i); hi |= ((unsigned)__builtin_rintf(pg8::sigm(v1[i] + b1[i]) * 255.f)) << (8 * i); }
            *(GAS unsigned long long*)(base + (size_t)row * DM + c) = (unsigned long long)lo | ((unsigned long long)hi << 32); } } };
struct FGate8 { const unsigned char* G; unsigned char* M8;
    typedef unsigned long long Pre;
    __device__ __forceinline__ Pre load(int row, int col) const { return *(const GAS unsigned long long*)(G + (size_t)row * DM + col); }
    __device__ __forceinline__ void operator()(int row, int col, const f32x4 v0, const f32x4 v1, const Pre gw) const {
        const size_t off = (size_t)row * DM + col; const unsigned lo = (unsigned)gw, hi = (unsigned)(gw >> 32);
        f32x4 o0, o1;
#pragma unroll
        for (int i = 0; i < 4; ++i) { o0[i] = (float)((lo >> (8 * i)) & 255u) * (F8_M / 255.f) * v0[i]; o1[i] = (float)((hi >> (8 * i)) & 255u) * (F8_M / 255.f) * v1[i]; }
        *(GAS v2u_t*)(M8 + off) = (v2u_t){pack_fp8x4(o0.x, o0.y, o0.z, o0.w), pack_fp8x4(o1.x, o1.y, o1.z, o1.w)}; } };
struct FResid { const unsigned char* X8; const float* SX; bf16* Z;
    struct Pre { unsigned long long xw; float sx; };
    __device__ __forceinline__ Pre load(int row, int col) const { Pre p; p.xw = *(const GAS unsigned long long*)(X8 + (size_t)row * DM + col); p.sx = SX[row]; return p; }
    __device__ __forceinline__ void operator()(int row, int col, const f32x4 v0, const f32x4 v1, const Pre& pr) const {
        const size_t off = (size_t)row * DM + col; const unsigned long long xw = pr.xw; const int xlo = (int)(unsigned)xw, xhi = (int)(unsigned)(xw >> 32); const float sa = pr.sx * ALPHA;
        f32x4 o0, o1;
#pragma unroll
        for (int i = 0; i < 4; ++i) { o0[i] = (float)((xlo << (24 - 8 * i)) >> 24) * sa + v0[i]; o1[i] = (float)((xhi << (24 - 8 * i)) >> 24) * sa + v1[i]; }
        *(GAS v4u*)(Z + off) = pg8::pack8(o0, o1); } };
struct NoPre {};
struct FStore { bf16* O; int ldc; typedef NoPre Pre;
    __device__ __forceinline__ Pre load(int, int) const { return Pre{}; }
    __device__ __forceinline__ void operator()(int row, int col, const f32x4 v0, const f32x4 v1, const Pre&) const { *(GAS v4u*)(O + (size_t)row * ldc + col) = pg8::pack8(v0, v1); } };
struct FStore8 { unsigned char* O; int ldc; float scale;
    typedef NoPre Pre;
    __device__ __forceinline__ Pre load(int, int) const { return Pre{}; }
    __device__ __forceinline__ void operator()(int row, int col, const f32x4 v0, const f32x4 v1, const Pre&) const { const f32x4 a = v0 * scale, b = v1 * scale;
        *(GAS v2u_t*)(O + (size_t)row * ldc + col) = (v2u_t){pack_fp8x4(a.x, a.y, a.z, a.w), pack_fp8x4(b.x, b.y, b.z, b.w)}; } };
struct FGateE { const unsigned char* PW8; unsigned char* GP8;
    typedef v2u_t Pre;
    __device__ __forceinline__ Pre load(int row, int col) const { return *(const GAS v2u_t*)(PW8 + (size_t)row * DM + col); }
    __device__ __forceinline__ void operator()(int row, int col, const f32x4 v0, const f32x4 v1, const Pre pw) const {
        const size_t off = (size_t)row * DM + col; const f32x4 p0 = unpack_fp8x4(pw.x), p1 = unpack_fp8x4(pw.y);
        f32x4 o0, o1;
#pragma unroll
        for (int i = 0; i < 4; ++i) { o0[i] = pg8::sigm(v0[i]) * p0[i]; o1[i] = pg8::sigm(v1[i]) * p1[i]; }
        *(GAS v2u_t*)(GP8 + off) = (v2u_t){pack_fp8x4(o0.x, o0.y, o0.z, o0.w), pack_fp8x4(o1.x, o1.y, o1.z, o1.w)}; } };
#ifndef REP_PH
#define REP_PH -1
#endif
#ifndef REP_N
#define REP_N 2
#endif
#define REPS(k) _Pragma("unroll") for (int rep_ = 0; rep_ < ((k) == REP_PH ? REP_N : 1); ++rep_)
__global__ void __launch_bounds__(NWAVES * 64, 2) mk_fwd(Args args) {
    extern __shared__ __attribute__((aligned(16))) unsigned char lds[];
    Frame F;
    F.lds = (LAS unsigned char*)lds;
    F.MISC = (volatile LAS unsigned*)(F.lds + MISC_OFF);
    F.tid = threadIdx.x; F.lane = F.tid & 63; F.wave = __builtin_amdgcn_readfirstlane(F.tid >> 6);
#define TID_NOW() (F.wave * 64 + lane_id_now())
    F.G = gridDim.x; { const int bx = blockIdx.x; F.vcu = (F.G % 8 == 0) ? (bx % 8) * (F.G / 8) + bx / 8 : bx; }
    unsigned char* ws = args.ws;
    F.ctl = (gu32*)(ws + WS_CTL);
    for (int u = F.tid; u < (LDS_BYTES - LDSCTL_OFF) / 4; u += NWAVES * 64) ((LAS unsigned*)(F.lds + LDSCTL_OFF))[u] = 0u;
    __syncthreads();
    XcdBarrier bar; bar.bar = (unsigned*)(F.ctl + CW_BAR); bar.x = 0; bar.st = nullptr;
    if (N_LAUNCHES == 1) bar = xcd_barrier_post((unsigned*)(F.ctl + CW_BAR), F.MISC + 8);
#define GRID_BAR() do { if (N_LAUNCHES == 1) xcd_barrier(bar, TID_NOW() == 0); } while (0)
#define GRID_ARRIVE() do { if (N_LAUNCHES == 1) xcd_barrier_arrive(bar, TID_NOW() == 0); } while (0)
#define GRID_WAIT() do { if (N_LAUNCHES == 1) xcd_barrier_wait(bar, TID_NOW() == 0); } while (0)
    const int lo = args.ph_lo, hi = args.ph_hi;
#ifdef PH_ONLY
#define IN(k) ((k) == PH_ONLY)
#else
#define IN(k) (lo <= (k) && (k) < hi)
#endif
#define BOTH(k) (IN(k) && IN((k) + 1))
    const int NGW = F.G * NWAVES; const size_t nthr = (size_t)F.G * (NWAVES * 64);
#define PHASE_IDS() int tid_ = TID_NOW(); asm volatile("" : "+v"(tid_)); const int lane_ = tid_ & 63; const int wave_ = __builtin_amdgcn_readfirstlane(tid_ >> 6); \
    const int gw = F.vcu * NWAVES + wave_; const size_t gtid = (size_t)F.vcu * (NWAVES * 64) + tid_; (void)lane_; (void)gw; (void)gtid
#define KA_PTR() const __attribute__((address_space(4))) char* ka_ = (const __attribute__((address_space(4))) char*)__builtin_amdgcn_kernarg_segment_ptr(); asm volatile("" : "+s"(ka_))
#define KIN(i) (*(const float* const __attribute__((address_space(4)))*)(ka_ + 8 * (i)))
#define KOUT() (*(float* const __attribute__((address_space(4)))*)(ka_ + 8 * 28))
    bf16* WBP_T = (bf16*)(ws + WS_WBP); bf16* WBA_T = (bf16*)(ws + WS_WBA); bf16* WOUT_T = (bf16*)(ws + WS_WOUT); bf16* WQG_T = (bf16*)(ws + WS_WQG);
    bf16* PLEW_T = (bf16*)(ws + WS_PLEW); bf16* POOLW_T = (bf16*)(ws + WS_POOLW); unsigned char* UB = ws + WS_U; unsigned char* VB = ws + WS_V;
    bf16* XN = (bf16*)(ws + WS_XN); bf16* PB = (bf16*)(ws + WS_PB); bf16* XP = (bf16*)(ws + WS_XP); bf16* QB = (bf16*)(ws + WS_Q); bf16* MIX = (bf16*)(ws + WS_MIX); bf16* YP = (bf16*)(ws + WS_YP);
    bf16* KB = (bf16*)(ws + WS_K); bf16* VVB = (bf16*)(ws + WS_VV); bf16* G0 = (bf16*)(ws + WS_G0); bf16* G1 = (bf16*)(ws + WS_G1);
    bf16* YA = (bf16*)(ws + WS_YA); bf16* MERGED = (bf16*)(ws + WS_MERGED); bf16* MERGED2 = (bf16*)(ws + WS_MERGED2); bf16* Z1 = (bf16*)(ws + WS_Z1); bf16* X1 = (bf16*)(ws + WS_X1); bf16* PWB = (bf16*)(ws + WS_PWB);
    bf16* QP = (bf16*)(ws + WS_QP); bf16* ZE = (bf16*)(ws + WS_ZE); int* IDS = (int*)(ws + WS_IDS); float* GATES = (float*)(ws + WS_GATES);

#define INV_SCALE(cw) (127.f / fmaxf(__uint_as_float(__hip_atomic_load(F.ctl + (cw), RLX_AGENT)), 1e-20f))
#define XPOSE_I8(idx, K_, N_, dst, cw) do { PHASE_IDS(); KA_PTR(); const float inv_ = INV_SCALE(cw); LAS float* scr_ = (LAS float*)(F.lds + RING_OFF + wave_ * 16384); \
        for (int it_ = gw; it_ < ((K_) / 64) * ((N_) / 32); it_ += NGW) p0_transpose_item_i8(KIN(idx), K_, N_, dst, scr_, it_, lane_, inv_); } while (0)
#define TABLE_PART(IMG, idx, dst, scale, part, nparts) do { PHASE_IDS(); KA_PTR(); constexpr size_t nb_ = (size_t)NEXP * DM / 32; \
        if (IMG && U_FP4) cvt_stream_fp4(KIN(idx), dst, scale, nb_ * (part) / (nparts), nb_ * ((part) + 1) / (nparts), gtid, nthr); \
        else cvt_stream_fp6<IMG>(KIN(idx), dst, scale, nb_ * (part) / (nparts), nb_ * ((part) + 1) / (nparts), gtid, nthr); } while (0)
    if (IN(0)) {
        { PHASE_IDS(); KA_PTR();
          absmax_stream(KIN(4), (size_t)DM * IN_COLS / 4, F.ctl + CW_WMAX_IN, gtid, nthr, lane_); absmax_stream(KIN(24), (size_t)DM * DM / 4, F.ctl + CW_WMAX_G, gtid, nthr, lane_);
          absmax_stream(KIN(13), (size_t)PW_ * DM / 4, F.ctl + CW_WMAX_BA, gtid, nthr, lane_); absmax_stream(KIN(15), (size_t)DM * DM / 4, F.ctl + CW_WMAX_O, gtid, nthr, lane_);
          absmax_stream(KIN(18), (size_t)DM * DM / 4, F.ctl + CW_WMAX_Q, gtid, nthr, lane_);
          }
        GRID_ARRIVE();
        { PHASE_IDS(); KA_PTR();
          ln0_rows(lane_, KIN(0), KIN(2), KIN(3), ws + WS_XN8, (float*)(ws + WS_SXN), gw, NGW); }
        GRID_WAIT();
        constexpr int I_IN = (DM / 64) * (IN_COLS / 32), I_BR = (PW_ / 64) * (DM / 32), I_SQ = (DM / 64) * (DM / 32), I_PLE = (PLE / 64) * (DM / 32), I_PG = (256 / 64) * (256 / 32);
        { PHASE_IDS(); KA_PTR();
          const float inv_win = 127.f / fmaxf(__uint_as_float(__hip_atomic_load(F.ctl + CW_WMAX_IN, RLX_AGENT)), 1e-20f);
          LAS float* scr = (LAS float*)(F.lds + RING_OFF + wave_ * 16384);
          for (int it = gw; it < I_IN; it += NGW) p0_transpose_item_i8(KIN(4), DM, IN_COLS, ws + WS_WIN8, scr, it, lane_, inv_win); }
        GRID_ARRIVE();
        XPOSE_I8(13, PW_, DM, (unsigned char*)WBA_T, CW_WMAX_BA);
        { PHASE_IDS(); KA_PTR(); LAS float* scr = (LAS float*)(F.lds + RING_OFF + wave_ * 16384);
          for (int it = gw; it < I_PLE; it += NGW) p0_transpose_item(KIN(23), PLE, DM, PLEW_T, 0, scr, it, lane_);
          for (int blk = gw; blk < 4 * 8 * 64; blk += NGW) fold_pool_block(KIN(12), KIN(5), KIN(6), (float*)(ws + WS_WFOLD), F.ctl + CW_WMAX_F, blk, lane_);
          cvt_stream(KIN(1), PB, (size_t)T * PLE / 8, gtid, nthr); }
        if (BOTH(0)) GRID_WAIT();
    }
    if (IN(1)) {
#define P1_HALF(part) do { pg8::Gemm g{(const bf16*)(ws + WS_XN8), (const bf16*)(ws + WS_WIN8 + (size_t)(part) * (IN_COLS / 2) * DM), DM / 2, DM / 2, DM / 2, 0u, 256u * (DM / 2)}; pg8::StaticOrder S; S.init(T, IN_COLS / 2, F.G, (int)blockIdx.x); \
            const float s_win = __uint_as_float(__hip_atomic_load(F.ctl + CW_WMAX_IN, RLX_AGENT)) * (1.f / 127.f); \
            KA_PTR(); pg8::Row8<FInProj, true> E{{XP, QB, KB, VVB, (unsigned char*)G0, (unsigned char*)G1, KIN(14), (part) * (IN_COLS / 2)}, (const float*)(ws + WS_SXN), s_win}; \
            pg8::gemm_phase<pg8::Row8<FInProj, true>, pg8::StaticOrder, true, true>(F.lds + RING_OFF, g, S, E, TID_NOW()); } while (0)
        P1_HALF(0);
        GRID_ARRIVE();
        P1_HALF(1);
        if (BOTH(1)) GRID_WAIT();
    }
    if (IN(2)) { REPS(2) { PHASE_IDS(); pool_mix_quant_phase(XP, ws + WS_YP8, (float*)(ws + WS_SYP), (LAS float*)(F.lds + RING_OFF), F.vcu, F.G, tid_); } }
    if (IN(3)) {
        GRID_ARRIVE();
        { PHASE_IDS(); quant_fold((const float*)(ws + WS_WFOLD), (unsigned char*)WBP_T, INV_SCALE(CW_WMAX_F), gtid, nthr); }
        REPS(3) { int tl = TID_NOW(); asm volatile("" : "+v"(tl)); const int ll = tl & 63; KA_PTR();
          float d1 = KIN(7)[ll] * KIN(8)[ll], d2 = KIN(9)[ll] * KIN(10)[ll]; d1 = wave_sum(d1); d2 = wave_sum(d2);
          const float lam = expf(d1) - expf(d2) + 0.2f;
          float gm = fmaxf(fabsf(KIN(11)[ll]), fabsf(KIN(11)[64 + ll])); gm = fmaxf(wave_max(gm), 1e-20f); const float s_ya = gm * (0.8f * 11.313708499f / 127.f);
#define UNIFORM_F(x) __uint_as_float((unsigned)__builtin_amdgcn_readfirstlane((int)__float_as_uint(x)))
          const float lam_u = UNIFORM_F(lam), s_ya_u = UNIFORM_F(s_ya), inv_s_u = UNIFORM_F(1.f / s_ya);
          const attn::Params AP{QB, KB, VVB, ws + WS_YA8, (float*)(ws + WS_SYA), KIN(27), KIN(11), lam_u, inv_s_u, s_ya_u};
          for (int n = F.vcu; n < BATCH * attn::NHEAD * attn::NQB; n += F.G) { const int v = n & 255, i = n >> 8, bh = v >> 3, s = v & 7;
              const int qb = 8 * i + ((i & 1) ? 7 - s : s);
              int tlu = tl; asm volatile("" : "+v"(tlu));
              attn::attn_unit2(AP, bh >> 3, bh & 7, qb, (char*)lds + RING_OFF, tlu); }
          }
        GRID_WAIT();
        GRID_ARRIVE(); XPOSE_I8(15, DM, DM, (unsigned char*)WOUT_T, CW_WMAX_O); TABLE_PART(true, 21, UB, U_SCALE, 0, 2); GRID_WAIT();
    }
    if (IN(4)) {
        REPS(4) {
        pg8::Gemm g{(const bf16*)(ws + WS_YP8), WBP_T, PW_ / 2, PW_ / 2, PW_ / 2, 0u, 256u * (PW_ / 2)}; pg8::StaticOrder S; S.init(T, DM, F.G, (int)blockIdx.x);
        const float s_w = __uint_as_float(__hip_atomic_load(F.ctl + CW_WMAX_F, RLX_AGENT)) * (1.f / 127.f);
        pg8::Row8<FGate8, true> E{{(const unsigned char*)G0, ws + WS_MERGED}, (const float*)(ws + WS_SYP), s_w};
        pg8::gemm_phase<pg8::Row8<FGate8, true>, pg8::StaticOrder, true, true>(F.lds + RING_OFF, g, S, E, TID_NOW());
        }
        if (BOTH(4)) __syncthreads();
    }
    if (IN(5)) {
        REPS(5) {
        pg8::Gemm g{(const bf16*)(ws + WS_YA8), WBA_T, PW_ / 2, PW_ / 2, PW_ / 2, 0u, 256u * (PW_ / 2)}; pg8::StaticOrder S; S.init(T, DM, F.G, (int)blockIdx.x);
        const float s_w = __uint_as_float(__hip_atomic_load(F.ctl + CW_WMAX_BA, RLX_AGENT)) * (1.f / 127.f);
        pg8::Row8<FGate8, true> E{{(const unsigned char*)G1, ws + WS_MERGED + 64 * MiB}, (const float*)(ws + WS_SYA), s_w};
        pg8::gemm_phase<pg8::Row8<FGate8, true>, pg8::StaticOrder, true, true>(F.lds + RING_OFF, g, S, E, TID_NOW());
        }
        GRID_ARRIVE(); XPOSE_I8(18, DM, DM, (unsigned char*)WQG_T, CW_WMAX_Q); TABLE_PART(true, 21, UB, U_SCALE, 1, 2); GRID_WAIT();
    }
    if (IN(6)) {
        REPS(36) { PHASE_IDS(); quant_rows_sum8<2>(ws + WS_MERGED, ws + WS_MERGED + 64 * MiB, ws + WS_M28, (float*)(ws + WS_SM2), gw, NGW, lane_); }
        GRID_ARRIVE(); XPOSE_I8(24, DM, DM, ws + WS_WG8, CW_WMAX_G); GRID_WAIT();
        REPS(6) {
        pg8::Gemm g{(const bf16*)(ws + WS_M28), WOUT_T, DM / 2, DM / 2, DM / 2, 0u, 256u * (DM / 2)}; pg8::StaticOrder S; S.init(T, DM, F.G, (int)blockIdx.x);
        const float s_w = __uint_as_float(__hip_atomic_load(F.ctl + CW_WMAX_O, RLX_AGENT)) * (1.f / 127.f);
        pg8::Row8<FResid, true> E{{ws + WS_XN8, (const float*)(ws + WS_SXN), Z1}, (const float*)(ws + WS_SM2), s_w};
        pg8::gemm_phase<pg8::Row8<FResid, true>, pg8::StaticOrder, true, true>(F.lds + RING_OFF, g, S, E, TID_NOW());
        }
        GRID_ARRIVE(); TABLE_PART(false, 22, VB, V_SCALE, 0, 3); GRID_WAIT();
    }
    if (IN(7)) {
        REPS(7) {
        { PHASE_IDS(); KA_PTR(); ln_rows_bf16(Z1, ws + WS_X18, ws + WS_X6, (float*)(ws + WS_SX1), KIN(16), KIN(17), gw, NGW, lane_); }
        GRID_ARRIVE();
        pg8::Gemm g{PB, PLEW_T, PLE, PLE, PLE, 0u, 256u * PLE}; pg8::StaticOrder S; S.init(T, DM, F.G, (int)blockIdx.x);
        pg8::Row8<FStore8> E{{(unsigned char*)PWB, DM, F8_PW}};
        pg8::gemm_phase<pg8::Row8<FStore8>, pg8::StaticOrder, true, true>(F.lds + RING_OFF, g, S, E, TID_NOW());
        }
        if (BOTH(7)) GRID_WAIT();
    }
    if (IN(8)) {
        REPS(8) {
        { pg8::Gemm g{(const bf16*)(ws + WS_X18), WQG_T, DM / 2, DM / 2, DM / 2, 0u, 256u * (DM / 2)}; pg8::StaticOrder S; S.init(T, DM, F.G, (int)blockIdx.x);
          const float s_wq = __uint_as_float(__hip_atomic_load(F.ctl + CW_WMAX_Q, RLX_AGENT)) * (1.f / 127.f);
          pg8::Row8<FStore, true> E{{QP, DM}, (const float*)(ws + WS_SX1), s_wq};
          pg8::gemm_phase<pg8::Row8<FStore, true>, pg8::StaticOrder, true, true>(F.lds + RING_OFF, g, S, E, TID_NOW()); }
        GRID_ARRIVE();
        { pg8::Gemm g{(const bf16*)(ws + WS_X18), (const bf16*)(ws + WS_WG8), DM / 2, DM / 2, DM / 2, 0u, 256u * (DM / 2)}; pg8::StaticOrder S; S.init(T, DM, F.G, (int)blockIdx.x);
          const float s_wg = __uint_as_float(__hip_atomic_load(F.ctl + CW_WMAX_G, RLX_AGENT)) * (1.f / 127.f);
          pg8::Row8<FGateE, true> E{{(const unsigned char*)PWB, (unsigned char*)ZE}, (const float*)(ws + WS_SX1), s_wg};
          pg8::gemm_phase<pg8::Row8<FGateE, true>, pg8::StaticOrder, true, true>(F.lds + RING_OFF, g, S, E, TID_NOW()); }
        }
        if (BOTH(8)) GRID_WAIT();
    }
    if (IN(9)) {
        REPS(9) {
        PHASE_IDS(); KA_PTR();
        psel::load_keys((char*)lds + RING_OFF, KIN(19), KIN(20), tid_);
        __syncthreads();
        for (int task = gw; task < T / 4; task += NGW) psel::select_task((const char*)lds + RING_OFF, QP, task * 4, lane_, (unsigned short*)(ws + WS_IDS16), (unsigned short*)(ws + WS_GATES), (unsigned short*)(ws + WS_IDT));
        __syncthreads();
        }
        GRID_ARRIVE(); TABLE_PART(false, 22, VB, V_SCALE, 1, 3); GRID_WAIT();
    }
    const int sl_ = (int)blockIdx.x & 7, rk_ = (int)blockIdx.x >> 3, nwv_ = ((F.G - sl_ + 7) >> 3) * NWAVES;
    if (IN(10)) {
        REPS(10) { PHASE_IDS(); peer_h_phase(ws + WS_X6, (const float*)(ws + WS_SX1), UB, (const unsigned short*)(ws + WS_IDT), (unsigned short*)(ws + WS_HP), sl_, rk_ * NWAVES + wave_, nwv_, lane_); }
        GRID_ARRIVE(); TABLE_PART(false, 22, VB, V_SCALE, 2, 3); GRID_WAIT();
    }
    if (IN(11)) { REPS(11) { PHASE_IDS(); peer_a_phase((const unsigned*)(ws + WS_HP), (const unsigned*)(ws + WS_GATES), (unsigned*)(ws + WS_AW16), gtid, nthr); } if (BOTH(11)) GRID_BAR(); }
    if (IN(12)) {
        REPS(12) { PHASE_IDS(); peer_f_phase(VB, (const unsigned short*)(ws + WS_IDS16), (const unsigned short*)(ws + WS_AW16), ws + WS_Z, sl_, rk_ * NWAVES + wave_, nwv_, lane_); }
        if (BOTH(12)) GRID_BAR();
    }
    if (IN(13)) { REPS(13) { PHASE_IDS(); KA_PTR(); ln_rows_bf16_to_f32(ws + WS_X18, (const float*)(ws + WS_SX1), (const unsigned char*)ZE, ws + WS_Z, KOUT(), KIN(25), KIN(26), gw, NGW, lane_); } }
#undef IN
#undef BOTH
#undef GRID_BAR
}

extern "C" void kernel_launch(void* const* d_in, const int* in_sizes, int n_in, void* d_out, int out_size, void* d_ws, size_t ws_size, hipStream_t stream) {
    static int grid = 0;
    if (grid == 0) {
        if (n_in != 28 || in_sizes[0] != T * DM || out_size != T * DM || ws_size < WS_END) {
            fprintf(stderr, "kernel_launch: shape mismatch: n_in %d in0 %d out %d ws %zu (need %zu); nothing launched\n", n_in, n_in > 0 ? in_sizes[0] : -1, out_size, ws_size, (size_t)WS_END); grid = -1; return; }
        int dev = 0, cus = 0, per_cu = 0;
        if (hipGetDevice(&dev) != hipSuccess || hipDeviceGetAttribute(&cus, hipDeviceAttributeMultiprocessorCount, dev) != hipSuccess) { fprintf(stderr, "kernel_launch: device query failed\n"); grid = -1; return; }
        if (hipFuncSetAttribute((const void*)mk_fwd, hipFuncAttributeMaxDynamicSharedMemorySize, LDS_BYTES) != hipSuccess) { fprintf(stderr, "kernel_launch: hipFuncSetAttribute failed\n"); grid = -1; return; }
        if (hipOccupancyMaxActiveBlocksPerMultiprocessor(&per_cu, (const void*)mk_fwd, NWAVES * 64, LDS_BYTES) != hipSuccess || per_cu < 1)
            fprintf(stderr, "kernel_launch: note: occupancy query reports %d workgroups per CU\n", per_cu);
        (void)hipGetLastError();
        grid = cus;
    }
    if (grid < 0) return;
    if (hipMemsetAsync((char*)d_ws + WS_CTL, 0, CTL_ZERO_BYTES, stream) != hipSuccess) { fprintf(stderr, "kernel_launch: memset failed\n"); return; }
    Args a{};
    for (int i = 0; i < 28; ++i) a.in[i] = (const float*)d_in[i];
    a.out = (float*)d_out; a.ws = (unsigned char*)d_ws;
    for (int li = 0; li < N_LAUNCHES; ++li) {
        a.ph_lo = (N_LAUNCHES == 1) ? 0 : li; a.ph_hi = (N_LAUNCHES == 1) ? N_PHASES : li + 1; a.li = li; a.pad = 0;
        hipLaunchKernelGGL(mk_fwd, dim3(grid), dim3(NWAVES * 64), LDS_BYTES, stream, a);
        const hipError_t le = hipPeekAtLastError();
        if (le != hipSuccess) { fprintf(stderr, "kernel_launch: launch %d failed: %s\n", li, hipGetErrorName(le)); break; }
    }
}
```

```cpp
#include <hip/hip_runtime.h>
#include <cstdio>
#include <cstdint>
#include <type_traits>

#ifndef MK_N_LAUNCHES
#define MK_N_LAUNCHES 1
#endif

namespace pg8 {
#define PG8_LAS __attribute__((address_space(3)))
typedef unsigned short bf16_t;
typedef short bf16x8 __attribute__((ext_vector_type(8)));
typedef float f32x4 __attribute__((ext_vector_type(4)));
typedef unsigned u32x4 __attribute__((ext_vector_type(4)));
typedef int i32x4 __attribute__((ext_vector_type(4)));
constexpr int BM = 256, BK = 64, HALF = 128, HTB = HALF * BK * 2  , STAGE_BYTES = 8 * HTB, NXCD = 8, WGM = 4;

__host__ __device__ __forceinline__ int lds_byte(int r, int c) { const int st = (r >> 4) * 2 + (c >> 5), rr = r & 15, cc = c & 31, ob = rr * 64 + cc * 2; return st * 1024 + (ob ^ (((ob >> 9) & 1) << 5)); }
__host__ __device__ __forceinline__ void stage_rc(int b, int& R, int& C) { const int st = b / 1024, sb = b % 1024, swz = sb ^ (((sb >> 9) & 1) << 5); R = (st >> 1) * 16 + swz / 64; C = (st & 1) * 32 + (swz % 64) / 2; }
__host__ __device__ __forceinline__ int perm32(int rho) { const int n = rho >> 4, i = rho & 15; return 8 * (i >> 2) + 4 * n + (i & 3); }

struct Unit { int pm, pn; };
struct Gemm { const bf16_t* A; const bf16_t* Bt; int lda, ldb, K; unsigned a_pn_off, b_pn_step; };

struct StaticOrder {
    int nM, nN, nwg, G, c;
    __host__ __device__ void init(int M, int N, int G_, int c_) { nM = M / BM; nN = N / BM; nwg = nM * nN; G = G_; c = c_; }
    __host__ __device__ bool next(int i, Unit& u) const {
        const long L = (long)i * G + c; if (L >= nwg) return false;
        int wgid = (int)L; { const int q = nwg / NXCD, r = nwg % NXCD, xcd = wgid % NXCD, off = wgid / NXCD; wgid = (xcd < r ? xcd * (q + 1) : r * (q + 1) + (xcd - r) * q) + off; }
        const int nig = WGM * nN, gid = wgid / nig, fm = gid * WGM, gsz = (nM - fm) < WGM ? (nM - fm) : WGM;
        u.pm = fm + ((wgid % nig) % gsz); u.pn = (wgid % nig) / gsz; return true;
    }
    __device__ __forceinline__ void a_ready(const Unit&) const {}
    __device__ __forceinline__ void done(const Unit&) const {}
};

__device__ __forceinline__ unsigned cvt_pk_bf16(float lo, float hi) { unsigned r; asm volatile("v_cvt_pk_bf16_f32 %0, %1, %2" : "=v"(r) : "v"(lo), "v"(hi)); return r; }
__device__ __forceinline__ float bf_lo(unsigned w) { return __uint_as_float(w << 16); }
__device__ __forceinline__ float bf_hi(unsigned w) { return __uint_as_float(w & 0xffff0000u); }
__device__ __forceinline__ float sigm(float x) { return __builtin_amdgcn_rcpf(1.f + __builtin_amdgcn_exp2f(-1.4426950408889634f * x)); }
typedef float f32x2 __attribute__((ext_vector_type(2)));
__device__ __forceinline__ f32x2 gelu_pk(f32x2 v) {
    const f32x2 av = __builtin_elementwise_abs(v), d = av * 0.2316418882f + 1.0f;
    f32x2 t; t.x = __builtin_amdgcn_rcpf(d.x); t.y = __builtin_amdgcn_rcpf(d.y);
    f32x2 q = t * 0.5307027145f + (-0.7265760135f); q = q * t + 0.7107068705f; q = q * t + (-0.142248368f); q = q * t + 0.127414796f; q = q * t;
    const f32x2 s = (v * v) * (-0.72134752044f);
    f32x2 e; e.x = __builtin_amdgcn_exp2f(s.x); e.y = __builtin_amdgcn_exp2f(s.y);
    const f32x2 m = v * (q * e), r = v - m;
    f32x2 o; o.x = v.x < 0.f ? m.x : r.x; o.y = v.y < 0.f ? m.y : r.y; return o;
}
__device__ __forceinline__ u32x4 pack8(const f32x4 a, const f32x4 b) { u32x4 w; w.x = cvt_pk_bf16(a[0], a[1]); w.y = cvt_pk_bf16(a[2], a[3]); w.z = cvt_pk_bf16(b[0], b[1]); w.w = cvt_pk_bf16(b[2], b[3]); return w; }
__device__ __forceinline__ void unpack8(const u32x4 w, f32x4& a, f32x4& b) { a = (f32x4){bf_lo(w.x), bf_hi(w.x), bf_lo(w.y), bf_hi(w.y)}; b = (f32x4){bf_lo(w.z), bf_hi(w.z), bf_lo(w.w), bf_hi(w.w)}; }

template <class F, bool I8 = false> struct Row8 {
    static constexpr bool PERM = true, AFTER_DRAIN = false, INT8 = I8; F f; const float* rowscale; float wscale;
    typedef typename std::conditional<I8, i32x4, f32x4>::type acc_t;
    __device__ __forceinline__ void operator()(const acc_t (&acc)[2][2][4][2], const Unit& u, int wr, int wc, int fr, int fq) const {
        const int row0 = u.pm * BM + wr * 64 + fr, col0 = u.pn * BM + wc * 32 + 8 * fq;
        float rs[2][4]; typename F::Pre pre[2][4][2];
#pragma unroll
        for (int ai = 0; ai < 2; ++ai)
#pragma unroll
            for (int m = 0; m < 4; ++m) { const int row = row0 + ai * HALF + m * 16; rs[ai][m] = 1.f; if (I8) rs[ai][m] = rowscale[row] * wscale;
#pragma unroll
                for (int bj = 0; bj < 2; ++bj) pre[ai][m][bj] = f.load(row, col0 + bj * HALF); }
#pragma unroll
        for (int ai = 0; ai < 2; ++ai)
#pragma unroll
            for (int m = 0; m < 4; ++m) { const int row = row0 + ai * HALF + m * 16; const float r_ = rs[ai][m];
#pragma unroll
                for (int bj = 0; bj < 2; ++bj) { f32x4 v0, v1;
                    if constexpr (I8) { v0 = __builtin_convertvector(acc[ai][bj][m][0], f32x4) * r_; v1 = __builtin_convertvector(acc[ai][bj][m][1], f32x4) * r_; } else { v0 = acc[ai][bj][m][0]; v1 = acc[ai][bj][m][1]; }
                    f(row, col0 + bj * HALF, v0, v1, pre[ai][m][bj]); } }
    }
};

template <class Epi, class Sched, bool ALIGN_EPI = false, bool SP2 = false>
__device__ __forceinline__ void gemm_phase(PG8_LAS unsigned char* lds, const Gemm g, const Sched& S, const Epi& E, const int tid_in) {
    const int tid = tid_in, wid = __builtin_amdgcn_readfirstlane(tid >> 6), lane = tid & 63, wr = wid >> 2, wc = wid & 3, fr = lane & 15, fq = lane >> 4;
    const int K = g.K, nt = K / BK;
    unsigned voffA[2], voffB[2];
#pragma unroll
    for (int i = 0; i < 2; ++i) { int R, C; stage_rc(tid * 16 + i * 8192, R, C); const int Rb = Epi::PERM ? ((R & ~31) + perm32(R & 31)) : R;
        voffA[i] = (unsigned)(R * g.lda + C) * 2u; voffB[i] = (unsigned)(Rb * g.ldb + C) * 2u; }
    const size_t kstep = (size_t)(BK * 2);
    const size_t hstepA = (size_t)HALF * g.lda * 2, hstepB = (size_t)HALF * g.ldb * 2;
    const size_t tstepA = 2 * hstepA;
    const unsigned ldsw = (unsigned)wid * 1024u;
    const int aoff = lds_byte(wr * 64 + fr, fq * 8), boff = lds_byte(wc * 32 + fr, fq * 8);
#define PG8_SA(b, h) (((b) * 2 + (h)) * HTB)
#define PG8_SB(b, h) ((4 + (b) * 2 + (h)) * HTB)
#define PG8_STAGE(bufoff, gbase, voff) do { _Pragma("unroll") for (int _i = 0; _i < 2; ++_i) \
        __builtin_amdgcn_global_load_lds((const unsigned*)((const char*)(gbase) + (voff)[_i]), (PG8_LAS unsigned*)(lds + (bufoff) + ldsw + _i * 8192), 16, 0, 0); } while (0)
#define PG8_LDA(dst, b, h) do { _Pragma("unroll") for (int m = 0; m < 4; ++m) _Pragma("unroll") for (int k = 0; k < 2; ++k) dst[m][k] = *(const PG8_LAS bf16x8*)(lds + PG8_SA(b, h) + aoff + m * 2048 + k * 1024); } while (0)
#define PG8_LDB(dst, b, h) do { _Pragma("unroll") for (int n = 0; n < 2; ++n) _Pragma("unroll") for (int k = 0; k < 2; ++k) dst[n][k] = *(const PG8_LAS bf16x8*)(lds + PG8_SB(b, h) + boff + n * 2048 + k * 1024); } while (0)
#define PG8_MMA(ai, bj, At, Bt) do { __builtin_amdgcn_s_setprio(1); _Pragma("unroll") for (int k = 0; k < 2; ++k) _Pragma("unroll") for (int m = 0; m < 4; ++m) _Pragma("unroll") for (int n = 0; n < 2; ++n) \
        { if constexpr (Epi::INT8) acc[ai][bj][m][n] = __builtin_amdgcn_mfma_i32_16x16x64_i8(__builtin_bit_cast(i32x4, Bt[n][k]), __builtin_bit_cast(i32x4, At[m][k]), acc[ai][bj][m][n], 0, 0, 0); \
          else acc[ai][bj][m][n] = __builtin_amdgcn_mfma_f32_16x16x32_bf16(Bt[n][k], At[m][k], acc[ai][bj][m][n], 0, 0, 0); } __builtin_amdgcn_s_setprio(0); } while (0)
#define PG8_WAIT_V(n) asm volatile("s_waitcnt vmcnt(" #n ")" ::: "memory")
#define PG8_WAIT_L(n) asm volatile("s_waitcnt lgkmcnt(" #n ")" ::: "memory")
#define PG8_BAR __builtin_amdgcn_s_barrier()
#define PG8_SCHED __builtin_amdgcn_sched_barrier(0)
#define PG8_UA(u) ((const char*)g.A + (size_t)(u).pm * tstepA + (size_t)(u).pn * g.a_pn_off * 2)
#define PG8_UB(u) ((const char*)g.Bt + (size_t)(u).pn * g.b_pn_step * 2)
    Unit cur, nxt; int ui = 0;
    if (!S.next(0, cur)) return;
    typename Epi::acc_t acc[2][2][4][2];
#pragma unroll
    for (int a = 0; a < 2; ++a)
#pragma unroll
        for (int b = 0; b < 2; ++b)
#pragma unroll
            for (int m = 0; m < 4; ++m)
#pragma unroll
                for (int n = 0; n < 2; ++n) acc[a][b][m][n] = (typename Epi::acc_t){};
    bf16x8 At[4][2], B0[2][2], B1[2][2];
    const char* cA = PG8_UA(cur); const char* cB = PG8_UB(cur);
    S.a_ready(cur);
    if constexpr (SP2) {
        PG8_STAGE(PG8_SB(0, 0), cB, voffB); PG8_STAGE(PG8_SB(0, 1), cB + hstepB, voffB); PG8_STAGE(PG8_SA(0, 0), cA, voffA); PG8_STAGE(PG8_SA(0, 1), cA + hstepA, voffA);
        if (wr == 1) PG8_BAR;
        PG8_WAIT_V(2); PG8_BAR;
        PG8_STAGE(PG8_SB(1, 0), cB + kstep, voffB); PG8_STAGE(PG8_SA(1, 0), cA + kstep, voffA); PG8_STAGE(PG8_SB(1, 1), cB + hstepB + kstep, voffB);
        PG8_WAIT_V(6); PG8_BAR;
    } else {
        PG8_STAGE(PG8_SB(0, 0), cB, voffB); PG8_STAGE(PG8_SA(0, 0), cA, voffA); PG8_STAGE(PG8_SB(0, 1), cB + hstepB, voffB); PG8_STAGE(PG8_SA(0, 1), cA + hstepA, voffA);
        if (wr == 1) PG8_BAR;
        PG8_WAIT_V(4); PG8_BAR;
        PG8_STAGE(PG8_SB(1, 0), cB + kstep, voffB); PG8_STAGE(PG8_SA(1, 0), cA + kstep, voffA); PG8_STAGE(PG8_SB(1, 1), cB + hstepB + kstep, voffB);
        PG8_WAIT_V(6); PG8_BAR;
    }
    for (;;) {
        const bool has_next = S.next(ui + 1, nxt);
        const char* nA = has_next ? PG8_UA(nxt) : cA; const char* nB = has_next ? PG8_UB(nxt) : cB;
        for (int t = 0; t < nt; t += 2) {
            const bool last = (t == nt - 2);
            const char* a1 = cA + (size_t)(t + 1) * kstep;
            const char* a2 = last ? nA : cA + (size_t)(t + 2) * kstep; const char* b2 = last ? nB : cB + (size_t)(t + 2) * kstep;
            const char* a3 = a2 + kstep; const char* b3 = b2 + kstep;
            if (last && has_next) S.a_ready(nxt);
            if constexpr (SP2) {
            PG8_LDB(B0, 0, 0); PG8_LDB(B1, 0, 1); PG8_SCHED; PG8_LDA(At, 0, 0); PG8_STAGE(PG8_SA(1, 1), a1 + hstepA, voffA);
            PG8_WAIT_V(8); PG8_WAIT_L(0); PG8_BAR; PG8_MMA(0, 0, At, B0); PG8_MMA(0, 1, At, B1); PG8_BAR; PG8_SCHED;
            PG8_LDA(At, 0, 1); PG8_STAGE(PG8_SB(0, 0), b2, voffB); PG8_STAGE(PG8_SB(0, 1), b2 + hstepB, voffB); PG8_STAGE(PG8_SA(0, 0), a2, voffA);
            PG8_WAIT_V(8); PG8_WAIT_L(0); PG8_BAR; PG8_MMA(1, 0, At, B0); PG8_MMA(1, 1, At, B1); PG8_BAR; PG8_SCHED;
            PG8_LDB(B0, 1, 0); PG8_LDB(B1, 1, 1); PG8_SCHED; PG8_LDA(At, 1, 0); PG8_STAGE(PG8_SA(0, 1), a2 + hstepA, voffA);
            PG8_WAIT_V(8); PG8_WAIT_L(0); PG8_BAR; PG8_MMA(0, 0, At, B0); PG8_MMA(0, 1, At, B1); PG8_BAR; PG8_SCHED;
            PG8_LDA(At, 1, 1); PG8_STAGE(PG8_SB(1, 0), b3, voffB); PG8_STAGE(PG8_SB(1, 1), b3 + hstepB, voffB); PG8_STAGE(PG8_SA(1, 0), a3, voffA);
            PG8_WAIT_V(8); PG8_WAIT_L(0); PG8_BAR; PG8_MMA(1, 0, At, B0); PG8_MMA(1, 1, At, B1); PG8_BAR; PG8_SCHED;
            } else {
            PG8_LDB(B0, 0, 0); PG8_SCHED; PG8_LDA(At, 0, 0); PG8_STAGE(PG8_SA(1, 1), a1 + hstepA, voffA);
            PG8_WAIT_L(8); PG8_BAR; PG8_WAIT_L(0); PG8_MMA(0, 0, At, B0); PG8_BAR; PG8_SCHED;
            PG8_LDB(B1, 0, 1); PG8_STAGE(PG8_SB(0, 0), b2, voffB);
            PG8_BAR; PG8_WAIT_L(0); PG8_MMA(0, 1, At, B1); PG8_BAR;
            PG8_LDA(At, 0, 1); PG8_STAGE(PG8_SA(0, 0), a2, voffA);
            PG8_BAR; PG8_WAIT_L(0); PG8_MMA(1, 0, At, B0); PG8_BAR; PG8_SCHED;
            PG8_STAGE(PG8_SB(0, 1), b2 + hstepB, voffB);
            PG8_WAIT_V(6); PG8_BAR; PG8_MMA(1, 1, At, B1); PG8_BAR;
            PG8_LDB(B0, 1, 0); PG8_SCHED; PG8_LDA(At, 1, 0); PG8_STAGE(PG8_SA(0, 1), a2 + hstepA, voffA);
            PG8_WAIT_L(8); PG8_BAR; PG8_WAIT_L(0); PG8_MMA(0, 0, At, B0); PG8_BAR; PG8_SCHED;
            PG8_LDB(B1, 1, 1); PG8_STAGE(PG8_SB(1, 0), b3, voffB);
            PG8_BAR; PG8_WAIT_L(0); PG8_MMA(0, 1, At, B1); PG8_BAR;
            PG8_LDA(At, 1, 1); PG8_STAGE(PG8_SA(1, 0), a3, voffA);
            PG8_BAR; PG8_WAIT_L(0); PG8_MMA(1, 0, At, B0); PG8_BAR; PG8_SCHED;
            PG8_STAGE(PG8_SB(1, 1), b3 + hstepB, voffB);
            PG8_WAIT_V(6); PG8_BAR; PG8_MMA(1, 1, At, B1); PG8_BAR;
            }
        }
        if constexpr (ALIGN_EPI) { if (wr == 0) PG8_BAR; }
        if constexpr (!Epi::AFTER_DRAIN) { E(acc, cur, wr, wc, fr, fq); S.done(cur); }
        if (!has_next) break;
#pragma unroll
        for (int a = 0; a < 2; ++a)
#pragma unroll
            for (int b = 0; b < 2; ++b)
#pragma unroll
                for (int m = 0; m < 4; ++m)
#pragma unroll
                    for (int n = 0; n < 2; ++n) acc[a][b][m][n] = (typename Epi::acc_t){};
        cur = nxt; cA = nA; cB = nB; ++ui;
        if constexpr (ALIGN_EPI) { if (wr == 1) PG8_BAR; }
    }
    PG8_WAIT_V(0);
    if constexpr (!ALIGN_EPI) { if (wr == 0) PG8_BAR; }
    PG8_BAR;
#undef PG8_SA
#undef PG8_SB
#undef PG8_STAGE
#undef PG8_LDA
#undef PG8_LDB
#undef PG8_MMA
#undef PG8_WAIT_V
#undef PG8_WAIT_L
#undef PG8_BAR
#undef PG8_SCHED
#undef PG8_UA
#undef PG8_UB
}
}
namespace attn {
using bf16x8 = __attribute__((ext_vector_type(8))) short;
using s16x4  = __attribute__((ext_vector_type(4))) short;
using f32x16 = __attribute__((ext_vector_type(16))) float;
using f32x4  = __attribute__((ext_vector_type(4))) float;
using u32x4  = __attribute__((ext_vector_type(4))) unsigned;
constexpr int SEQ = 8192, LD = 1024, KVBLK = 64, QBLK = 32, NHEAD = 8, NQB = SEQ / 128;
constexpr float SC = 0.125f * 1.4426950408889634f;
constexpr float L2E = 1.4426950408889634f;
constexpr float THR = 8.f;
constexpr int SHM_V = 16384, SHM_K = 16384;
constexpr int OFF_V = 0, OFF_K = 2 * SHM_V, OFF_WS = OFF_K + 2 * SHM_K, OFF_TB = OFF_WS + 8 * 256 + 0, TB_N = 256;
constexpr int STG_LD = 132, STG_BYTES = 32 * STG_LD * 4;
constexpr int LDS_BYTES = OFF_TB + TB_N * 4;
static_assert(4 * STG_BYTES <= OFF_TB, "combine stage must not reach the bias table");
#define KSWZ(row, colB) ((row) * 256 + ((colB) ^ (((row) & 7) << 4)))
#define SBAR() __builtin_amdgcn_sched_barrier(0)
__device__ __forceinline__ int crow(int r, int hi) { return (r & 3) + 8 * (r >> 2) + 4 * hi; }
__device__ __forceinline__ unsigned cvtpk(float lo, float hi) { unsigned r; asm volatile("v_cvt_pk_bf16_f32 %0, %1, %2" : "=v"(r) : "v"(lo), "v"(hi)); return r; }

__device__ __forceinline__ int t5_bucket(int rel) {
  const int n = rel < 0 ? -rel : rel; int b;
  if (n < 8) b = n; else if (n < 12) b = 8; else if (n < 16) b = 9; else if (n < 23) b = 10; else if (n < 32) b = 11; else if (n < 46) b = 12; else if (n < 64) b = 13; else if (n < 91) b = 14; else b = 15;
  return b + (rel > 0 ? 16 : 0);
}

__device__ __forceinline__ void partialSM(f32x16& p0, f32x16& p1, float& m_reg, float& mn, float& alpha, int j, int c, float cb, const float* tq, int hi) {
  if (j >= c - 2) {
    if (j > c) {
#pragma unroll
      for (int r = 0; r < 16; ++r) { p0[r] = -1e30f; p1[r] = -1e30f; }
    } else {
      const float* t = tq + 64 * j;
#pragma unroll
      for (int r = 0; r < 16; ++r) { p0[r] = fmaf(p0[r], SC, t[crow(r, hi)]); p1[r] = fmaf(p1[r], SC, t[32 + crow(r, hi)]); }
    }
    float pmax = p0[0];
#pragma unroll
    for (int r = 1; r < 16; ++r) pmax = fmaxf(pmax, p0[r]);
#pragma unroll
    for (int r = 0; r < 16; ++r) pmax = fmaxf(pmax, p1[r]);
    { auto rr = __builtin_amdgcn_permlane32_swap(__float_as_uint(pmax), __float_as_uint(pmax), false, false); pmax = fmaxf(__uint_as_float(rr[0]), __uint_as_float(rr[1])); }
    if (__builtin_expect(__all(pmax - m_reg <= THR), 1)) { mn = m_reg; alpha = 1.f; }
    else { mn = fmaxf(m_reg, pmax); alpha = __builtin_amdgcn_exp2f(m_reg - mn); m_reg = mn; }
#pragma unroll
    for (int r = 0; r < 16; ++r) { p0[r] -= mn; p1[r] -= mn; }
  } else {
    float pmax = p0[0];
#pragma unroll
    for (int r = 1; r < 16; ++r) pmax = fmaxf(pmax, p0[r]);
#pragma unroll
    for (int r = 0; r < 16; ++r) pmax = fmaxf(pmax, p1[r]);
    { auto rr = __builtin_amdgcn_permlane32_swap(__float_as_uint(pmax), __float_as_uint(pmax), false, false); pmax = fmaxf(__uint_as_float(rr[0]), __uint_as_float(rr[1])); }
    pmax = fmaf(pmax, SC, cb);
    if (__builtin_expect(__all(pmax - m_reg <= THR), 1)) { mn = m_reg; alpha = 1.f; }
    else { mn = fmaxf(m_reg, pmax); alpha = __builtin_amdgcn_exp2f(m_reg - mn); m_reg = mn; }
    const float off = cb - mn;
#pragma unroll
    for (int r = 0; r < 16; ++r) { p0[r] = fmaf(p0[r], SC, off); p1[r] = fmaf(p1[r], SC, off); }
  }
#pragma unroll
  for (int r = 0; r < 16; ++r) p0[r] = __builtin_amdgcn_exp2f(p0[r]);
}
__device__ __forceinline__ void finishSM(f32x16& p0, f32x16& p1, float alpha, float& l_reg, bf16x8& pa0, bf16x8& pa1, bf16x8& pa2, bf16x8& pa3) {
#pragma unroll
  for (int r = 0; r < 16; ++r) p1[r] = __builtin_amdgcn_exp2f(p1[r]);
  float ps = 0;
#pragma unroll
  for (int r = 0; r < 16; ++r) ps += p0[r];
#pragma unroll
  for (int r = 0; r < 16; ++r) ps += p1[r];
  { auto rr = __builtin_amdgcn_permlane32_swap(__float_as_uint(ps), __float_as_uint(ps), false, false); ps = __uint_as_float(rr[0]) + __uint_as_float(rr[1]); }
  l_reg = l_reg * alpha + ps;
#define PK4(P, BASE, OUT) do { unsigned a0 = cvtpk(P[BASE + 0], P[BASE + 1]), a1 = cvtpk(P[BASE + 2], P[BASE + 3]);   \
    unsigned b0 = cvtpk(P[BASE + 4], P[BASE + 5]), b1 = cvtpk(P[BASE + 6], P[BASE + 7]);                              \
    auto r0 = __builtin_amdgcn_permlane32_swap(a0, b0, false, false); auto r1 = __builtin_amdgcn_permlane32_swap(a1, b1, false, false); \
    u32x4 w = {r0[0], r1[0], r0[1], r1[1]}; OUT = *reinterpret_cast<bf16x8*>(&w); } while (0)
  PK4(p0, 0, pa0); PK4(p0, 8, pa1); PK4(p1, 0, pa2); PK4(p1, 8, pa3);
#undef PK4
}
__device__ __forceinline__ void qkt(f32x16& p0, f32x16& p1, const char* Ks, const bf16x8* qr, int r32, int hi, int sm) {
  p0 = f32x16{}; p1 = f32x16{};
#pragma unroll
  for (int d0 = 0; d0 < 4; ++d0) { const int cb = (sm * 64 + d0 * 16 + hi * 8) * 2;
    const bf16x8 b0 = *reinterpret_cast<const bf16x8*>(Ks + KSWZ(r32, cb));
    const bf16x8 b1 = *reinterpret_cast<const bf16x8*>(Ks + KSWZ(32 + r32, cb));
    p0 = __builtin_amdgcn_mfma_f32_32x32x16_bf16(b0, qr[d0], p0, 0, 0, 0);
    p1 = __builtin_amdgcn_mfma_f32_32x32x16_bf16(b1, qr[d0], p1, 0, 0, 0); }
}
__device__ __forceinline__ int v_st(int k, int c) { const int kk = (k & ~0xC) | ((k & 4) << 1) | ((k & 8) >> 1); return ((kk >> 3) * 4 + (c >> 5)) * 512 + ((kk & 7) * 32 + (c & 31)) * 2; }
__device__ __forceinline__ int v_rd_base(int lane) { return ((lane & 3) << 3) | (((lane >> 2) & 3) << 6) | (((lane >> 4) & 1) << 5) | (((lane >> 5) & 1) << 8); }
constexpr int v_rd_off(int d0, int ks, int half) { return d0 * 512 + ks * 4096 + half * 2048; }
template <int OFF> __device__ __forceinline__ s16x4 tr_read(int vb) { s16x4 r; asm volatile("ds_read_b64_tr_b16 %0, %1 offset:%2" : "=&v"(r) : "v"(vb), "i"(OFF) : "memory"); return r; }
template <int D0> __device__ __forceinline__ void pv_one(f32x16& od, int vb, bf16x8 pa0, bf16x8 pa1, bf16x8 pa2, bf16x8 pa3) {
  const s16x4 l0 = tr_read<v_rd_off(D0, 0, 0)>(vb), h0 = tr_read<v_rd_off(D0, 0, 1)>(vb), l1 = tr_read<v_rd_off(D0, 1, 0)>(vb), h1 = tr_read<v_rd_off(D0, 1, 1)>(vb);
  const s16x4 l2 = tr_read<v_rd_off(D0, 2, 0)>(vb), h2 = tr_read<v_rd_off(D0, 2, 1)>(vb), l3 = tr_read<v_rd_off(D0, 3, 0)>(vb), h3 = tr_read<v_rd_off(D0, 3, 1)>(vb);
  asm volatile("s_waitcnt lgkmcnt(0)" ::: "memory"); SBAR();
#define PK(L, H) (bf16x8){L[0], L[1], L[2], L[3], H[0], H[1], H[2], H[3]}
  od = __builtin_amdgcn_mfma_f32_32x32x16_bf16(pa0, PK(l0, h0), od, 0, 0, 0);
  od = __builtin_amdgcn_mfma_f32_32x32x16_bf16(pa1, PK(l1, h1), od, 0, 0, 0);
  od = __builtin_amdgcn_mfma_f32_32x32x16_bf16(pa2, PK(l2, h2), od, 0, 0, 0);
  od = __builtin_amdgcn_mfma_f32_32x32x16_bf16(pa3, PK(l3, h3), od, 0, 0, 0);
#undef PK
}
__device__ __forceinline__ void pv_d0(f32x16* o, int vb, bf16x8 pa0, bf16x8 pa1, bf16x8 pa2, bf16x8 pa3) {
  pv_one<0>(o[0], vb, pa0, pa1, pa2, pa3); pv_one<1>(o[1], vb, pa0, pa1, pa2, pa3); pv_one<2>(o[2], vb, pa0, pa1, pa2, pa3); pv_one<3>(o[3], vb, pa0, pa1, pa2, pa3);
}

struct Params { const unsigned short* Q; const unsigned short* K; const unsigned short* V; unsigned char* O8; float* OS; const float* rel_bias; const float* subln_g; float lam; float inv_s, s; };

__device__ __forceinline__ void attn_unit(const Params& P, int b, int h, int qb, char* lds, int tid_in) {
  const int tid = tid_in, wid = __builtin_amdgcn_readfirstlane(tid >> 6), lane = tid & 63, r32 = lane & 31, hi = lane >> 5;
  const int sm = wid >> 2, wq = wid & 3;
  unsigned short* V_lds = (unsigned short*)(lds + OFF_V); unsigned short* K_lds = (unsigned short*)(lds + OFF_K);
  float* ws = (float*)(lds + OFF_WS) + wid * 64; float* li_l = ws; float* al_l = ws + 32;
  float* tb = (float*)(lds + OFF_TB);
  const long rowbase = (long)b * SEQ; const int q0 = qb * 128;
  const unsigned short* Kh = P.K + rowbase * LD + h * 128; const unsigned short* Vh = P.V + rowbase * LD + h * 128;
  if (tid < TB_N) tb[tid] = P.rel_bias[t5_bucket(tid - 191) * NHEAD + h] * L2E;
  const float cb = P.rel_bias[15 * NHEAD + h] * L2E;
  float m_reg = -1e30f, l_reg = 0; f32x16 o[4] = {}; bf16x8 qr[4];
  const int qpos = q0 + wq * QBLK + r32;
  const int c = (q0 + wq * QBLK) >> 6;
  const float* tq = tb + 191 - qpos;
  const unsigned short* Qw = P.Q + (rowbase + qpos) * LD + h * 128 + sm * 64 + hi * 8;
#pragma unroll
  for (int d0 = 0; d0 < 4; ++d0) qr[d0] = *reinterpret_cast<const bf16x8*>(Qw + d0 * 16);
  const int sr = tid >> 4, sc = (tid & 15) * 8, vst0 = v_st(sr, sc), vst1 = v_st(32 + sr, sc);
  const int vb0 = (int)(uintptr_t)V_lds + v_rd_base(lane);
  struct { bf16x8 vs0, vs1, ks0, ks1; } sr_[2];
#define SLOAD(i, k0) do { sr_[i].vs0 = *reinterpret_cast<const bf16x8*>(&Vh[(long)((k0) + sr) * LD + sc]); sr_[i].vs1 = *reinterpret_cast<const bf16x8*>(&Vh[(long)((k0) + 32 + sr) * LD + sc]); \
    sr_[i].ks0 = *reinterpret_cast<const bf16x8*>(&Kh[(long)((k0) + sr) * LD + sc]); sr_[i].ks1 = *reinterpret_cast<const bf16x8*>(&Kh[(long)((k0) + 32 + sr) * LD + sc]); } while (0)
#define SWRITE(bb, i) do { *(bf16x8*)((char*)V_lds + (bb) * SHM_V + vst0) = sr_[i].vs0;          \
    *(bf16x8*)((char*)V_lds + (bb) * SHM_V + vst1) = sr_[i].vs1; const int kc = sc * 2;               \
    *(bf16x8*)((char*)K_lds + (bb) * SHM_K + KSWZ(sr, kc)) = sr_[i].ks0;                       \
    *(bf16x8*)((char*)K_lds + (bb) * SHM_K + KSWZ(32 + sr, kc)) = sr_[i].ks1; } while (0)
#define SWAIT() asm volatile("s_waitcnt vmcnt(4)" ::: "memory")
#define RESC(a) do { if (__any((a) < 1.f)) { if (hi == 0) al_l[r32] = (a); asm volatile("s_waitcnt lgkmcnt(0)" ::: "memory"); \
    _Pragma("unroll") for (int d = 0; d < 4; ++d) _Pragma("unroll") for (int r = 0; r < 16; ++r) o[d][r] *= al_l[crow(r, hi)]; } } while (0)
  f32x16 pA0, pA1, pB0, pB1; float mnA, mnB, alA, alB; bf16x8 pa0, pa1, pa2, pa3; const int NT = 2 * qb + 2;
  constexpr int SE = 0, SO = 1;
  SLOAD(SE, 0); asm volatile("s_waitcnt vmcnt(0)" ::: "memory"); SWRITE(0, SE); __syncthreads();
  qkt(pA0, pA1, (const char*)K_lds, qr, r32, hi, sm); partialSM(pA0, pA1, m_reg, mnA, alA, 0, c, cb, tq, hi);
  SLOAD(SO, KVBLK); if (2 < NT) SLOAD(SE, 2 * KVBLK);
  SWAIT(); SWRITE(1, SO); __syncthreads();
  for (int j = 1; j + 1 < NT; j += 2) {
    SBAR(); qkt(pB0, pB1, (const char*)K_lds + SHM_K, qr, r32, hi, sm);
    finishSM(pA0, pA1, alA, l_reg, pa0, pa1, pa2, pa3); SBAR();
    SLOAD(SO, (j + 2) * KVBLK); SBAR();
    pv_d0(o, vb0, pa0, pa1, pa2, pa3); partialSM(pB0, pB1, m_reg, mnB, alB, j, c, cb, tq, hi);
    __syncthreads(); SWAIT(); SWRITE(0, SE);
    RESC(alB); __syncthreads();
    SBAR(); qkt(pA0, pA1, (const char*)K_lds, qr, r32, hi, sm);
    finishSM(pB0, pB1, alB, l_reg, pa0, pa1, pa2, pa3); SBAR();
    if (j + 3 < NT) SLOAD(SE, (j + 3) * KVBLK); SBAR();
    pv_d0(o, vb0 + SHM_V, pa0, pa1, pa2, pa3); partialSM(pA0, pA1, m_reg, mnA, alA, j + 1, c, cb, tq, hi);
    __syncthreads(); SWAIT(); SWRITE(1, SO);
    RESC(alA); __syncthreads();
  }
  SBAR(); qkt(pB0, pB1, (const char*)K_lds + SHM_K, qr, r32, hi, sm);
  finishSM(pA0, pA1, alA, l_reg, pa0, pa1, pa2, pa3); SBAR();
  pv_d0(o, vb0, pa0, pa1, pa2, pa3); partialSM(pB0, pB1, m_reg, mnB, alB, NT - 1, c, cb, tq, hi);
  __syncthreads(); RESC(alB);
  finishSM(pB0, pB1, alB, l_reg, pa0, pa1, pa2, pa3); SBAR();
  pv_d0(o, vb0 + SHM_V, pa0, pa1, pa2, pa3);
  if (hi == 0) li_l[r32] = l_reg; asm volatile("s_waitcnt lgkmcnt(0)" ::: "memory");
  float rli[16];
  const float fac = sm ? P.lam : 1.f;
#pragma unroll
  for (int r = 0; r < 16; ++r) rli[r] = __builtin_amdgcn_rcpf(li_l[crow(r, hi)]) * fac;
  __syncthreads();
  float* stg = (float*)lds + wq * (32 * STG_LD);
  if (sm == 1) {
#pragma unroll
    for (int d0 = 0; d0 < 4; ++d0)
#pragma unroll
      for (int r = 0; r < 16; ++r) stg[crow(r, hi) * STG_LD + d0 * 32 + r32] = o[d0][r] * rli[r];
  }
  __syncthreads();
  if (sm == 0) {
#pragma unroll
    for (int d0 = 0; d0 < 4; ++d0)
#pragma unroll
      for (int r = 0; r < 16; ++r) { float* p = &stg[crow(r, hi) * STG_LD + d0 * 32 + r32]; *p = o[d0][r] * rli[r] - *p; }
    asm volatile("s_waitcnt lgkmcnt(0)" ::: "memory");
    const float* rp = stg + r32 * STG_LD + hi * 64;
    f32x4 v[16]; float ss = 0.f;
#pragma unroll
    for (int i = 0; i < 16; ++i) { v[i] = *(const f32x4*)(rp + 4 * i); ss += (v[i].x * v[i].x + v[i].y * v[i].y) + (v[i].z * v[i].z + v[i].w * v[i].w); }
    { auto rr = __builtin_amdgcn_permlane32_swap(__float_as_uint(ss), __float_as_uint(ss), false, false); ss = __uint_as_float(rr[0]) + __uint_as_float(rr[1]); }
    const float rs = 0.8f / sqrtf(ss * (1.f / 128.f) + 1e-5f);
    unsigned char* Ow = P.O8 + (rowbase + q0 + wq * QBLK + r32) * LD + h * 128 + hi * 64;
    const float* gp = P.subln_g + hi * 64; const float rq = rs * P.inv_s;
#pragma unroll
    for (int i = 0; i < 4; ++i) { u32x4 w;
#pragma unroll
      for (int q = 0; q < 4; ++q) { const f32x4 g = *(const f32x4*)(gp + 16 * i + 4 * q); const f32x4 a = v[4 * i + q] * rq * g;
        w[q] = ((unsigned)((int)__builtin_rintf(a.x)) & 255u) | (((unsigned)((int)__builtin_rintf(a.y)) & 255u) << 8) | (((unsigned)((int)__builtin_rintf(a.z)) & 255u) << 16) | (((unsigned)((int)__builtin_rintf(a.w)) & 255u) << 24); }
      *(u32x4*)(Ow + 16 * i) = w; }
    if (h == 0 && hi == 0) P.OS[rowbase + q0 + wq * QBLK + r32] = P.s;
  }
  __syncthreads();
#undef SLOAD
#undef SWRITE
#undef SWAIT
#undef RESC
}

constexpr int SLOT2 = 16384, L2_K = 0, L2_V = 3 * SLOT2, L2_WS = 6 * SLOT2, L2_TB = L2_WS + 8 * 256, LDS_BYTES2 = L2_TB + TB_N * 4;
static_assert(4 * STG_BYTES <= L2_WS && LDS_BYTES2 <= 131072, "combine stage must stay below the per-wave words; the body's LDS must fit the ring");
#define PIN(x) asm volatile("" : "+v"(x))
#define MFMA32(a, b, c) __builtin_amdgcn_mfma_f32_32x32x16_bf16(a, b, c, 0, 0, 0)
#define WAIT_BAR(N) asm volatile("s_waitcnt vmcnt(" #N ") lgkmcnt(0)\n\ts_barrier" ::: "memory")
__device__ __forceinline__ void glds16(unsigned voff, const void* sbase, unsigned lds_base) {
    unsigned sv; asm volatile("s_mov_b32 %0, m0\n\ts_mov_b32 m0, %2\n\ts_nop 0\n\tglobal_load_lds_dwordx4 %1, %3\n\ts_mov_b32 m0, %0" : "=&s"(sv) : "v"(voff), "s"(lds_base), "s"(sbase) : "memory"); }
typedef __attribute__((address_space(3))) const char* lds_cptr;
typedef short v4i16_t __attribute__((ext_vector_type(4)));
__device__ __forceinline__ void kload2(bf16x8* kf, lds_cptr kp, int d0) { kf[2 * d0] = *(const __attribute__((address_space(3))) bf16x8*)(kp + d0 * 2048); kf[2 * d0 + 1] = *(const __attribute__((address_space(3))) bf16x8*)(kp + d0 * 2048 + 512); }
__device__ __forceinline__ s16x4 vtr(lds_cptr p) { return __builtin_bit_cast(s16x4, __builtin_amdgcn_ds_read_tr16_b64_v4i16((__attribute__((address_space(3))) v4i16_t*)p)); }
#define MX3(a, b, c) __builtin_fmaxf(__builtin_fmaxf((a), (b)), (c))
__device__ __forceinline__ float rowmax(const f32x16& p0, const f32x16& p1) {
    float a = MX3(p0[0], p0[1], p1[0]), b = MX3(p0[2], p0[3], p1[1]); a = MX3(a, p1[2], p1[3]);
#pragma unroll
    for (int r = 4; r < 16; r += 4) { a = MX3(a, p0[r], p0[r + 1]); b = MX3(b, p0[r + 2], p0[r + 3]); a = MX3(a, p1[r], p1[r + 1]); b = MX3(b, p1[r + 2], p1[r + 3]); }
    float m = __builtin_fmaxf(a, b); auto rr = __builtin_amdgcn_permlane32_swap(__float_as_uint(m), __float_as_uint(m), false, false);
    return __builtin_fmaxf(__uint_as_float(rr[0]), __uint_as_float(rr[1])); }
template <bool REL> __device__ __forceinline__ void band_xform(f32x16& p0, f32x16& p1, int j, int c, float cb, const __attribute__((address_space(3))) float* tq, int hi) {
  if (j > c) {
#pragma unroll
    for (int r = 0; r < 16; ++r) { p0[r] = -INFINITY; p1[r] = -INFINITY; }
  } else if (j >= c - 2) { const __attribute__((address_space(3))) float* t = tq + 64 * j; const float sub = REL ? cb : 0.f;
#pragma unroll
    for (int r = 0; r < 16; ++r) { p0[r] += t[crow(r, hi)] - sub; p1[r] += t[32 + crow(r, hi)] - sub; }
  } else if (!REL) {
#pragma unroll
    for (int r = 0; r < 16; ++r) { p0[r] += cb; p1[r] += cb; }
  }
}
__device__ __forceinline__ void attn_unit2(const Params& P, int b, int h, int qb, char* lds, int tid_in) {
  const int tid = tid_in, wid = __builtin_amdgcn_readfirstlane(tid >> 6), lane = tid & 63, r32 = lane & 31, hi = lane >> 5;
  const int sm = wid >> 2, wq = wid & 3;
  const long rowbase = (long)b * SEQ; const int q0 = qb * 128, NT = 2 * qb + 2;
  const int qpos = q0 + wq * QBLK + r32, c = (q0 + wq * QBLK) >> 6;
  float* wsf = (float*)(lds + L2_WS) + wid * 64; float* tb = (float*)(lds + L2_TB);
  if (tid < TB_N) tb[tid] = P.rel_bias[t5_bucket(tid - 191) * NHEAD + h] * L2E;
  const float cb = P.rel_bias[15 * NHEAD + h] * L2E;
  const __attribute__((address_space(3))) float* tq = (const __attribute__((address_space(3))) float*)tb + 191 - qpos;
  const unsigned short* Qw = P.Q + (rowbase + qpos) * LD + h * 128 + sm * 64 + hi * 8;
  const unsigned lds0 = (unsigned)(uintptr_t)lds;
  const char* kbase = (const char*)(P.K + rowbase * LD + h * 128 + wid * 16);
  const char* vbase = (const char*)(P.V + rowbase * LD + h * 128 + (long)(32 * (wid & 1)) * LD + (wid >> 1) * 32);
  const unsigned koff = (unsigned)lane * (LD * 2), voff = (unsigned)(lane >> 2) * (LD * 2) + (lane & 3) * 16;
  const unsigned kdst = lds0 + L2_K + wid * 2048, vdst = lds0 + L2_V + wid * 2048;
#define RFL(x) ((unsigned)__builtin_amdgcn_readfirstlane((int)(x)))
#define DMA_K(t, slot) do { const char* g_ = kbase + (long)(t) * (KVBLK * LD * 2); glds16(koff, g_, RFL(kdst + (slot))); glds16(koff, g_ + 16, RFL(kdst + (slot) + 1024)); } while (0)
#define DMA_V(t, slot) do { const char* g_ = vbase + (long)(t) * (KVBLK * LD * 2); glds16(voff, g_, RFL(vdst + (slot))); glds16(voff, g_ + 16 * LD * 2, RFL(vdst + (slot) + 1024)); } while (0)
  const lds_cptr vp0 = (lds_cptr)lds + L2_V + ((lane >> 4) & 1) * 32 + (lane & 3) * 8 + (4 * hi + ((lane & 15) >> 2)) * 64;
  const lds_cptr kp0 = (lds_cptr)lds + L2_K + (8 * sm + hi) * 1024 + r32 * 16;
  DMA_K(0, 0); DMA_V(0, 0); DMA_K(1, SLOT2);
  bf16x8 qr[4];
#pragma unroll
  for (int d0 = 0; d0 < 4; ++d0) qr[d0] = *reinterpret_cast<const bf16x8*>(Qw + d0 * 16);
  float mhat = 0.f, l_reg = 0.f; f32x16 o[4] = {}; const f32x16 zero16 = {};
  bool resc = false;
  f32x16 pA0, pA1, pB0, pB1; bf16x8 kf[8]; s16x4 vlo[4], vhi[4]; u32x4 pw0, pw1, pw2, pw3;
  int sl_prev = 0, sl_cur = 0, sl_next = SLOT2;
#define ROT() do { sl_prev = sl_cur; sl_cur = sl_next; sl_next = (sl_next == 2 * SLOT2) ? 0 : sl_next + SLOT2; } while (0)
#define RESC2() do { if (resc) { _Pragma("unroll") for (int d_ = 0; d_ < 4; ++d_) _Pragma("unroll") for (int r = 0; r < 16; ++r) o[d_][r] *= wsf[crow(r, hi)]; } } while (0)
  DMA_K(2, 2 * SLOT2);
  WAIT_BAR(6);
#pragma unroll
  for (int d0 = 0; d0 < 4; ++d0) kload2(kf, kp0, d0);
  pA0 = MFMA32(kf[0], qr[0], zero16); pA1 = MFMA32(kf[1], qr[0], zero16); pA0 = MFMA32(kf[2], qr[1], pA0); pA1 = MFMA32(kf[3], qr[1], pA1);
  pA0 = MFMA32(kf[4], qr[2], pA0); pA1 = MFMA32(kf[5], qr[2], pA1); pA0 = MFMA32(kf[6], qr[3], pA0); pA1 = MFMA32(kf[7], qr[3], pA1);
  band_xform<false>(pA0, pA1, 0, c, cb, tq, hi);
  { mhat = rowmax(pA0, pA1); const float nmh = -mhat;
#pragma unroll
    for (int r = 0; r < 16; ++r) { pA0[r] = __builtin_amdgcn_exp2f(pA0[r] + nmh); pA1[r] = __builtin_amdgcn_exp2f(pA1[r] + nmh); } }
  f32x16 negm;
#pragma unroll
  for (int r = 0; r < 16; ++r) negm[r] = cb - mhat;
  PIN(negm);
  WAIT_BAR(0);
  DMA_K(3, 0); DMA_V(1, SLOT2); ROT();
#pragma unroll
  for (int d0 = 0; d0 < 4; ++d0) kload2(kf, kp0 + sl_cur, d0);
  if (NT == 2) { WAIT_BAR(0); } else { WAIT_BAR(4); }
#define PKW(P_, i) cvtpk(P_[i], P_[i + 1])
#define PAF(k) __builtin_bit_cast(bf16x8, pw##k)
#define VFR(i) (bf16x8){vlo[i][0], vlo[i][1], vlo[i][2], vlo[i][3], vhi[i][0], vhi[i][1], vhi[i][2], vhi[i][3]}
#define VRDS(slot, qd, ks) do { vlo[slot] = vtr(vp_ + ((qd) * 4096 + (ks) * 1024)); vhi[slot] = vtr(vp_ + ((qd) * 4096 + (ks) * 1024 + 512)); } while (0)
#define KRD(G, d0) do { if (G) { kload2(kf, kp0 + sl_next, d0); SBAR(); } } while (0)
#define GAPA(MF, a0, a1, a2, a3, W0, W1, PW) do { MF; sacc += a0; sacc += a1; sacc += a2; sacc += a3; W0; W1; PIN(PW); PIN(sacc); SBAR(); } while (0)
#define EX(BAND_, v) __builtin_amdgcn_exp2f(v)
#define GAPB(BAND_, MF, X, i) do { MF; X[i] = EX(BAND_, X[i]); X[i + 1] = EX(BAND_, X[i + 1]); PIN(X); SBAR(); } while (0)
#define STEP(C0, C1, P0, P1, t, BAND_, GK, GV, GL) do { SBAR(); \
    const lds_cptr vp_ = vp0 + sl_prev; \
    float sacc = P0[0] + P0[1]; \
                          GAPA(C0 = MFMA32(kf[0], qr[0], negm), P0[2], P0[3], P0[4], P0[5],     pw0[0] = PKW(P0, 0),  pw0[1] = PKW(P0, 2),  pw0); \
                          GAPA(C1 = MFMA32(kf[1], qr[0], negm), P0[6], P0[7], P0[8], P0[9],     pw0[2] = PKW(P0, 4),  pw0[3] = PKW(P0, 6),  pw0); \
                          GAPA(C0 = MFMA32(kf[2], qr[1], C0),    P0[10], P0[11], P0[12], P0[13], pw1[0] = PKW(P0, 8),  pw1[1] = PKW(P0, 10), pw1); \
                          GAPA(C1 = MFMA32(kf[3], qr[1], C1),    P0[14], P0[15], P1[0], P1[1],   pw1[2] = PKW(P0, 12), pw1[3] = PKW(P0, 14), pw1); \
    VRDS(0, 0, 0); SBAR(); GAPA(C0 = MFMA32(kf[4], qr[2], C0),    P1[2], P1[3], P1[4], P1[5],     pw2[0] = PKW(P1, 0),  pw2[1] = PKW(P1, 2),  pw2); \
    VRDS(1, 1, 0); SBAR(); GAPA(C1 = MFMA32(kf[5], qr[2], C1),    P1[6], P1[7], P1[8], P1[9],     pw2[2] = PKW(P1, 4),  pw2[3] = PKW(P1, 6),  pw2); \
    VRDS(2, 2, 0); SBAR(); GAPA(C0 = MFMA32(kf[6], qr[3], C0),    P1[10], P1[11], P1[12], P1[13], pw3[0] = PKW(P1, 8),  pw3[1] = PKW(P1, 10), pw3); \
    VRDS(3, 3, 0); SBAR(); GAPA(C1 = MFMA32(kf[7], qr[3], C1),    P1[14], P1[15], 0.f, 0.f,       pw3[2] = PKW(P1, 12), pw3[3] = PKW(P1, 14), pw3); \
    l_reg += sacc; \
    if (GK) DMA_K((t) + 3, sl_cur); if (GV) DMA_V((t) + 1, sl_next); \
    if (BAND_) band_xform<true>(C0, C1, (t), c, cb, tq, hi); \
    { const float rm = rowmax(C0, C1); resc = false;                                                             \
      if (__builtin_expect(__any(rm > THR), 0)) { const float dl = __builtin_fmaxf(rm, 0.f); mhat += dl;            \
          _Pragma("unroll") for (int r = 0; r < 16; ++r) { C0[r] -= dl; C1[r] -= dl; } \
          _Pragma("unroll") for (int r = 0; r < 16; ++r) negm[r] = cb - mhat; PIN(negm); \
          const float f = __builtin_amdgcn_exp2f(-dl); l_reg *= f; if (hi == 0) wsf[r32] = f; resc = true; } } \
    SBAR(); \
      \
    GAPB(BAND_, o[0] = MFMA32(PAF(0), VFR(0), o[0]), C0, 0);  VRDS(0, 0, 1); SBAR(); \
    GAPB(BAND_, o[1] = MFMA32(PAF(0), VFR(1), o[1]), C0, 2);  VRDS(1, 1, 1); SBAR(); \
    GAPB(BAND_, o[2] = MFMA32(PAF(0), VFR(2), o[2]), C0, 4);  VRDS(2, 2, 1); SBAR(); \
    GAPB(BAND_, o[3] = MFMA32(PAF(0), VFR(3), o[3]), C0, 6);  VRDS(3, 3, 1); SBAR(); \
    GAPB(BAND_, o[0] = MFMA32(PAF(1), VFR(0), o[0]), C0, 8);  VRDS(0, 0, 2); SBAR(); \
    GAPB(BAND_, o[1] = MFMA32(PAF(1), VFR(1), o[1]), C0, 10); VRDS(1, 1, 2); SBAR(); \
    GAPB(BAND_, o[2] = MFMA32(PAF(1), VFR(2), o[2]), C0, 12); VRDS(2, 2, 2); SBAR(); \
    GAPB(BAND_, o[3] = MFMA32(PAF(1), VFR(3), o[3]), C0, 14); VRDS(3, 3, 2); SBAR(); \
    GAPB(BAND_, o[0] = MFMA32(PAF(2), VFR(0), o[0]), C1, 0);  VRDS(0, 0, 3); SBAR(); \
    GAPB(BAND_, o[1] = MFMA32(PAF(2), VFR(1), o[1]), C1, 2);  VRDS(1, 1, 3); SBAR(); \
    GAPB(BAND_, o[2] = MFMA32(PAF(2), VFR(2), o[2]), C1, 4);  VRDS(2, 2, 3); SBAR(); \
    GAPB(BAND_, o[3] = MFMA32(PAF(2), VFR(3), o[3]), C1, 6);  VRDS(3, 3, 3); SBAR(); \
    KRD(GL, 0); GAPB(BAND_, o[0] = MFMA32(PAF(3), VFR(0), o[0]), C1, 8); \
    KRD(GL, 1); GAPB(BAND_, o[1] = MFMA32(PAF(3), VFR(1), o[1]), C1, 10); \
    KRD(GL, 2); GAPB(BAND_, o[2] = MFMA32(PAF(3), VFR(2), o[2]), C1, 12); \
    KRD(GL, 3); GAPB(BAND_, o[3] = MFMA32(PAF(3), VFR(3), o[3]), C1, 14); \
    } while (0)
  int t = 1;
  for (; t + 5 < NT; t += 2) {
    STEP(pB0, pB1, pA0, pA1, t, false, true, true, true);     WAIT_BAR(4); RESC2(); ROT();
    STEP(pA0, pA1, pB0, pB1, t + 1, false, true, true, true); WAIT_BAR(4); RESC2(); ROT();
  }
#define ENDW(tt) do { if ((tt) + 3 < NT) { WAIT_BAR(4); } else if ((tt) + 2 < NT) { WAIT_BAR(2); } else { WAIT_BAR(0); } } while (0)
  for (; t + 1 < NT; t += 2) {
    STEP(pB0, pB1, pA0, pA1, t, true, (t + 3 < NT), (t + 1 < NT), (t + 1 < NT));         ENDW(t);     RESC2(); ROT();
    STEP(pA0, pA1, pB0, pB1, t + 1, true, (t + 4 < NT), (t + 2 < NT), (t + 2 < NT));     ENDW(t + 1); RESC2(); ROT();
  }
  STEP(pB0, pB1, pA0, pA1, NT - 1, true, false, false, false); RESC2();
  { float sacc = pB0[0] + pB0[1];
#pragma unroll
    for (int r = 2; r < 16; ++r) sacc += pB0[r];
#pragma unroll
    for (int r = 0; r < 16; ++r) sacc += pB1[r];
    l_reg += sacc;
    pw0 = (u32x4){PKW(pB0, 0), PKW(pB0, 2), PKW(pB0, 4), PKW(pB0, 6)}; pw1 = (u32x4){PKW(pB0, 8), PKW(pB0, 10), PKW(pB0, 12), PKW(pB0, 14)};
    pw2 = (u32x4){PKW(pB1, 0), PKW(pB1, 2), PKW(pB1, 4), PKW(pB1, 6)}; pw3 = (u32x4){PKW(pB1, 8), PKW(pB1, 10), PKW(pB1, 12), PKW(pB1, 14)};
    const lds_cptr vp_ = vp0 + sl_cur;
#pragma unroll
    for (int ks = 0; ks < 4; ++ks) {
      VRDS(0, 0, ks); VRDS(1, 1, ks); VRDS(2, 2, ks); VRDS(3, 3, ks);
      const bf16x8 pa = ks == 0 ? PAF(0) : ks == 1 ? PAF(1) : ks == 2 ? PAF(2) : PAF(3);
      o[0] = MFMA32(pa, VFR(0), o[0]); o[1] = MFMA32(pa, VFR(1), o[1]); o[2] = MFMA32(pa, VFR(2), o[2]); o[3] = MFMA32(pa, VFR(3), o[3]); } }
  { auto rr = __builtin_amdgcn_permlane32_swap(__float_as_uint(l_reg), __float_as_uint(l_reg), false, false); l_reg = __uint_as_float(rr[0]) + __uint_as_float(rr[1]); }
  float* li_l = wsf + 32;
  if (hi == 0) li_l[r32] = l_reg; asm volatile("s_waitcnt lgkmcnt(0)" ::: "memory");
  float rli[16];
  const float fac = sm ? P.lam : 1.f;
#pragma unroll
  for (int r = 0; r < 16; ++r) rli[r] = __builtin_amdgcn_rcpf(li_l[crow(r, hi)]) * fac;
  WAIT_BAR(0);
  float* stg = (float*)lds + wq * (32 * STG_LD);
  if (sm == 1) {
#pragma unroll
    for (int d0 = 0; d0 < 4; ++d0)
#pragma unroll
      for (int r = 0; r < 16; ++r) stg[crow(r, hi) * STG_LD + d0 * 32 + r32] = o[d0][r] * rli[r];
  }
  __syncthreads();
  if (sm == 0) {
#pragma unroll
    for (int d0 = 0; d0 < 4; ++d0)
#pragma unroll
      for (int r = 0; r < 16; ++r) { float* p = &stg[crow(r, hi) * STG_LD + d0 * 32 + r32]; *p = o[d0][r] * rli[r] - *p; }
    asm volatile("s_waitcnt lgkmcnt(0)" ::: "memory");
    const float* rp = stg + r32 * STG_LD + hi * 64;
    f32x4 v[16]; float ss = 0.f;
#pragma unroll
    for (int i = 0; i < 16; ++i) { v[i] = *(const f32x4*)(rp + 4 * i); ss += (v[i].x * v[i].x + v[i].y * v[i].y) + (v[i].z * v[i].z + v[i].w * v[i].w); }
    { auto rr = __builtin_amdgcn_permlane32_swap(__float_as_uint(ss), __float_as_uint(ss), false, false); ss = __uint_as_float(rr[0]) + __uint_as_float(rr[1]); }
    const float rs = 0.8f / sqrtf(ss * (1.f / 128.f) + 1e-5f);
    unsigned char* Ow = P.O8 + (rowbase + q0 + wq * QBLK + r32) * LD + h * 128 + hi * 64;
    const float* gp = P.subln_g + hi * 64; const float rq = rs * P.inv_s;
#pragma unroll
    for (int i = 0; i < 4; ++i) { u32x4 w;
#pragma unroll
      for (int q = 0; q < 4; ++q) { const f32x4 g = *(const f32x4*)(gp + 16 * i + 4 * q); const f32x4 a = v[4 * i + q] * rq * g;
        w[q] = ((unsigned)((int)__builtin_rintf(a.x)) & 255u) | (((unsigned)((int)__builtin_rintf(a.y)) & 255u) << 8) | (((unsigned)((int)__builtin_rintf(a.z)) & 255u) << 16) | (((unsigned)((int)__builtin_rintf(a.w)) & 255u) << 24); }
      *(u32x4*)(Ow + 16 * i) = w; }
    if (h == 0 && hi == 0) { float sv; asm volatile("v_mov_b32 %0, %1" : "=v"(sv) : "s"(P.s)); P.OS[rowbase + q0 + wq * QBLK + r32] = sv; }
  }
  __syncthreads();
#undef RFL
#undef DMA_K
#undef DMA_V
#undef ROT
#undef RESC2
#undef PKW
#undef PAF
#undef VFR
#undef VRDS
#undef KRD
#undef GAPA
#undef EX
#undef GAPB
#undef STEP
#undef ENDW
}
#undef SBAR
}
constexpr int NWAVES = 8;
constexpr int BATCH = 4, SEQ = 8192, DM = 2048, T = BATCH * SEQ;
constexpr int IN_COLS = 8192, PW_ = 1024, NEXP = 16384, PLE = 256;
constexpr float LN_EPS = 1e-5f;
constexpr float ALPHA = 1.189207115002721f;
constexpr int N_PHASES = 14;
constexpr int N_LAUNCHES = MK_N_LAUNCHES;
static_assert(N_LAUNCHES == 1, "one launch only (the prologue has an internal grid barrier)");

constexpr size_t MiB = 1u << 20;
constexpr size_t WS_CTL = 0, CTL_ZERO_BYTES = 64 * 1024;
constexpr size_t WS_WBP = 2 * MiB, WS_WBA = 6 * MiB, WS_WOUT = 10 * MiB, WS_WQG = 18 * MiB, WS_PLEW = 34 * MiB, WS_POOLW = 35 * MiB;
constexpr size_t WS_WIN = 36 * MiB, WS_U = 68 * MiB, WS_V = 92 * MiB, WS_X6 = 116 * MiB;
constexpr size_t WS_XN = 196 * MiB, WS_XN8 = WS_XN, WS_YP8 = WS_XN + 64 * MiB;
constexpr size_t WS_PB = 324 * MiB;
constexpr size_t WS_XP = 340 * MiB, WS_Q = 404 * MiB, WS_YP = 532 * MiB;
constexpr size_t WS_K = 596 * MiB, WS_VV = 660 * MiB;
constexpr size_t WS_G0 = 724 * MiB, WS_G1 = 852 * MiB;
constexpr size_t WS_END = 980 * MiB;
constexpr size_t WS_YA = WS_XP  , WS_MERGED = WS_K  , WS_MERGED2 = WS_K  , WS_Z1 = WS_Q  , WS_X1 = WS_G0, WS_PWB = WS_G1, WS_QP = WS_XN, WS_ZE = WS_K;
constexpr size_t WS_WFOLD = WS_YP  ;
constexpr size_t WS_IDS = WS_YP, WS_GATES = WS_YP + 16 * MiB, WS_IDS16 = WS_YP + 32 * MiB  , WS_AW16 = WS_YP + 40 * MiB  , WS_IDT = WS_YP + 48 * MiB  ;
constexpr size_t WS_WIN8 = WS_WIN  , WS_SXN = WS_WIN + 16 * MiB  , WS_SX1 = WS_WIN + 17 * MiB  , WS_WG8 = WS_WQG + 8 * MiB  ;
constexpr size_t WS_MIX = WS_G1 + 64 * MiB  , WS_X18 = WS_XP  ;
constexpr size_t WS_YA8 = WS_G0 + 64 * MiB  , WS_M28 = WS_XP  ;
constexpr size_t WS_SYP = WS_WIN + 18 * MiB, WS_SYA = WS_WIN + 19 * MiB, WS_SM2 = WS_WIN + 20 * MiB;
constexpr int CW_WMAX_IN = 8192, CW_WMAX_G = 8256, CW_WMAX_BP = 8320, CW_WMAX_BA = 8384, CW_WMAX_O = 8448, CW_WMAX_Q = 8512, CW_WMAX_F = 8576;
constexpr size_t WS_HP = WS_XN  , WS_AW = WS_XP  , WS_Z = WS_Q  ;
constexpr int CW_TMO = 0, CW_CODE = 1, CW_BAR = 4096;

constexpr int RING_OFF = 0, RING_BYTES = 131072;
constexpr int LDSCTL_OFF = RING_BYTES, MISC_OFF = LDSCTL_OFF + 320;
constexpr int LDS_BYTES = 147456;
static_assert(MISC_OFF + 128 <= LDS_BYTES && attn::LDS_BYTES <= RING_BYTES, "LDS map");

#define GAS __attribute__((address_space(1)))
#define LAS __attribute__((address_space(3)))
typedef unsigned short bf16;
typedef unsigned v4u __attribute__((ext_vector_type(4)));
typedef float f32x4 __attribute__((ext_vector_type(4)));
typedef float f32x16 __attribute__((ext_vector_type(16)));
typedef short bf16x8 __attribute__((ext_vector_type(8)));
typedef __bf16 bf16x2_t __attribute__((ext_vector_type(2)));
typedef GAS unsigned gu32;
#define RLX_AGENT __ATOMIC_RELAXED, __HIP_MEMORY_SCOPE_AGENT
#define LDS_WAIT() asm volatile("s_waitcnt lgkmcnt(0)" ::: "memory")
#define VM_WAIT() asm volatile("s_waitcnt vmcnt(0)" ::: "memory")
__device__ __forceinline__ unsigned f2bf(float f) { unsigned u = __builtin_bit_cast(unsigned, f); return (u + 0x7fffu + ((u >> 16) & 1u)) >> 16; }
__device__ __forceinline__ unsigned pk2(float lo, float hi) { return f2bf(lo) | (f2bf(hi) << 16); }
using pg8::bf_lo; using pg8::bf_hi;

#define XB_TMO      128
#define XB_XCNT(j)  (256  + 64 * (j))
#define XB_XSUB(j)  (1280 + 64 * (j))
#define XB_XGEN(j)  (2304 + 64 * (j))
#define XB_TOP      3328
#define XB_TOPGEN   3392
#define XCD_BAR_WORDS 3456
#define XB_SPIN_CAP (1u << 18)

__device__ __forceinline__ unsigned xb_ld(unsigned* p)              { return __hip_atomic_load(p, __ATOMIC_RELAXED, __HIP_MEMORY_SCOPE_AGENT); }
__device__ __forceinline__ unsigned xb_add(unsigned* p, unsigned v) { return __hip_atomic_fetch_add(p, v, __ATOMIC_RELAXED, __HIP_MEMORY_SCOPE_AGENT); }
__device__ __forceinline__ unsigned xb_xcc_id() { return (unsigned)__builtin_amdgcn_s_getreg((3 << 11) | 20) & 0xFu; }
#define XB_SPIN(cond, bar) do { unsigned _sp = 0; while (cond) { __builtin_amdgcn_s_sleep(1); \
    if ((++_sp & 255u) == 0u) { if (xb_ld(&(bar)[XB_TMO])) break; if (_sp > XB_SPIN_CAP) { atomicAdd(&(bar)[XB_TMO], 1u); break; } } } } while (0)

struct XcdBarrier {
    unsigned* bar; unsigned x;
    volatile LAS unsigned* st;
};
__device__ __forceinline__ XcdBarrier xcd_barrier_post(unsigned* bar, volatile LAS unsigned* st) {
    XcdBarrier b; b.bar = bar; b.x = xb_xcc_id(); b.st = st;
    if (threadIdx.x == 0) (void)xb_add(&bar[XB_XCNT(b.x)], 1u);
    return b;
}
__device__ __forceinline__ void xcd_barrier_complete(unsigned* bar, unsigned x, unsigned& nloc, unsigned& nx) {
    const unsigned G = gridDim.x * gridDim.y * gridDim.z;
    unsigned sum, cnt, mine, sp = 0u;
    for (;;) {
        sum = 0u; cnt = 0u; mine = 0u;
#pragma unroll
        for (unsigned j = 0; j < 16; ++j) { const unsigned c = xb_ld(&bar[XB_XCNT(j)]); sum += c; cnt += (c > 0u) ? 1u : 0u; mine = (j == x) ? c : mine; }
        if (sum == G) break;
        __builtin_amdgcn_s_sleep(1);
        if ((++sp & 255u) == 0u) { if (xb_ld(&bar[XB_TMO])) break; if (sp > XB_SPIN_CAP) { atomicAdd(&bar[XB_TMO], 1u); break; } }
    }
    nloc = mine > 0u ? mine : 1u; nx = cnt > 0u ? cnt : 1u;
}
__device__ __forceinline__ void xcd_barrier(const XcdBarrier& b, const bool is_t0  ) {
    asm volatile("s_waitcnt vmcnt(0)" ::: "memory");
    __syncthreads();
    if (is_t0) {
        unsigned* bar = b.bar;
        __builtin_amdgcn_s_waitcnt(0);
        unsigned nloc = b.st[0], nx = b.st[1];
        if (nloc == 0u) { xcd_barrier_complete(bar, b.x, nloc, nx); b.st[0] = nloc; b.st[1] = nx; }
        const unsigned old = xb_add(&bar[XB_XSUB(b.x)], 1u);
        const unsigned gen = old / nloc;
        if (old + 1u == (gen + 1u) * nloc) {
            __builtin_amdgcn_fence(__ATOMIC_RELEASE, "agent");
            asm volatile("s_waitcnt vmcnt(0)" ::: "memory");
            const unsigned og = xb_add(&bar[XB_TOP], 1u);
            const unsigned tg = og / nx;
            if (og + 1u == (tg + 1u) * nx) xb_add(&bar[XB_TOPGEN], 1u);
            else XB_SPIN(xb_ld(&bar[XB_TOPGEN]) == tg, bar);
            __builtin_amdgcn_fence(__ATOMIC_ACQUIRE, "agent");
            xb_add(&bar[XB_XGEN(b.x)], 1u);
            asm volatile("s_waitcnt vmcnt(0)" ::: "memory");
        } else {
            XB_SPIN(xb_ld(&bar[XB_XGEN(b.x)]) == gen, bar);
            __builtin_amdgcn_fence(__ATOMIC_ACQUIRE, "agent");
            asm volatile("s_waitcnt vmcnt(0)" ::: "memory");
        }
    }
    __syncthreads();
}

__device__ __forceinline__ void xcd_barrier_arrive(const XcdBarrier& b, const bool is_t0) {
    asm volatile("s_waitcnt vmcnt(0)" ::: "memory");
    __syncthreads();
    if (is_t0) {
        unsigned* bar = b.bar;
        __builtin_amdgcn_s_waitcnt(0);
        unsigned nloc = b.st[0], nx = b.st[1];
        if (nloc == 0u) { xcd_barrier_complete(bar, b.x, nloc, nx); b.st[0] = nloc; b.st[1] = nx; }
        const unsigned old = xb_add(&bar[XB_XSUB(b.x)], 1u);
        const unsigned gen = old / nloc;
        b.st[2] = gen;
        if (old + 1u == (gen + 1u) * nloc) {
            __builtin_amdgcn_fence(__ATOMIC_RELEASE, "agent");
            asm volatile("s_waitcnt vmcnt(0)" ::: "memory");
            xb_add(&bar[XB_XGEN(b.x)], 1u);
            const unsigned og = xb_add(&bar[XB_TOP], 1u);
            const unsigned tg = og / nx;
            if (og + 1u == (tg + 1u) * nx) xb_add(&bar[XB_TOPGEN], 1u);
        }
    }
}
__device__ __forceinline__ void xcd_barrier_wait(const XcdBarrier& b, const bool is_t0) {
    if (is_t0) {
        unsigned* bar = b.bar; const unsigned gen = b.st[2];
        XB_SPIN(xb_ld(&bar[XB_TOPGEN]) <= gen, bar);
        __builtin_amdgcn_fence(__ATOMIC_ACQUIRE, "agent");
        asm volatile("s_waitcnt vmcnt(0)" ::: "memory");
    }
    __syncthreads();
}

__device__ __forceinline__ int lane_id_now() { int l; asm volatile("v_mbcnt_lo_u32_b32 %0, -1, 0\n\tv_mbcnt_hi_u32_b32 %0, -1, %0" : "=v"(l)); return l; }
struct Frame {
    LAS unsigned char* lds;
    volatile LAS unsigned* MISC;
    gu32* ctl;
    int tid, lane, wave;
    int vcu, G;
};
__device__ __forceinline__ float wave_sum(float v) {
#pragma unroll
    for (int o = 1; o < 64; o <<= 1) v += __shfl_xor(v, o);
    return v;
}
__device__ __forceinline__ void p0_transpose_item(const float* W, int K, int N, bf16* WT, int row_off, LAS float* scr, int item, int lane) {
    const int nblk = N / 32, kb = item / nblk, nb = item % nblk, k0 = 64 * kb, n0 = 32 * nb;
    { float v[32];
#pragma unroll
      for (int i = 0; i < 32; ++i) { const int kk = 2 * i + (lane >> 5); v[i] = ((const GAS float*)W)[(size_t)(k0 + kk) * N + n0 + (lane & 31)]; }
#pragma unroll
      for (int i = 0; i < 32; ++i) { const int kk = 2 * i + (lane >> 5); scr[kk * 33 + (lane & 31)] = v[i]; } }
    LDS_WAIT(); asm volatile("" ::: "memory");
    const int c = lane & 7;
#pragma unroll
    for (int j = 0; j < 4; ++j) { const int n = (lane >> 3) + 8 * j; const LAS float* s = scr + (8 * c) * 33 + n;
        v4u o; o.x = pk2(s[0 * 33], s[1 * 33]); o.y = pk2(s[2 * 33], s[3 * 33]); o.z = pk2(s[4 * 33], s[5 * 33]); o.w = pk2(s[6 * 33], s[7 * 33]);
        *(GAS v4u*)(WT + (size_t)(row_off + n0 + n) * K + k0 + 8 * c) = o; }
    LDS_WAIT(); asm volatile("" ::: "memory");
}
__device__ __forceinline__ float wave_max(float v) {
#pragma unroll
    for (int o = 1; o < 64; o <<= 1) v = fmaxf(v, __shfl_xor(v, o));
    return v;
}
__device__ __forceinline__ unsigned q8(float v) { return (unsigned)((int)__builtin_rintf(v)) & 0xFFu; }
__device__ __forceinline__ void ln0_rows(int lane, const float* x, const float* g, const float* bta, unsigned char* o8, float* oscale, int gw, int ngw) {
    int m = gw; if (m >= T) return;
    f32x4 gg[8], bb[8], v[8];
#pragma unroll
    for (int j = 0; j < 8; ++j) { gg[j] = ((const GAS f32x4*)g)[lane + 64 * j]; bb[j] = ((const GAS f32x4*)bta)[lane + 64 * j]; v[j] = ((const GAS f32x4*)(x + (size_t)m * DM))[lane + 64 * j]; }
#pragma unroll 1
    for (;;) {
        const int mn = m + ngw; const bool has = mn < T; f32x4 nv[8];
        { const GAS f32x4* xr = (const GAS f32x4*)(x + (size_t)(has ? mn : m) * DM) + lane;
#pragma unroll
          for (int j = 0; j < 8; ++j) nv[j] = xr[64 * j]; }
        float s = 0.f;
#pragma unroll
        for (int j = 0; j < 8; ++j) s += (v[j].x + v[j].y) + (v[j].z + v[j].w);
        const float mean = wave_sum(s) * (1.f / DM); float s2 = 0.f;
#pragma unroll
        for (int j = 0; j < 8; ++j) { v[j] = v[j] - mean; s2 += (v[j].x * v[j].x + v[j].y * v[j].y) + (v[j].z * v[j].z + v[j].w * v[j].w); }
        const float rstd = 1.f / sqrtf(wave_sum(s2) * (1.f / DM) + LN_EPS);
        float am = 0.f;
#pragma unroll
        for (int j = 0; j < 8; ++j) { v[j] = v[j] * rstd * gg[j] + bb[j];
            am = fmaxf(fmaxf(am, fmaxf(fabsf(v[j].x), fabsf(v[j].y))), fmaxf(fabsf(v[j].z), fabsf(v[j].w))); }
        am = fmaxf(wave_max(am), 1e-20f); const float inv = 127.f / am;
        GAS unsigned* q = (GAS unsigned*)(o8 + (size_t)m * DM) + lane;
#pragma unroll
        for (int j = 0; j < 8; ++j) q[64 * j] = q8(v[j].x * inv) | (q8(v[j].y * inv) << 8) | (q8(v[j].z * inv) << 16) | (q8(v[j].w * inv) << 24);
        if (lane == 0) oscale[m] = am * (1.f / 127.f);
        if (!has) break;
#pragma unroll
        for (int j = 0; j < 8; ++j) v[j] = nv[j];
        m = mn;
    }
}
__device__ __forceinline__ void p0_transpose_item_i8(const float* W, int K, int N, unsigned char* WT, LAS float* scr, int item, int lane, float inv) {
    const int nblk = N / 32, kb = item / nblk, nb = item % nblk, k0 = 64 * kb, n0 = 32 * nb;
    { float v[32];
#pragma unroll
      for (int i = 0; i < 32; ++i) { const int kk = 2 * i + (lane >> 5); v[i] = ((const GAS float*)W)[(size_t)(k0 + kk) * N + n0 + (lane & 31)]; }
#pragma unroll
      for (int i = 0; i < 32; ++i) { const int kk = 2 * i + (lane >> 5); scr[kk * 33 + (lane & 31)] = v[i]; } }
    LDS_WAIT(); asm volatile("" ::: "memory");
    const int c = lane & 7;
#pragma unroll
    for (int j = 0; j < 4; ++j) { const int n = (lane >> 3) + 8 * j; const LAS float* sp = scr + (8 * c) * 33 + n;
        const unsigned lo = q8(sp[0 * 33] * inv) | (q8(sp[1 * 33] * inv) << 8) | (q8(sp[2 * 33] * inv) << 16) | (q8(sp[3 * 33] * inv) << 24);
        const unsigned hi = q8(sp[4 * 33] * inv) | (q8(sp[5 * 33] * inv) << 8) | (q8(sp[6 * 33] * inv) << 16) | (q8(sp[7 * 33] * inv) << 24);
        *(GAS unsigned long long*)(WT + (size_t)(n0 + n) * K + k0 + 8 * c) = (unsigned long long)lo | ((unsigned long long)hi << 32); }
    LDS_WAIT(); asm volatile("" ::: "memory");
}
__device__ __forceinline__ void absmax_stream(const float* src, size_t n4, gu32* word, size_t gtid, size_t nthr, int lane) {
    float m = 0.f; size_t i = gtid;
    for (; i + 3 * nthr < n4; i += 4 * nthr) { f32x4 a[4];
#pragma unroll
        for (int u = 0; u < 4; ++u) a[u] = ((const GAS f32x4*)src)[i + u * nthr];
#pragma unroll
        for (int u = 0; u < 4; ++u) m = fmaxf(fmaxf(m, fmaxf(fabsf(a[u].x), fabsf(a[u].y))), fmaxf(fabsf(a[u].z), fabsf(a[u].w))); }
    for (; i < n4; i += nthr) { const f32x4 a = ((const GAS f32x4*)src)[i]; m = fmaxf(fmaxf(m, fmaxf(fabsf(a.x), fabsf(a.y))), fmaxf(fabsf(a.z), fabsf(a.w))); }
    m = wave_max(m);
    if (lane == 0) __hip_atomic_fetch_max(word, __float_as_uint(m), RLX_AGENT);
}
__device__ __forceinline__ void cvt_stream(const float* src, bf16* dst, size_t n8, size_t gtid, size_t nthr) {
    size_t i = gtid;
    for (; i + 3 * nthr < n8; i += 4 * nthr) { f32x4 a[4], b[4];
#pragma unroll
        for (int u = 0; u < 4; ++u) { a[u] = ((const GAS f32x4*)src)[2 * (i + u * nthr)]; b[u] = ((const GAS f32x4*)src)[2 * (i + u * nthr) + 1]; }
#pragma unroll
        for (int u = 0; u < 4; ++u) { v4u o; o.x = pk2(a[u].x, a[u].y); o.y = pk2(a[u].z, a[u].w); o.z = pk2(b[u].x, b[u].y); o.w = pk2(b[u].z, b[u].w); ((GAS v4u*)dst)[i + u * nthr] = o; } }
    for (; i < n8; i += nthr) { const f32x4 a = ((const GAS f32x4*)src)[2 * i], b = ((const GAS f32x4*)src)[2 * i + 1];
        v4u o; o.x = pk2(a.x, a.y); o.y = pk2(a.z, a.w); o.z = pk2(b.x, b.y); o.w = pk2(b.z, b.w); ((GAS v4u*)dst)[i] = o; }
}

struct Args { const float* in[28]; float* out; unsigned char* ws; int ph_lo, ph_hi, li, pad; };
constexpr float F8_F = 16.f, F8_PW = 8.f, F8_M = 32.f;
typedef float f32x2c __attribute__((ext_vector_type(2)));
__device__ __forceinline__ unsigned pack_fp8x4(float a, float b, float c, float d) { int w = 0; w = __builtin_amdgcn_cvt_pk_fp8_f32(a, b, w, false); w = __builtin_amdgcn_cvt_pk_fp8_f32(c, d, w, true); return (unsigned)w; }
__device__ __forceinline__ f32x4 unpack_fp8x4(unsigned w) { const f32x2c lo = __builtin_amdgcn_cvt_pk_f32_fp8((int)w, false), hi = __builtin_amdgcn_cvt_pk_f32_fp8((int)w, true); return (f32x4){lo.x, lo.y, hi.x, hi.y}; }
__device__ __forceinline__ void pool_mix_quant_phase(const bf16* XP, unsigned char* M8, float* SM, LAS float* xch  , int bstart, int bstride, int tid) {
    const int wv = __builtin_amdgcn_readfirstlane(tid >> 6), lane = tid & 63, sb = wv >> 1, ch = (wv & 1) * 64 + lane, g = ch >> 5, w = 2 << g;
    int par = 0;
    for (int b = bstart; b < T / 128; b += bstride) {
        const int t0 = b * 128 + sb * 32, tt0 = t0 & (SEQ - 1);
        const GAS v4u* p = (const GAS v4u*)(XP + (size_t)t0 * PW_ + ch * 8);
        f32x4 s0 = {0.f, 0.f, 0.f, 0.f}, s1 = s0;
        v4u rin[8], rout[8];
#define PMQ_LOAD(c4_) _Pragma("unroll") for (int k = 0; k < 8; ++k) { const int r = 8 * (c4_) + k, tt = tt0 + r; rin[k] = p[(size_t)r * (PW_ / 8)]; \
            rout[k] = (tt - w + 1 >= 0) ? *(p + (ptrdiff_t)(r - w + 1) * (PW_ / 8)) : (v4u){0u, 0u, 0u, 0u}; }
        PMQ_LOAD(0)
        for (int k = 1; k < w; ++k) if (tt0 - k >= 0) { f32x4 a, bq; pg8::unpack8(*(p - (size_t)k * (PW_ / 8)), a, bq); s0 += a; s1 += bq; }
#pragma unroll 1
        for (int c4 = 0; c4 < 4; ++c4) {
            f32x4 o0[8], o1[8]; float m[8];
#pragma unroll
            for (int k = 0; k < 8; ++k) { const int r = 8 * c4 + k, tt = tt0 + r; f32x4 x0, x1; pg8::unpack8(rin[k], x0, x1); s0 += x0; s1 += x1;
                const int n = (tt + 1 < w) ? tt + 1 : w; const float inv = 1.f / (float)n;
                o0[k] = s0 * inv - x0; o1[k] = s1 * inv - x1;
                m[k] = fmaxf(fmaxf(fmaxf(fabsf(o0[k].x), fabsf(o0[k].y)), fmaxf(fabsf(o0[k].z), fabsf(o0[k].w))), fmaxf(fmaxf(fabsf(o1[k].x), fabsf(o1[k].y)), fmaxf(fabsf(o1[k].z), fabsf(o1[k].w))));
                { f32x4 a, bq; pg8::unpack8(rout[k], a, bq); s0 -= a; s1 -= bq; } }
            if (c4 < 3) { PMQ_LOAD(c4 + 1) }
#pragma unroll
            for (int k = 0; k < 8; ++k) m[k] = wave_max(m[k]);
            LAS float* mine = xch + (par * 8 + wv) * 8; const LAS float* other = xch + (par * 8 + (wv ^ 1)) * 8;
            if (lane == 0) { *(LAS f32x4*)mine = (f32x4){m[0], m[1], m[2], m[3]}; *(LAS f32x4*)(mine + 4) = (f32x4){m[4], m[5], m[6], m[7]}; }
            __syncthreads();
            const f32x4 pa = *(const LAS f32x4*)other, pb = *(const LAS f32x4*)(other + 4);
#pragma unroll
            for (int k = 0; k < 8; ++k) { const float am = fmaxf(fmaxf(m[k], k < 4 ? pa[k & 3] : pb[k & 3]), 1e-20f), inv = 127.f / am; const int r = 8 * c4 + k;
                const f32x4 a = o0[k] * inv, bq = o1[k] * inv;
                *(GAS unsigned long long*)(M8 + (size_t)(t0 + r) * PW_ + ch * 8) = (unsigned long long)(q8(a.x) | (q8(a.y) << 8) | (q8(a.z) << 16) | (q8(a.w) << 24)) | ((unsigned long long)(q8(bq.x) | (q8(bq.y) << 8) | (q8(bq.z) << 16) | (q8(bq.w) << 24)) << 32);
                if ((wv & 1) == 0 && lane == 0) SM[t0 + r] = am * (1.f / 127.f); }
            par ^= 1;
        }
#undef PMQ_LOAD
    }
}
template <int NC, int R> __device__ __forceinline__ void quant_rows(const bf16* X, unsigned char* X8, float* XS, int gw, int ngw, int lane) {
    constexpr int NV = NC / 512;
    for (int t0 = gw; t0 < T; t0 += R * ngw) {
        v4u raw[R][NV];
#pragma unroll
        for (int r = 0; r < R; ++r) { const int t = (t0 + r * ngw < T) ? t0 + r * ngw : t0; const GAS v4u* xr = (const GAS v4u*)(X + (size_t)t * NC) + lane;
#pragma unroll
            for (int j = 0; j < NV; ++j) raw[r][j] = xr[64 * j]; }
#pragma unroll
        for (int r = 0; r < R; ++r) { const int t = t0 + r * ngw; if (t >= T) break;
            f32x4 v[2 * NV]; float am = 0.f;
#pragma unroll
            for (int j = 0; j < NV; ++j) pg8::unpack8(raw[r][j], v[2 * j], v[2 * j + 1]);
#pragma unroll
            for (int j = 0; j < 2 * NV; ++j) am = fmaxf(fmaxf(am, fmaxf(fabsf(v[j].x), fabsf(v[j].y))), fmaxf(fabsf(v[j].z), fabsf(v[j].w)));
            am = fmaxf(wave_max(am), 1e-20f); const float inv = 127.f / am;
            GAS unsigned long long* qr = (GAS unsigned long long*)(X8 + (size_t)t * NC) + lane;
#pragma unroll
            for (int j = 0; j < NV; ++j) { const f32x4 a = v[2 * j] * inv, b = v[2 * j + 1] * inv;
                qr[64 * j] = (unsigned long long)(q8(a.x) | (q8(a.y) << 8) | (q8(a.z) << 16) | (q8(a.w) << 24)) | ((unsigned long long)(q8(b.x) | (q8(b.y) << 8) | (q8(b.z) << 16) | (q8(b.w) << 24)) << 32); }
            if (lane == 0) XS[t] = am * (1.f / 127.f); }
    }
}
typedef float v16f_t __attribute__((ext_vector_type(16)));
typedef unsigned v6u_t __attribute__((ext_vector_type(6)));
typedef unsigned v2u_t __attribute__((ext_vector_type(2)));
constexpr int SLICE_ROWB = 192;
template <int R> __device__ __forceinline__ void quant_rows_sum8(const unsigned char* A8, const unsigned char* B8, unsigned char* X8, float* XS, int gw, int ngw, int lane) {
    int t0 = gw; if (t0 >= T) return;
    v2u_t ra[R][4], rb[R][4];
#define QRS_LOAD(da, db, tb) _Pragma("unroll") for (int r = 0; r < R; ++r) { const int t = ((tb) + r * ngw < T) ? (tb) + r * ngw : (tb); \
        _Pragma("unroll") for (int j = 0; j < 4; ++j) { const size_t o = (size_t)t * DM + j * 512 + lane * 8; da[r][j] = *(const GAS v2u_t*)(A8 + o); db[r][j] = *(const GAS v2u_t*)(B8 + o); } }
    QRS_LOAD(ra, rb, t0)
#pragma unroll 1
    for (;;) {
        const int tn = t0 + R * ngw; const bool has = tn < T; const int tl = has ? tn : t0; v2u_t na[R][4], nb[R][4];
        QRS_LOAD(na, nb, tl)
#pragma unroll
        for (int r = 0; r < R; ++r) { const int t = t0 + r * ngw; if (t >= T) break;
            f32x4 v[8]; float am = 0.f;
#pragma unroll
            for (int j = 0; j < 4; ++j) { v[2 * j] = unpack_fp8x4(ra[r][j].x) + unpack_fp8x4(rb[r][j].x); v[2 * j + 1] = unpack_fp8x4(ra[r][j].y) + unpack_fp8x4(rb[r][j].y); }
#pragma unroll
            for (int j = 0; j < 8; ++j) am = fmaxf(fmaxf(am, fmaxf(fabsf(v[j].x), fabsf(v[j].y))), fmaxf(fabsf(v[j].z), fabsf(v[j].w)));
            am = fmaxf(wave_max(am), 1e-20f); const float inv = 127.f / am;
            GAS unsigned long long* qr = (GAS unsigned long long*)(X8 + (size_t)t * DM) + lane;
#pragma unroll
            for (int j = 0; j < 4; ++j) { const f32x4 a = v[2 * j] * inv, b = v[2 * j + 1] * inv;
                qr[64 * j] = (unsigned long long)(q8(a.x) | (q8(a.y) << 8) | (q8(a.z) << 16) | (q8(a.w) << 24)) | ((unsigned long long)(q8(b.x) | (q8(b.y) << 8) | (q8(b.z) << 16) | (q8(b.w) << 24)) << 32); }
            if (lane == 0) XS[t] = am * (1.f / (127.f * F8_M)); }
        if (!has) break;
#pragma unroll
        for (int r = 0; r < R; ++r)
#pragma unroll
            for (int j = 0; j < 4; ++j) { ra[r][j] = na[r][j]; rb[r][j] = nb[r][j]; }
        t0 = tn;
    }
#undef QRS_LOAD
}
__device__ __forceinline__ void ln_rows_bf16(const bf16* Z, unsigned char* X8, unsigned char* X6, float* XS, const float* g, const float* bta, int gw, int ngw, int lane) {
    int t = gw; if (t >= T) return;
    f32x4 gg[8], bb[8]; v4u zw[4];
    { const GAS f32x4* gp = (const GAS f32x4*)(g + lane * 32); const GAS f32x4* bp = (const GAS f32x4*)(bta + lane * 32); const GAS v4u* zr = (const GAS v4u*)(Z + (size_t)t * DM + lane * 32);
#pragma unroll
      for (int j = 0; j < 8; ++j) { gg[j] = gp[j]; bb[j] = bp[j]; }
#pragma unroll
      for (int j = 0; j < 4; ++j) zw[j] = zr[j]; }
#pragma unroll 1
    for (;;) {
        const int tn = t + ngw; const bool has = tn < T; v4u nz[4];
        { const GAS v4u* zr = (const GAS v4u*)(Z + (size_t)(has ? tn : t) * DM + lane * 32);
#pragma unroll
          for (int j = 0; j < 4; ++j) nz[j] = zr[j]; }
        f32x4 v[8]; float s = 0.f;
#pragma unroll
        for (int j = 0; j < 4; ++j) pg8::unpack8(zw[j], v[2 * j], v[2 * j + 1]);
#pragma unroll
        for (int j = 0; j < 8; ++j) s += (v[j].x + v[j].y) + (v[j].z + v[j].w);
        const float mean = wave_sum(s) * (1.f / DM); float s2 = 0.f;
#pragma unroll
        for (int j = 0; j < 8; ++j) { v[j] = v[j] - mean; s2 += (v[j].x * v[j].x + v[j].y * v[j].y) + (v[j].z * v[j].z + v[j].w * v[j].w); }
        const float rstd = 1.f / sqrtf(wave_sum(s2) * (1.f / DM) + LN_EPS);
        float am = 0.f;
#pragma unroll
        for (int j = 0; j < 8; ++j) v[j] = v[j] * rstd * gg[j] + bb[j];
#pragma unroll
        for (int j = 0; j < 8; ++j) am = fmaxf(fmaxf(am, fmaxf(fabsf(v[j].x), fabsf(v[j].y))), fmaxf(fabsf(v[j].z), fabsf(v[j].w)));
        am = fmaxf(wave_max(am), 1e-20f); const float inv = 127.f / am, inv6 = 7.5f / am;
        GAS v4u* qr = (GAS v4u*)(X8 + (size_t)t * DM + lane * 32);
#pragma unroll
        for (int j = 0; j < 2; ++j) { v4u o;
#pragma unroll
            for (int i = 0; i < 4; ++i) { const f32x4 a = v[4 * j + i] * inv; o[i] = q8(a.x) | (q8(a.y) << 8) | (q8(a.z) << 16) | (q8(a.w) << 24); }
            qr[j] = o; }
        v16f_t lo, hi;
#pragma unroll
        for (int j = 0; j < 8; ++j) { const f32x4 a = v[j] * inv6; lo[2 * j] = a.x; hi[2 * j] = a.y; lo[2 * j + 1] = a.z; hi[2 * j + 1] = a.w; }
        const v6u_t p6 = __builtin_amdgcn_cvt_scalef32_2xpk16_fp6_f32(lo, hi, 1.0f);
        { const int sl = lane >> 3, jb = lane & 7, cb = jb >> 2, gq = jb & 3; unsigned char* r6 = X6 + ((size_t)sl * T + t) * SLICE_ROWB + gq * 16;
          *(GAS v4u*)(r6 + cb * 64) = (v4u){p6[0], p6[1], p6[2], p6[3]}; *(GAS v2u_t*)(r6 + 128 + cb * 8) = (v2u_t){p6[4], p6[5]}; }
        if (lane == 0) XS[t] = am * (1.f / 127.f);
        if (!has) break;
#pragma unroll
        for (int j = 0; j < 4; ++j) zw[j] = nz[j];
        t = tn;
    }
}

namespace psel {
constexpr float NEG = -3.0e38f;
#define PKSWZ(row, colB) ((row) * 256 + ((colB) ^ (((row) & 7) << 4)))
__device__ __forceinline__ int crow(int r, int hi) { return (r & 3) + 8 * (r >> 2) + 4 * hi; }
#define CE_DESC(a, b) do { const float hi_ = fmaxf(a, b), lo_ = fminf(a, b); a = hi_; b = lo_; } while (0)
__device__ __forceinline__ void sort16_desc(float (&x)[16]) {
    CE_DESC(x[0], x[13]); CE_DESC(x[1], x[12]); CE_DESC(x[2], x[15]); CE_DESC(x[3], x[14]); CE_DESC(x[4], x[8]); CE_DESC(x[5], x[6]); CE_DESC(x[7], x[11]); CE_DESC(x[9], x[10]);
    CE_DESC(x[0], x[5]); CE_DESC(x[1], x[7]); CE_DESC(x[2], x[9]); CE_DESC(x[3], x[4]); CE_DESC(x[6], x[13]); CE_DESC(x[8], x[14]); CE_DESC(x[10], x[15]); CE_DESC(x[11], x[12]);
    CE_DESC(x[0], x[1]); CE_DESC(x[2], x[3]); CE_DESC(x[4], x[5]); CE_DESC(x[6], x[8]); CE_DESC(x[7], x[9]); CE_DESC(x[10], x[11]); CE_DESC(x[12], x[13]); CE_DESC(x[14], x[15]);
    CE_DESC(x[0], x[2]); CE_DESC(x[1], x[3]); CE_DESC(x[4], x[10]); CE_DESC(x[5], x[11]); CE_DESC(x[6], x[7]); CE_DESC(x[8], x[9]); CE_DESC(x[12], x[14]); CE_DESC(x[13], x[15]);
    CE_DESC(x[1], x[2]); CE_DESC(x[3], x[12]); CE_DESC(x[4], x[6]); CE_DESC(x[5], x[7]); CE_DESC(x[8], x[10]); CE_DESC(x[9], x[11]); CE_DESC(x[13], x[14]);
    CE_DESC(x[1], x[4]); CE_DESC(x[2], x[6]); CE_DESC(x[5], x[8]); CE_DESC(x[7], x[10]); CE_DESC(x[9], x[13]); CE_DESC(x[11], x[14]);
    CE_DESC(x[2], x[4]); CE_DESC(x[3], x[6]); CE_DESC(x[9], x[12]); CE_DESC(x[11], x[13]);
    CE_DESC(x[3], x[5]); CE_DESC(x[6], x[8]); CE_DESC(x[7], x[9]); CE_DESC(x[10], x[12]);
    CE_DESC(x[3], x[4]); CE_DESC(x[5], x[6]); CE_DESC(x[7], x[8]); CE_DESC(x[9], x[10]); CE_DESC(x[11], x[12]);
    CE_DESC(x[6], x[7]); CE_DESC(x[8], x[9]);
}
__device__ __forceinline__ void merge16_desc(float (&a)[16], const float (&b)[16]) {
#pragma unroll
    for (int i = 0; i < 16; ++i) a[i] = fmaxf(a[i], b[15 - i]);
#pragma unroll
    for (int j = 8; j > 0; j >>= 1)
#pragma unroll
        for (int i = 0; i < 16; ++i) { const int l = i ^ j; if (l > i) CE_DESC(a[i], a[l]); }
}
__device__ __forceinline__ void load_keys(char* lds, const float* k1, const float* k2, int tid) {
#pragma unroll
    for (int i = 0; i < 8; ++i) { const int e = tid + 512 * i, which = e >> 11, rem = e & 2047, row = rem >> 4, cg = rem & 15;
        const GAS f32x4* s = (const GAS f32x4*)((which ? k2 : k1) + row * 128 + cg * 8); const f32x4 a = s[0], b = s[1];
        *(v4u*)(lds + which * 32768 + PKSWZ(row, cg * 16)) = pg8::pack8(a, b); }
}
__device__ __forceinline__ void half_top16(const char* klds, const int (&kofs)[4], const bf16* qb, int hi, float (&out)[16]) {
    bf16x8 bq[8];
#pragma unroll
    for (int ks = 0; ks < 8; ++ks) bq[ks] = *(const GAS bf16x8*)(qb + ks * 16);
    f32x16 acc[4] = {};
#pragma unroll
    for (int ks = 0; ks < 8; ++ks)
#pragma unroll
        for (int rb = 0; rb < 4; ++rb) { const bf16x8 a = *reinterpret_cast<const bf16x8*>(klds + kofs[ks & 3] + rb * 8192 + (ks >> 2) * 128);
            acc[rb] = __builtin_amdgcn_mfma_f32_32x32x16_bf16(a, bq[ks], acc[rb], 0, 0, 0); }
    float g0[16], g1[16], g2[16], g3[16];
#pragma unroll
    for (int r = 0; r < 16; ++r) { const int kb = (r & 3) + 8 * (r >> 2);
        g0[r] = __uint_as_float((__float_as_uint(acc[0][r]) & 0xFFFFFF80u) | (unsigned)(127 ^ kb)); g1[r] = __uint_as_float((__float_as_uint(acc[1][r]) & 0xFFFFFF80u) | (unsigned)(127 ^ (32 + kb)));
        g2[r] = __uint_as_float((__float_as_uint(acc[2][r]) & 0xFFFFFF80u) | (unsigned)(127 ^ (64 + kb))); g3[r] = __uint_as_float((__float_as_uint(acc[3][r]) & 0xFFFFFF80u) | (unsigned)(127 ^ (96 + kb))); }
    sort16_desc(g0); sort16_desc(g1); sort16_desc(g2); sort16_desc(g3);
    merge16_desc(g0, g1); merge16_desc(g2, g3); merge16_desc(g0, g2);
    const unsigned hx = (unsigned)hi << 2; float pr[16];
#pragma unroll
    for (int i = 0; i < 16; ++i) { g0[i] = __uint_as_float(__float_as_uint(g0[i]) ^ hx); pr[i] = __shfl_xor(g0[i], 32); }
    merge16_desc(g0, pr);
#pragma unroll
    for (int i = 0; i < 16; ++i) out[i] = g0[i];
}
__device__ __forceinline__ void select_task(const char* lds, const bf16* QP, int t0, int lane, unsigned short* IDS16, unsigned short* GATES16, unsigned short* IDT) {
    const int r32 = lane & 31, hi = lane >> 5; const int tok = t0 + (r32 >> 3), head = r32 & 7;
    const bf16* qrow = QP + (size_t)tok * DM + head * 256 + hi * 8;
    float o1[16], o2[16];
    int kofs[4];
#pragma unroll
    for (int q = 0; q < 4; ++q) { kofs[q] = r32 * 256 + ((q * 32 + hi * 16) ^ ((r32 & 7) << 4)); asm volatile("" : "+v"(kofs[q])); }
    half_top16(lds, kofs, qrow, hi, o1);
    half_top16(lds + 32768, kofs, qrow + 128, hi, o2);
    float c1[16], c2[16]; unsigned k1p[4] = {0u, 0u, 0u, 0u}, k2p[4] = {0u, 0u, 0u, 0u};
#pragma unroll
    for (int a = 0; a < 16; ++a) { const unsigned b1 = __float_as_uint(o1[a]), b2 = __float_as_uint(o2[a]); c1[a] = __uint_as_float(b1 & 0xFFFFFF80u); c2[a] = __uint_as_float(b2 & 0xFFFFFF80u);
        k1p[a >> 2] |= (127u - (b1 & 0x7Fu)) << ((a & 3) * 8); k2p[a >> 2] |= (127u - (b2 & 0x7Fu)) << ((a & 3) * 8); }
#define CAND(a, b) __uint_as_float((__float_as_uint(c1[a] + c2[b]) & 0xFFFFFF00u) | (unsigned)(((15 - (a)) << 4) | (15 - (b))))
    float L0[16], L1[16], T2[16], S[16], T3[16], L4[16], T4[16], L6[16], L7[16];
#pragma unroll
    for (int b = 0; b < 16; ++b) { L0[b] = CAND(0, b); L1[b] = b < 8 ? CAND(1, b & 7) : NEG; T2[b] = b < 5 ? CAND(2, b < 5 ? b : 0) : NEG; S[b] = b < 8 ? CAND(8 + (b & 7), 0) : NEG;
        T3[b] = b < 4 ? CAND(3, b & 3) : NEG; L4[b] = b < 3 ? CAND(4, b < 3 ? b : 0) : NEG; T4[b] = b < 2 ? CAND(5, b & 1) : NEG; L6[b] = b < 2 ? CAND(6, b & 1) : NEG; L7[b] = b < 2 ? CAND(7, b & 1) : NEG; }
#undef CAND
    merge16_desc(L0, L1); merge16_desc(T2, S); merge16_desc(T3, L4); merge16_desc(T4, L6); merge16_desc(T3, T4); merge16_desc(T3, L7); merge16_desc(T2, T3); merge16_desc(L0, T2);
    int oid[16]; float e[16]; float sum = 0.f; const float mx = L0[0];
#pragma unroll
    for (int i = 0; i < 16; ++i) { const unsigned bits = __float_as_uint(L0[i]); const int a = 15 - (int)((bits >> 4) & 15u), b = 15 - (int)(bits & 15u);
        const unsigned w1 = (a >> 2) == 0 ? k1p[0] : (a >> 2) == 1 ? k1p[1] : (a >> 2) == 2 ? k1p[2] : k1p[3]; const unsigned w2 = (b >> 2) == 0 ? k2p[0] : (b >> 2) == 1 ? k2p[1] : (b >> 2) == 2 ? k2p[2] : k2p[3];
        oid[i] = (int)((w1 >> ((a & 3) * 8)) & 0xFFu) * 128 + (int)((w2 >> ((b & 3) * 8)) & 0xFFu);
        e[i] = __builtin_amdgcn_exp2f((L0[i] - mx) * 1.4426950408889634f); sum += e[i]; }
    const float inv = 1.f / sum;
    if (hi == 0) {
        GAS v4u* ip16 = (GAS v4u*)(IDS16 + (size_t)tok * 128 + head * 16); GAS v4u* gp16 = (GAS v4u*)(GATES16 + (size_t)tok * 128 + head * 16);
#pragma unroll
        for (int i = 0; i < 2; ++i) { v4u iw, gw_;
#pragma unroll
            for (int q = 0; q < 4; ++q) { const int a = 8 * i + 2 * q; iw[q] = (unsigned)oid[a] | ((unsigned)oid[a + 1] << 16);
                typedef _Float16 h2v __attribute__((ext_vector_type(2))); const h2v gh = {(_Float16)(e[a] * inv), (_Float16)(e[a + 1] * inv)}; gw_[q] = __builtin_bit_cast(unsigned, gh); }
            ip16[i] = iw; gp16[i] = gw_; }
        GAS unsigned short* it = (GAS unsigned short*)(IDT + (size_t)tok * 128 + head);
#pragma unroll
        for (int i = 0; i < 16; ++i) it[8 * i] = (unsigned short)oid[i]; }
}
}

#ifndef U_FP4
#define U_FP4 1
#endif
constexpr float U_SCALE = U_FP4 ? 96.f : 64.f, V_SCALE = 2.f;
constexpr size_t SLICE_BYTES = (size_t)NEXP * SLICE_ROWB;
constexpr int SLICE_ROWB_U = U_FP4 ? 128 : SLICE_ROWB;
constexpr size_t SLICE_BYTES_U = (size_t)NEXP * SLICE_ROWB_U;
typedef float v32f_t __attribute__((ext_vector_type(32)));
typedef __bf16 v32bf_t __attribute__((ext_vector_type(32)));
typedef unsigned v16u_t __attribute__((ext_vector_type(16)));
#define FP6_INTERLEAVED 1
template <int CTRL> __device__ __forceinline__ float dpp_add(float x) { return x + __uint_as_float(__builtin_amdgcn_update_dpp(0u, __float_as_uint(x), CTRL, 0xF, 0xF, true)); }
__device__ __forceinline__ size_t slice_off16(int id, int j) { return (size_t)id * SLICE_ROWB + j * 16; }
__device__ __forceinline__ size_t slice_off8(int id, int j) { return (size_t)id * SLICE_ROWB + 128 + j * 8; }
typedef int v8i_t __attribute__((ext_vector_type(8)));
typedef _Float16 h2_t __attribute__((ext_vector_type(2)));
constexpr int NPC = U_FP4 ? 2 : 3;
template <int H0> __device__ __forceinline__ void rows4_issue(v4u (&R)[4 * NPC]  , const unsigned char* Uq  , const int (&idv)[8]  ) {
#pragma unroll
    for (int h = 0; h < 4; ++h) { const GAS v4u* p = (const GAS v4u*)(Uq + (size_t)(unsigned)idv[H0 + h] * SLICE_ROWB_U);
#pragma unroll
        for (int k = 0; k < NPC; ++k) R[NPC * h + k] = p[4 * k]; }
}
__device__ __forceinline__ v8i_t fp6_operand(const v6u_t a) { return (v8i_t){(int)a[0], (int)a[1], (int)a[2], (int)a[3], (int)a[4], (int)a[5], 0, 0}; }
__device__ __forceinline__ unsigned bperm(int addr, unsigned v) { return (unsigned)__builtin_amdgcn_ds_bpermute(addr, (int)v); }
__device__ __forceinline__ void rows4_compute(const v4u (&R)[4 * NPC], const v6u_t (&b)[2], float scale, unsigned short* hp_tok  , int r, int g, int pa  ) {
    const v8i_t B0 = fp6_operand(b[0]), B1 = fp6_operand(b[1]);
    f32x4 C[4];
#pragma unroll
    for (int h = 0; h < 4; ++h) { unsigned d[4 * NPC];
#pragma unroll
        for (int k = 0; k < NPC; ++k) { const v4u w = R[NPC * h + k]; d[4 * k] = bperm(pa, w.x); d[4 * k + 1] = bperm(pa, w.y); d[4 * k + 2] = bperm(pa, w.z); d[4 * k + 3] = bperm(pa, w.w); }
#if U_FP4
        const v8i_t A0 = {(int)d[0], (int)d[1], (int)d[2], (int)d[3], 0, 0, 0, 0}, A1 = {(int)d[4], (int)d[5], (int)d[6], (int)d[7], 0, 0, 0, 0};
        C[h] = __builtin_amdgcn_mfma_scale_f32_16x16x128_f8f6f4(A0, B0, (f32x4){0.f, 0.f, 0.f, 0.f}, 4, 2, 0, 0, 0, 0);
        C[h] = __builtin_amdgcn_mfma_scale_f32_16x16x128_f8f6f4(A1, B1, C[h], 4, 2, 0, 0, 0, 0); }
#else
        const v8i_t A0 = {(int)d[0], (int)d[1], (int)d[2], (int)d[3], (int)d[8 % (4 * NPC)], (int)d[9 % (4 * NPC)], 0, 0}, A1 = {(int)d[4], (int)d[5], (int)d[6], (int)d[7], (int)d[10 % (4 * NPC)], (int)d[11 % (4 * NPC)], 0, 0};
        C[h] = __builtin_amdgcn_mfma_scale_f32_16x16x128_f8f6f4(A0, B0, (f32x4){0.f, 0.f, 0.f, 0.f}, 2, 2, 0, 0, 0, 0);
        C[h] = __builtin_amdgcn_mfma_scale_f32_16x16x128_f8f6f4(A1, B1, C[h], 2, 2, 0, 0, 0, 0); }
#endif
    f32x4 o = C[0]; o = (r == 1) ? C[1] : o; o = (r == 2) ? C[2] : o; o = (r == 3) ? C[3] : o;
    if (r < 4) { const f32x4 v = o * scale; const h2_t lo = {(_Float16)v.x, (_Float16)v.y}, hi = {(_Float16)v.z, (_Float16)v.w};
        *(GAS v2u_t*)(hp_tok + r * 16 + 4 * g) = (v2u_t){__builtin_bit_cast(unsigned, lo), __builtin_bit_cast(unsigned, hi)}; }
}
struct TokM { int idv[8]; v6u_t b[2]; float sc; };
__device__ __forceinline__ void tokm_load(TokM& k, const unsigned char* X6g  , const float* SX1, const unsigned short* IDS16, int t, int lane) {
    const GAS v4u* xb = (const GAS v4u*)(X6g + (size_t)t * SLICE_ROWB); { const v4u a = xb[0], b = xb[4], e = xb[8]; k.b[0] = (v6u_t){a.x, a.y, a.z, a.w, e.x, e.y}; k.b[1] = (v6u_t){b.x, b.y, b.z, b.w, e.z, e.w}; }
    const v4u iw = *(const GAS v4u*)(IDS16   + (size_t)t * 128 + (lane >> 2) * 8);
#pragma unroll
    for (int c = 0; c < 8; ++c) k.idv[c] = (int)((c & 1) ? iw[c >> 1] >> 16 : iw[c >> 1] & 0xFFFFu);
    k.sc = SX1[t] * (127.f / 7.5f);
}
__device__ __forceinline__ void peer_h_phase(const unsigned char* X6, const float* SX1, const unsigned char* U6s, const unsigned short* IDS, unsigned short* HP  , int s, int wv, int nwv, int lane) {
    const int r = lane & 15, g = lane >> 4, pa = 4 * (4 * r + g);
    const unsigned char* Uq = U6s + (size_t)s * SLICE_BYTES_U + (lane & 3) * 16; const unsigned char* X6g = X6 + (size_t)s * T * SLICE_ROWB + g * 16;
    int t = wv; if (t >= T) return;
    TokM cur; tokm_load(cur, X6g, SX1, IDS, t, lane);
    v4u ra[4 * NPC], rb[4 * NPC];
    rows4_issue<0>(ra, Uq, cur.idv);
#pragma unroll 1
    for (;;) {
        const int tn = t + nwv; const bool has = tn < T;
        TokM nxt = cur; if (has) tokm_load(nxt, X6g, SX1, IDS, tn, lane);
        rows4_issue<4>(rb, Uq, cur.idv);
        __builtin_amdgcn_sched_barrier(0);
        unsigned short* hp = HP + ((size_t)s * T + t) * 128;
        rows4_compute(ra, cur.b, cur.sc, hp, r, g, pa);
        __builtin_amdgcn_sched_barrier(0);
        if (has) rows4_issue<0>(ra, Uq, nxt.idv);
        __builtin_amdgcn_sched_barrier(0);
        rows4_compute(rb, cur.b, cur.sc, hp + 64, r, g, pa);
        if (!has) break;
        cur = nxt; t = tn;
    }
}
__device__ __forceinline__ void peer_a_phase(const unsigned* HP  , const unsigned* GATES16  , unsigned* AW16, size_t gtid, size_t nthr) {
    constexpr int UN = 16;
    for (size_t i0 = gtid; i0 < (size_t)T * 64; i0 += UN * nthr) {
        unsigned w[UN][8]; unsigned gw2[UN];
#pragma unroll
        for (int u = 0; u < UN; ++u) { const size_t i = (i0 + u * nthr < (size_t)T * 64) ? i0 + u * nthr : i0;
#pragma unroll
            for (int s = 0; s < 8; ++s) w[u][s] = *(const GAS unsigned*)(HP + (size_t)s * T * 64 + i);
            gw2[u] = *(const GAS unsigned*)(GATES16 + i); }
#pragma unroll
        for (int u = 0; u < UN; ++u) { const size_t i = i0 + u * nthr; if (i >= (size_t)T * 64) break;
            float h0 = 0.f, h1 = 0.f;
#pragma unroll
            for (int s = 0; s < 8; ++s) { const h2_t hw = __builtin_bit_cast(h2_t, w[u][s]); h0 += (float)hw.x; h1 += (float)hw.y; }
            const pg8::f32x2 ge = pg8::gelu_pk((pg8::f32x2){h0 * (1.f / U_SCALE), h1 * (1.f / U_SCALE)});
            const h2_t gt = __builtin_bit_cast(h2_t, gw2[u]); const h2_t o = {(_Float16)(ge.x * (float)gt.x * (1.f / V_SCALE)), (_Float16)(ge.y * (float)gt.y * (1.f / V_SCALE))};
            *(GAS unsigned*)(AW16 + i) = __builtin_bit_cast(unsigned, o); }
    }
}
constexpr int GF = 4;
typedef _Float16 v32h_t __attribute__((ext_vector_type(32)));
__device__ __forceinline__ v6u_t ld_slice_row(const unsigned char* slice, int id, int j) { const v4u a = *(const GAS v4u*)(slice + slice_off16(id, j)); const v2u_t b = *(const GAS v2u_t*)(slice + slice_off8(id, j));
    return (v6u_t){a.x, a.y, a.z, a.w, b.x, b.y}; }
template <int G0> __device__ __forceinline__ void rows_issue4(v6u_t (&r)[GF], const unsigned char* slice, const unsigned (&idp)[8], int j) {
#pragma unroll
    for (int q = 0; q < GF; ++q) { const int g = G0 + q; r[q] = ld_slice_row(slice, (int)((idp[g >> 1] >> (16 * (g & 1))) & 0xFFFFu), j); }
}
template <int G0> __device__ __forceinline__ void f_compute(const v6u_t (&r)[GF], const unsigned (&avp)[8], v32h_t& acc) {
#pragma unroll
    for (int q = 0; q < GF; ++q) { const int g = G0 + q; const v32h_t vf = __builtin_amdgcn_cvt_scalef32_pk32_f16_fp6(r[q], 1.0f); const unsigned aw = avp[g >> 1]; const _Float16 a = __builtin_bit_cast(_Float16, (unsigned short)((g & 1) ? (aw >> 16) : (aw & 0xFFFFu)));
        acc = __builtin_elementwise_fma(vf, (v32h_t)a, acc);
        __builtin_amdgcn_sched_barrier(0); }
}
__device__ __forceinline__ void ld8u(unsigned (&d)[8], const void* p) { const GAS v4u* r = (const GAS v4u*)p; const v4u a = r[0], b = r[1]; d[0] = a.x; d[1] = a.y; d[2] = a.z; d[3] = a.w; d[4] = b.x; d[5] = b.y; d[6] = b.z; d[7] = b.w; }
__device__ __forceinline__ void peer_f_phase(const unsigned char* V6s, const unsigned short* IDS16, const unsigned short* AW16, unsigned char* F8  , int s, int wv, int nwv, int lane) {
    const int e = lane >> 3, j = lane & 7; const unsigned char* Vs = V6s + (size_t)s * SLICE_BYTES;
    constexpr int n_oct = T >> 3; int oct = wv, c = 0; if (oct >= n_oct) return;
#define STEP_NEXT(oa, ca, ob, cb) do { ob = oa; cb = ca + 1; if (cb == 8) { cb = 0; ob = oa + nwv; } if (ob >= n_oct) { ob = oa; cb = ca; } } while (0)
#define STEP_OFS(o, cc) ((size_t)((o) * 8 + e) * 128 + (cc) * 16)
    int o1, c1; STEP_NEXT(oct, c, o1, c1);
    unsigned idn[8], idnn[8], avc[8], avn[8];
    { unsigned id0[8]; ld8u(id0, IDS16 + STEP_OFS(oct, c)); ld8u(avc, AW16 + STEP_OFS(oct, c)); ld8u(idn, IDS16 + STEP_OFS(o1, c1));
      v6u_t b0[GF], b1[GF], b2[GF], b3[GF];
      rows_issue4<0>(b0, Vs, id0, j); rows_issue4<4>(b1, Vs, id0, j); rows_issue4<8>(b2, Vs, id0, j); rows_issue4<12>(b3, Vs, id0, j);
      v32h_t acc = (v32h_t)(_Float16)0;
#pragma unroll 1
      for (;;) {
        const bool last = (o1 == oct && c1 == c);
        int o2, c2; STEP_NEXT(o1, c1, o2, c2);
        ld8u(idnn, IDS16 + STEP_OFS(o2, c2)); ld8u(avn, AW16 + STEP_OFS(o1, c1));
        const size_t zoff = (size_t)(oct * 8 + e) * DM + s * 256 + j * 32;
        __builtin_amdgcn_sched_barrier(0);
        f_compute<0>(b0, avc, acc);
        __builtin_amdgcn_sched_barrier(0);
        rows_issue4<0>(b0, Vs, idn, j);
        __builtin_amdgcn_sched_barrier(0);
        f_compute<4>(b1, avc, acc);
        __builtin_amdgcn_sched_barrier(0);
        rows_issue4<4>(b1, Vs, idn, j);
        __builtin_amdgcn_sched_barrier(0);
        f_compute<8>(b2, avc, acc);
        __builtin_amdgcn_sched_barrier(0);
        rows_issue4<8>(b2, Vs, idn, j);
        __builtin_amdgcn_sched_barrier(0);
        f_compute<12>(b3, avc, acc);
        __builtin_amdgcn_sched_barrier(0);
        rows_issue4<12>(b3, Vs, idn, j);
        __builtin_amdgcn_sched_barrier(0);
        if (c == 7) {
            GAS v4u* fo = (GAS v4u*)(F8 + zoff);
#pragma unroll
            for (int q = 0; q < 2; ++q) { v4u o;
#pragma unroll
                for (int i = 0; i < 4; ++i) { const int b = 16 * q + 4 * i; o[i] = pack_fp8x4((float)acc[b] * F8_F, (float)acc[b + 1] * F8_F, (float)acc[b + 2] * F8_F, (float)acc[b + 3] * F8_F); }
                fo[q] = o; }
            acc = (v32h_t)(_Float16)0;
        }
        if (last) break;
#pragma unroll
        for (int i = 0; i < 8; ++i) { idn[i] = idnn[i]; avc[i] = avn[i]; }
        oct = o1; c = c1; o1 = o2; c1 = c2;
      }
    }
#undef STEP_NEXT
#undef STEP_OFS
}
__device__ __forceinline__ void ln_rows_bf16_to_f32(const unsigned char* X8  , const float* SX, const unsigned char* GP8, const unsigned char* F8, float* out, const float* g, const float* bta, int gw, int ngw, int lane) {
    int t = gw; if (t >= T) return;
    f32x4 gg[8], bb[8]; v2u_t xw[4], gq[4], fw[4]; float sx;
#pragma unroll
    for (int q = 0; q < 4; ++q) { const GAS f32x4* gp = (const GAS f32x4*)(g + q * 512 + lane * 8); const GAS f32x4* bp = (const GAS f32x4*)(bta + q * 512 + lane * 8);
        gg[2 * q] = gp[0]; gg[2 * q + 1] = gp[1]; bb[2 * q] = bp[0]; bb[2 * q + 1] = bp[1];
        const size_t o = (size_t)t * DM + q * 512 + lane * 8; xw[q] = *(const GAS v2u_t*)(X8 + o); gq[q] = *(const GAS v2u_t*)(GP8 + o); fw[q] = *(const GAS v2u_t*)(F8 + o); }
    sx = SX[t];
#pragma unroll 1
    for (;;) {
        const int tn = t + ngw; const bool has = tn < T; const int tl = has ? tn : t; v2u_t nx[4], ng[4], nf[4];
#pragma unroll
        for (int q = 0; q < 4; ++q) { const size_t o = (size_t)tl * DM + q * 512 + lane * 8; nx[q] = *(const GAS v2u_t*)(X8 + o); ng[q] = *(const GAS v2u_t*)(GP8 + o); nf[q] = *(const GAS v2u_t*)(F8 + o); }
        const float nsx = SX[tl];
        f32x4 v[8]; float s = 0.f; const float sa = sx * ALPHA;
#pragma unroll
        for (int q = 0; q < 4; ++q) { const int xlo = (int)xw[q].x, xhi = (int)xw[q].y;
            const f32x4 g0 = unpack_fp8x4(gq[q].x), g1 = unpack_fp8x4(gq[q].y), f0 = unpack_fp8x4(fw[q].x), f1 = unpack_fp8x4(fw[q].y);
#pragma unroll
            for (int i = 0; i < 4; ++i) { v[2 * q][i] = (float)((xlo << (24 - 8 * i)) >> 24) * sa + g0[i] * (1.f / F8_PW) + f0[i] * (1.f / F8_F); v[2 * q + 1][i] = (float)((xhi << (24 - 8 * i)) >> 24) * sa + g1[i] * (1.f / F8_PW) + f1[i] * (1.f / F8_F); } }
#pragma unroll
        for (int q = 0; q < 8; ++q) s += (v[q].x + v[q].y) + (v[q].z + v[q].w);
        const float mean = wave_sum(s) * (1.f / DM); float s2 = 0.f;
#pragma unroll
        for (int q = 0; q < 8; ++q) { v[q] = v[q] - mean; s2 += (v[q].x * v[q].x + v[q].y * v[q].y) + (v[q].z * v[q].z + v[q].w * v[q].w); }
        const float rstd = 1.f / sqrtf(wave_sum(s2) * (1.f / DM) + LN_EPS);
#pragma unroll
        for (int q = 0; q < 4; ++q) { GAS f32x4* op = (GAS f32x4*)(out + (size_t)t * DM + q * 512 + lane * 8);
            op[0] = v[2 * q] * rstd * gg[2 * q] + bb[2 * q]; op[1] = v[2 * q + 1] * rstd * gg[2 * q + 1] + bb[2 * q + 1]; }
        if (!has) break;
#pragma unroll
        for (int q = 0; q < 4; ++q) { xw[q] = nx[q]; gq[q] = ng[q]; fw[q] = nf[q]; }
        sx = nsx; t = tn;
    }
}
template <bool MFMA_IMG> __device__ __forceinline__ void cvt_stream_fp6(const float* src, unsigned char* dst, float scale, size_t i0, size_t i1  , size_t gtid, size_t nthr) {
    for (size_t i = i0 + gtid; i < i1; i += nthr) { const GAS f32x4* sp = (const GAS f32x4*)src + 8 * i; v16f_t lo, hi;
#pragma unroll
        for (int q = 0; q < 8; ++q) { const f32x4 a = sp[q] * scale;
#pragma unroll
            for (int c = 0; c < 4; ++c) { const int el = 4 * q + c;
                if (FP6_INTERLEAVED) { if (el & 1) hi[el >> 1] = a[c]; else lo[el >> 1] = a[c]; } else { if (el < 16) lo[el] = a[c]; else hi[el - 16] = a[c]; } } }
        const v6u_t p = __builtin_amdgcn_cvt_scalef32_2xpk16_fp6_f32(lo, hi, 1.0f);
        const int row = (int)(i >> 6), blk = (int)(i & 63), sl = blk >> 3, jb = blk & 7; unsigned char* r = dst + (size_t)sl * SLICE_BYTES;
        if (MFMA_IMG) { unsigned char* rr = r + (size_t)row * SLICE_ROWB + (jb & 3) * 16; const int cb = jb >> 2;
            *(GAS v4u*)(rr + cb * 64) = (v4u){p[0], p[1], p[2], p[3]}; *(GAS v2u_t*)(rr + 128 + cb * 8) = (v2u_t){p[4], p[5]}; }
        else { *(GAS v4u*)(r + slice_off16(row, jb)) = (v4u){p[0], p[1], p[2], p[3]}; *(GAS v2u_t*)(r + slice_off8(row, jb)) = (v2u_t){p[4], p[5]}; } }
}
__device__ __forceinline__ void cvt_stream_fp4(const float* src, unsigned char* dst, float scale, size_t i0, size_t i1, size_t gtid, size_t nthr) {
    for (size_t i = i0 + gtid; i < i1; i += nthr) { const GAS f32x4* sp = (const GAS f32x4*)src + 8 * i; unsigned w[4] = {0u, 0u, 0u, 0u};
#pragma unroll
        for (int q = 0; q < 8; ++q) { const f32x4 a = sp[q] * scale;
            if (q & 1) { w[q >> 1] = __builtin_amdgcn_cvt_scalef32_pk_fp4_f32(w[q >> 1], a.x, a.y, 1.0f, 2); w[q >> 1] = __builtin_amdgcn_cvt_scalef32_pk_fp4_f32(w[q >> 1], a.z, a.w, 1.0f, 3); }
            else       { w[q >> 1] = __builtin_amdgcn_cvt_scalef32_pk_fp4_f32(w[q >> 1], a.x, a.y, 1.0f, 0); w[q >> 1] = __builtin_amdgcn_cvt_scalef32_pk_fp4_f32(w[q >> 1], a.z, a.w, 1.0f, 1); } }
        const int row = (int)(i >> 6), blk = (int)(i & 63), sl = blk >> 3, jb = blk & 7;
        *(GAS v4u*)(dst + (size_t)sl * SLICE_BYTES_U + (size_t)row * SLICE_ROWB_U + jb * 16) = (v4u){w[0], w[1], w[2], w[3]}; }
}

__device__ __forceinline__ void fold_pool_block(const float* WBP, const float* WG, const float* SCL, float* WF, gu32* amax_word, int blk, int lane) {
    const int g = blk >> 9, i0 = ((blk >> 6) & 7) * 32, n0 = (blk & 63) * 32, r = lane & 31, h = lane >> 5;
    const GAS float* ap = (const GAS float*)WBP + (size_t)(g * 256 + 8 * h) * DM + n0 + r;
    const GAS float* bp = (const GAS float*)WG + (size_t)g * 65536 + (size_t)(i0 + r) * 256 + 8 * h;
    const GAS float* sp = (const GAS float*)SCL + g * 256 + 8 * h;
    f32x16 acc = {};
#pragma unroll 4
    for (int ks = 0; ks < 16; ++ks) {
        f32x4 a0, a1;
#pragma unroll
        for (int jj = 0; jj < 4; ++jj) { a0[jj] = ap[(size_t)(16 * ks + jj) * DM]; a1[jj] = ap[(size_t)(16 * ks + 4 + jj) * DM]; }
        const f32x4 b0 = *(const GAS f32x4*)(bp + 16 * ks) * *(const GAS f32x4*)(sp + 16 * ks), b1 = *(const GAS f32x4*)(bp + 16 * ks + 4) * *(const GAS f32x4*)(sp + 16 * ks + 4);
        acc = __builtin_amdgcn_mfma_f32_32x32x16_bf16(__builtin_bit_cast(bf16x8, pg8::pack8(a0, a1)), __builtin_bit_cast(bf16x8, pg8::pack8(b0, b1)), acc, 0, 0, 0);
    }
    float m = 0.f;
#pragma unroll
    for (int q = 0; q < 16; ++q) { const int row = (q & 3) + 8 * (q >> 2) + 4 * h; *((GAS float*)WF + (size_t)(n0 + row) * PW_ + g * 256 + i0 + r) = acc[q]; m = fmaxf(m, fabsf(acc[q])); }
    m = wave_max(m);
    if (lane == 0) __hip_atomic_fetch_max(amax_word, __float_as_uint(m), RLX_AGENT);
}
__device__ __forceinline__ void quant_fold(const float* WF, unsigned char* W8, float inv, size_t gtid, size_t nthr) {
    for (size_t i = gtid; i < (size_t)DM * PW_ / 16; i += nthr) { const GAS f32x4* sp = (const GAS f32x4*)WF + 4 * i; v4u o;
#pragma unroll
        for (int q = 0; q < 4; ++q) { const f32x4 a = sp[q] * inv; o[q] = q8(a.x) | (q8(a.y) << 8) | (q8(a.z) << 16) | (q8(a.w) << 24); }
        ((GAS v4u*)W8)[i] = o; }
}

struct FInProj { bf16 *XP, *Q, *K, *V; unsigned char *G0, *G1; const float* gate_b; int col0;
    struct Pre { f32x4 b0, b1; };
    __device__ __forceinline__ Pre load(int, int col_) const { const int col = col_ + col0, gc = col >= 4096 ? col - 4096 : 0;
        const float* gb = gate_b + gc; Pre p; p.b0 = *(const GAS f32x4*)gb; p.b1 = *(const GAS f32x4*)(gb + 4); return p; }
    __device__ __forceinline__ void operator()(int row, int col_, const f32x4 v0, const f32x4 v1, const Pre& pr) const {
        const int col = col_ + col0, t = col >> 10;
        if (t < 4) { bf16* base = t == 0 ? XP : t == 1 ? Q : t == 2 ? K : V; const float qs = t == 1 ? attn::SC : 1.f;
            *(GAS v4u*)(base + (size_t)row * 1024 + (col & 1023)) = pg8::pack8(v0 * qs, v1 * qs); }
        else { unsigned char* base = t < 6 ? G0 : G1; const int c = col & 2047; const f32x4 b0 = pr.b0, b1 = pr.b1; unsigned lo = 0u, hi = 0u;
#pragma unroll
            for (int i = 0; i < 4; ++i) { lo |= ((unsigned)__builtin_rintf(pg8::sigm(v0[i] + b0[i]) * 255.f)) << (8 * i); hi |= ((unsigned)__builtin_rintf(pg8::sigm(v1[i] + b1[i]) * 255.f)) << (8 * i); }
            *(GAS unsigned long long*)(base + (size_t)row * DM + c) = (unsigned long long)lo | ((unsigned long long)hi << 32); } } };
struct FGate8 { const unsigned char* G; unsigned char* M8;
    typedef unsigned long long Pre;
    __device__ __forceinline__ Pre load(int row, int col) const { return *(const GAS unsigned long long*)(G + (size_t)row * DM + col); }
    __device__ __forceinline__ void operator()(int row, int col, const f32x4 v0, const f32x4 v1, const Pre gw) const {
        const size_t off = (size_t)row * DM + col; const unsigned lo = (unsigned)gw, hi = (unsigned)(gw >> 32);
        f32x4 o0, o1;
#pragma unroll
        for (int i = 0; i < 4; ++i) { o0[i] = (float)((lo >> (8 * i)) & 255u) * (F8_M / 255.f) * v0[i]; o1[i] = (float)((hi >> (8 * i)) & 255u) * (F8_M / 255.f) * v1[i]; }
        *(GAS v2u_t*)(M8 + off) = (v2u_t){pack_fp8x4(o0.x, o0.y, o0.z, o0.w), pack_fp8x4(o1.x, o1.y, o1.z, o1.w)}; } };
struct FResid { const unsigned char* X8; const float* SX; bf16* Z;
    struct Pre { unsigned long long xw; float sx; };
    __device__ __forceinline__ Pre load(int row, int col) const { Pre p; p.xw = *(const GAS unsigned long long*)(X8 + (size_t)row * DM + col); p.sx = SX[row]; return p; }
    __device__ __forceinline__ void operator()(int row, int col, const f32x4 v0, const f32x4 v1, const Pre& pr) const {
        const size_t off = (size_t)row * DM + col; const unsigned long long xw = pr.xw; const int xlo = (int)(unsigned)xw, xhi = (int)(unsigned)(xw >> 32); const float sa = pr.sx * ALPHA;
        f32x4 o0, o1;
#pragma unroll
        for (int i = 0; i < 4; ++i) { o0[i] = (float)((xlo << (24 - 8 * i)) >> 24) * sa + v0[i]; o1[i] = (float)((xhi << (24 - 8 * i)) >> 24) * sa + v1[i]; }
        *(GAS v4u*)(Z + off) = pg8::pack8(o0, o1); } };
struct NoPre {};
struct FStore { bf16* O; int ldc; typedef NoPre Pre;
    __device__ __forceinline__ Pre load(int, int) const { return Pre{}; }
    __device__ __forceinline__ void operator()(int row, int col, const f32x4 v0, const f32x4 v1, const Pre&) const { *(GAS v4u*)(O + (size_t)row * ldc + col) = pg8::pack8(v0, v1); } };
struct FStore8 { unsigned char* O; int ldc; float scale;
    typedef NoPre Pre;
    __device__ __forceinline__ Pre load(int, int) const { return Pre{}; }
    __device__ __forceinline__ void operator()(int row, int col, const f32x4 v0, const f32x4 v1, const Pre&) const { const f32x4 a = v0 * scale, b = v1 * scale;
        *(GAS v2u_t*)(O + (size_t)row * ldc + col) = (v2u_t){pack_fp8x4(a.x, a.y, a.z, a.w), pack_fp8x4(b.x, b.y, b.z, b.w)}; } };
struct FGateE { const unsigned char* PW8; unsigned char* GP8;
    typedef v2u_t Pre;
    __device__ __forceinline__ Pre load(int row, int col) const { return *(const GAS v2u_t*)(PW8 + (size_t)row * DM + col); }
    __device__ __forceinline__ void operator()(int row, int col, const f32x4 v0, const f32x4 v1, const Pre pw) const {
        const size_t off = (size_t)row * DM + col; const f32x4 p0 = unpack_fp8x4(pw.x), p1 = unpack_fp8x4(pw.y);
        f32x4 o0, o1;
#pragma unroll
        for (int i = 0; i < 4; ++i) { o0[i] = pg8::sigm(v0[i]) * p0[i]; o1[i] = pg8::sigm(v1[i]) * p1[i]; }
        *(GAS v2u_t*)(GP8 + off) = (v2u_t){pack_fp8x4(o0.x, o0.y, o0.z, o0.w), pack_fp8x4(o1.x, o1.y, o1.z, o1.w)}; } };
#ifndef REP_PH
#define REP_PH -1
#endif
#ifndef REP_N
#define REP_N 2
#endif
#define REPS(k) _Pragma("unroll") for (int rep_ = 0; rep_ < ((k) == REP_PH ? REP_N : 1); ++rep_)
__global__ void __launch_bounds__(NWAVES * 64, 2) mk_fwd(Args args) {
    extern __shared__ __attribute__((aligned(16))) unsigned char lds[];
    Frame F;
    F.lds = (LAS unsigned char*)lds;
    F.MISC = (volatile LAS unsigned*)(F.lds + MISC_OFF);
    F.tid = threadIdx.x; F.lane = F.tid & 63; F.wave = __builtin_amdgcn_readfirstlane(F.tid >> 6);
#define TID_NOW() (F.wave * 64 + lane_id_now())
    F.G = gridDim.x; { const int bx = blockIdx.x; F.vcu = (F.G % 8 == 0) ? (bx % 8) * (F.G / 8) + bx / 8 : bx; }
    unsigned char* ws = args.ws;
    F.ctl = (gu32*)(ws + WS_CTL);
    for (int u = F.tid; u < (LDS_BYTES - LDSCTL_OFF) / 4; u += NWAVES * 64) ((LAS unsigned*)(F.lds + LDSCTL_OFF))[u] = 0u;
    __syncthreads();
    XcdBarrier bar; bar.bar = (unsigned*)(F.ctl + CW_BAR); bar.x = 0; bar.st = nullptr;
    if (N_LAUNCHES == 1) bar = xcd_barrier_post((unsigned*)(F.ctl + CW_BAR), F.MISC + 8);
#define GRID_BAR() do { if (N_LAUNCHES == 1) xcd_barrier(bar, TID_NOW() == 0); } while (0)
#define GRID_ARRIVE() do { if (N_LAUNCHES == 1) xcd_barrier_arrive(bar, TID_NOW() == 0); } while (0)
#define GRID_WAIT() do { if (N_LAUNCHES == 1) xcd_barrier_wait(bar, TID_NOW() == 0); } while (0)
    const int lo = args.ph_lo, hi = args.ph_hi;
#ifdef PH_ONLY
#define IN(k) ((k) == PH_ONLY)
#else
#define IN(k) (lo <= (k) && (k) < hi)
#endif
#define BOTH(k) (IN(k) && IN((k) + 1))
    const int NGW = F.G * NWAVES; const size_t nthr = (size_t)F.G * (NWAVES * 64);
#define PHASE_IDS() int tid_ = TID_NOW(); asm volatile("" : "+v"(tid_)); const int lane_ = tid_ & 63; const int wave_ = __builtin_amdgcn_readfirstlane(tid_ >> 6); \
    const int gw = F.vcu * NWAVES + wave_; const size_t gtid = (size_t)F.vcu * (NWAVES * 64) + tid_; (void)lane_; (void)gw; (void)gtid
#define KA_PTR() const __attribute__((address_space(4))) char* ka_ = (const __attribute__((address_space(4))) char*)__builtin_amdgcn_kernarg_segment_ptr(); asm volatile("" : "+s"(ka_))
#define KIN(i) (*(const float* const __attribute__((address_space(4)))*)(ka_ + 8 * (i)))
#define KOUT() (*(float* const __attribute__((address_space(4)))*)(ka_ + 8 * 28))
    bf16* WBP_T = (bf16*)(ws + WS_WBP); bf16* WBA_T = (bf16*)(ws + WS_WBA); bf16* WOUT_T = (bf16*)(ws + WS_WOUT); bf16* WQG_T = (bf16*)(ws + WS_WQG);
    bf16* PLEW_T = (bf16*)(ws + WS_PLEW); bf16* POOLW_T = (bf16*)(ws + WS_POOLW); unsigned char* UB = ws + WS_U; unsigned char* VB = ws + WS_V;
    bf16* XN = (bf16*)(ws + WS_XN); bf16* PB = (bf16*)(ws + WS_PB); bf16* XP = (bf16*)(ws + WS_XP); bf16* QB = (bf16*)(ws + WS_Q); bf16* MIX = (bf16*)(ws + WS_MIX); bf16* YP = (bf16*)(ws + WS_YP);
    bf16* KB = (bf16*)(ws + WS_K); bf16* VVB = (bf16*)(ws + WS_VV); bf16* G0 = (bf16*)(ws + WS_G0); bf16* G1 = (bf16*)(ws + WS_G1);
    bf16* YA = (bf16*)(ws + WS_YA); bf16* MERGED = (bf16*)(ws + WS_MERGED); bf16* MERGED2 = (bf16*)(ws + WS_MERGED2); bf16* Z1 = (bf16*)(ws + WS_Z1); bf16* X1 = (bf16*)(ws + WS_X1); bf16* PWB = (bf16*)(ws + WS_PWB);
    bf16* QP = (bf16*)(ws + WS_QP); bf16* ZE = (bf16*)(ws + WS_ZE); int* IDS = (int*)(ws + WS_IDS); float* GATES = (float*)(ws + WS_GATES);

#define INV_SCALE(cw) (127.f / fmaxf(__uint_as_float(__hip_atomic_load(F.ctl + (cw), RLX_AGENT)), 1e-20f))
#define XPOSE_I8(idx, K_, N_, dst, cw) do { PHASE_IDS(); KA_PTR(); const float inv_ = INV_SCALE(cw); LAS float* scr_ = (LAS float*)(F.lds + RING_OFF + wave_ * 16384); \
        for (int it_ = gw; it_ < ((K_) / 64) * ((N_) / 32); it_ += NGW) p0_transpose_item_i8(KIN(idx), K_, N_, dst, scr_, it_, lane_, inv_); } while (0)
#define TABLE_PART(IMG, idx, dst, scale, part, nparts) do { PHASE_IDS(); KA_PTR(); constexpr size_t nb_ = (size_t)NEXP * DM / 32; \
        if (IMG && U_FP4) cvt_stream_fp4(KIN(idx), dst, scale, nb_ * (part) / (nparts), nb_ * ((part) + 1) / (nparts), gtid, nthr); \
        else cvt_stream_fp6<IMG>(KIN(idx), dst, scale, nb_ * (part) / (nparts), nb_ * ((part) + 1) / (nparts), gtid, nthr); } while (0)
    if (IN(0)) {
        { PHASE_IDS(); KA_PTR();
          absmax_stream(KIN(4), (size_t)DM * IN_COLS / 4, F.ctl + CW_WMAX_IN, gtid, nthr, lane_); absmax_stream(KIN(24), (size_t)DM * DM / 4, F.ctl + CW_WMAX_G, gtid, nthr, lane_);
          absmax_stream(KIN(13), (size_t)PW_ * DM / 4, F.ctl + CW_WMAX_BA, gtid, nthr, lane_); absmax_stream(KIN(15), (size_t)DM * DM / 4, F.ctl + CW_WMAX_O, gtid, nthr, lane_);
          absmax_stream(KIN(18), (size_t)DM * DM / 4, F.ctl + CW_WMAX_Q, gtid, nthr, lane_);
          }
        GRID_ARRIVE();
        { PHASE_IDS(); KA_PTR();
          ln0_rows(lane_, KIN(0), KIN(2), KIN(3), ws + WS_XN8, (float*)(ws + WS_SXN), gw, NGW); }
        GRID_WAIT();
        constexpr int I_IN = (DM / 64) * (IN_COLS / 32), I_BR = (PW_ / 64) * (DM / 32), I_SQ = (DM / 64) * (DM / 32), I_PLE = (PLE / 64) * (DM / 32), I_PG = (256 / 64) * (256 / 32);
        { PHASE_IDS(); KA_PTR();
          const float inv_win = 127.f / fmaxf(__uint_as_float(__hip_atomic_load(F.ctl + CW_WMAX_IN, RLX_AGENT)), 1e-20f);
          LAS float* scr = (LAS float*)(F.lds + RING_OFF + wave_ * 16384);
          for (int it = gw; it < I_IN; it += NGW) p0_transpose_item_i8(KIN(4), DM, IN_COLS, ws + WS_WIN8, scr, it, lane_, inv_win); }
        GRID_ARRIVE();
        XPOSE_I8(13, PW_, DM, (unsigned char*)WBA_T, CW_WMAX_BA);
        { PHASE_IDS(); KA_PTR(); LAS float* scr = (LAS float*)(F.lds + RING_OFF + wave_ * 16384);
          for (int it = gw; it < I_PLE; it += NGW) p0_transpose_item(KIN(23), PLE, DM, PLEW_T, 0, scr, it, lane_);
          for (int blk = gw; blk < 4 * 8 * 64; blk += NGW) fold_pool_block(KIN(12), KIN(5), KIN(6), (float*)(ws + WS_WFOLD), F.ctl + CW_WMAX_F, blk, lane_);
          cvt_stream(KIN(1), PB, (size_t)T * PLE / 8, gtid, nthr); }
        if (BOTH(0)) GRID_WAIT();
    }
    if (IN(1)) {
#define P1_HALF(part) do { pg8::Gemm g{(const bf16*)(ws + WS_XN8), (const bf16*)(ws + WS_WIN8 + (size_t)(part) * (IN_COLS / 2) * DM), DM / 2, DM / 2, DM / 2, 0u, 256u * (DM / 2)}; pg8::StaticOrder S; S.init(T, IN_COLS / 2, F.G, (int)blockIdx.x); \
            const float s_win = __uint_as_float(__hip_atomic_load(F.ctl + CW_WMAX_IN, RLX_AGENT)) * (1.f / 127.f); \
            KA_PTR(); pg8::Row8<FInProj, true> E{{XP, QB, KB, VVB, (unsigned char*)G0, (unsigned char*)G1, KIN(14), (part) * (IN_COLS / 2)}, (const float*)(ws + WS_SXN), s_win}; \
            pg8::gemm_phase<pg8::Row8<FInProj, true>, pg8::StaticOrder, true, true>(F.lds + RING_OFF, g, S, E, TID_NOW()); } while (0)
        P1_HALF(0);
        GRID_ARRIVE();
        P1_HALF(1);
        if (BOTH(1)) GRID_WAIT();
    }
    if (IN(2)) { REPS(2) { PHASE_IDS(); pool_mix_quant_phase(XP, ws + WS_YP8, (float*)(ws + WS_SYP), (LAS float*)(F.lds + RING_OFF), F.vcu, F.G, tid_); } }
    if (IN(3)) {
        GRID_ARRIVE();
        { PHASE_IDS(); quant_fold((const float*)(ws + WS_WFOLD), (unsigned char*)WBP_T, INV_SCALE(CW_WMAX_F), gtid, nthr); }
        REPS(3) { int tl = TID_NOW(); asm volatile("" : "+v"(tl)); const int ll = tl & 63; KA_PTR();
          float d1 = KIN(7)[ll] * KIN(8)[ll], d2 = KIN(9)[ll] * KIN(10)[ll]; d1 = wave_sum(d1); d2 = wave_sum(d2);
          const float lam = expf(d1) - expf(d2) + 0.2f;
          float gm = fmaxf(fabsf(KIN(11)[ll]), fabsf(KIN(11)[64 + ll])); gm = fmaxf(wave_max(gm), 1e-20f); const float s_ya = gm * (0.8f * 11.313708499f / 127.f);
#define UNIFORM_F(x) __uint_as_float((unsigned)__builtin_amdgcn_readfirstlane((int)__float_as_uint(x)))
          const float lam_u = UNIFORM_F(lam), s_ya_u = UNIFORM_F(s_ya), inv_s_u = UNIFORM_F(1.f / s_ya);
          const attn::Params AP{QB, KB, VVB, ws + WS_YA8, (float*)(ws + WS_SYA), KIN(27), KIN(11), lam_u, inv_s_u, s_ya_u};
          for (int n = F.vcu; n < BATCH * attn::NHEAD * attn::NQB; n += F.G) { const int v = n & 255, i = n >> 8, bh = v >> 3, s = v & 7;
              const int qb = 8 * i + ((i & 1) ? 7 - s : s);
              int tlu = tl; asm volatile("" : "+v"(tlu));
              attn::attn_unit2(AP, bh >> 3, bh & 7, qb, (char*)lds + RING_OFF, tlu); }
          }
        GRID_WAIT();
        GRID_ARRIVE(); XPOSE_I8(15, DM, DM, (unsigned char*)WOUT_T, CW_WMAX_O); TABLE_PART(true, 21, UB, U_SCALE, 0, 2); GRID_WAIT();
    }
    if (IN(4)) {
        REPS(4) {
        pg8::Gemm g{(const bf16*)(ws + WS_YP8), WBP_T, PW_ / 2, PW_ / 2, PW_ / 2, 0u, 256u * (PW_ / 2)}; pg8::StaticOrder S; S.init(T, DM, F.G, (int)blockIdx.x);
        const float s_w = __uint_as_float(__hip_atomic_load(F.ctl + CW_WMAX_F, RLX_AGENT)) * (1.f / 127.f);
        pg8::Row8<FGate8, true> E{{(const unsigned char*)G0, ws + WS_MERGED}, (const float*)(ws + WS_SYP), s_w};
        pg8::gemm_phase<pg8::Row8<FGate8, true>, pg8::StaticOrder, true, true>(F.lds + RING_OFF, g, S, E, TID_NOW());
        }
        if (BOTH(4)) __syncthreads();
    }
    if (IN(5)) {
        REPS(5) {
        pg8::Gemm g{(const bf16*)(ws + WS_YA8), WBA_T, PW_ / 2, PW_ / 2, PW_ / 2, 0u, 256u * (PW_ / 2)}; pg8::StaticOrder S; S.init(T, DM, F.G, (int)blockIdx.x);
        const float s_w = __uint_as_float(__hip_atomic_load(F.ctl + CW_WMAX_BA, RLX_AGENT)) * (1.f / 127.f);
        pg8::Row8<FGate8, true> E{{(const unsigned char*)G1, ws + WS_MERGED + 64 * MiB}, (const float*)(ws + WS_SYA), s_w};
        pg8::gemm_phase<pg8::Row8<FGate8, true>, pg8::StaticOrder, true, true>(F.lds + RING_OFF, g, S, E, TID_NOW());
        }
        GRID_ARRIVE(); XPOSE_I8(18, DM, DM, (unsigned char*)WQG_T, CW_WMAX_Q); TABLE_PART(true, 21, UB, U_SCALE, 1, 2); GRID_WAIT();
    }
    if (IN(6)) {
        REPS(36) { PHASE_IDS(); quant_rows_sum8<2>(ws + WS_MERGED, ws + WS_MERGED + 64 * MiB, ws + WS_M28, (float*)(ws + WS_SM2), gw, NGW, lane_); }
        GRID_ARRIVE(); XPOSE_I8(24, DM, DM, ws + WS_WG8, CW_WMAX_G); GRID_WAIT();
        REPS(6) {
        pg8::Gemm g{(const bf16*)(ws + WS_M28), WOUT_T, DM / 2, DM / 2, DM / 2, 0u, 256u * (DM / 2)}; pg8::StaticOrder S; S.init(T, DM, F.G, (int)blockIdx.x);
        const float s_w = __uint_as_float(__hip_atomic_load(F.ctl + CW_WMAX_O, RLX_AGENT)) * (1.f / 127.f);
        pg8::Row8<FResid, true> E{{ws + WS_XN8, (const float*)(ws + WS_SXN), Z1}, (const float*)(ws + WS_SM2), s_w};
        pg8::gemm_phase<pg8::Row8<FResid, true>, pg8::StaticOrder, true, true>(F.lds + RING_OFF, g, S, E, TID_NOW());
        }
        GRID_ARRIVE(); TABLE_PART(false, 22, VB, V_SCALE, 0, 3); GRID_WAIT();
    }
    if (IN(7)) {
        REPS(7) {
        { PHASE_IDS(); KA_PTR(); ln_rows_bf16(Z1, ws + WS_X18, ws + WS_X6, (float*)(ws + WS_SX1), KIN(16), KIN(17), gw, NGW, lane_); }
        GRID_ARRIVE();
        pg8::Gemm g{PB, PLEW_T, PLE, PLE, PLE, 0u, 256u * PLE}; pg8::StaticOrder S; S.init(T, DM, F.G, (int)blockIdx.x);
        pg8::Row8<FStore8> E{{(unsigned char*)PWB, DM, F8_PW}};
        pg8::gemm_phase<pg8::Row8<FStore8>, pg8::StaticOrder, true, true>(F.lds + RING_OFF, g, S, E, TID_NOW());
        }
        if (BOTH(7)) GRID_WAIT();
    }
    if (IN(8)) {
        REPS(8) {
        { pg8::Gemm g{(const bf16*)(ws + WS_X18), WQG_T, DM / 2, DM / 2, DM / 2, 0u, 256u * (DM / 2)}; pg8::StaticOrder S; S.init(T, DM, F.G, (int)blockIdx.x);
          const float s_wq = __uint_as_float(__hip_atomic_load(F.ctl + CW_WMAX_Q, RLX_AGENT)) * (1.f / 127.f);
          pg8::Row8<FStore, true> E{{QP, DM}, (const float*)(ws + WS_SX1), s_wq};
          pg8::gemm_phase<pg8::Row8<FStore, true>, pg8::StaticOrder, true, true>(F.lds + RING_OFF, g, S, E, TID_NOW()); }
        GRID_ARRIVE();
        { pg8::Gemm g{(const bf16*)(ws + WS_X18), (const bf16*)(ws + WS_WG8), DM / 2, DM / 2, DM / 2, 0u, 256u * (DM / 2)}; pg8::StaticOrder S; S.init(T, DM, F.G, (int)blockIdx.x);
          const float s_wg = __uint_as_float(__hip_atomic_load(F.ctl + CW_WMAX_G, RLX_AGENT)) * (1.f / 127.f);
          pg8::Row8<FGateE, true> E{{(const unsigned char*)PWB, (unsigned char*)ZE}, (const float*)(ws + WS_SX1), s_wg};
          pg8::gemm_phase<pg8::Row8<FGateE, true>, pg8::StaticOrder, true, true>(F.lds + RING_OFF, g, S, E, TID_NOW()); }
        }
        if (BOTH(8)) GRID_WAIT();
    }
    if (IN(9)) {
        REPS(9) {
        PHASE_IDS(); KA_PTR();
        psel::load_keys((char*)lds + RING_OFF, KIN(19), KIN(20), tid_);
        __syncthreads();
        for (int task = gw; task < T / 4; task += NGW) psel::select_task((const char*)lds + RING_OFF, QP, task * 4, lane_, (unsigned short*)(ws + WS_IDS16), (unsigned short*)(ws + WS_GATES), (unsigned short*)(ws + WS_IDT));
        __syncthreads();
        }
        GRID_ARRIVE(); TABLE_PART(false, 22, VB, V_SCALE, 1, 3); GRID_WAIT();
    }
    const int sl_ = (int)blockIdx.x & 7, rk_ = (int)blockIdx.x >> 3, nwv_ = ((F.G - sl_ + 7) >> 3) * NWAVES;
    if (IN(10)) {
        REPS(10) { PHASE_IDS(); peer_h_phase(ws + WS_X6, (const float*)(ws + WS_SX1), UB, (const unsigned short*)(ws + WS_IDT), (unsigned short*)(ws + WS_HP), sl_, rk_ * NWAVES + wave_, nwv_, lane_); }
        GRID_ARRIVE(); TABLE_PART(false, 22, VB, V_SCALE, 2, 3); GRID_WAIT();
    }
    if (IN(11)) { REPS(11) { PHASE_IDS(); peer_a_phase((const unsigned*)(ws + WS_HP), (const unsigned*)(ws + WS_GATES), (unsigned*)(ws + WS_AW16), gtid, nthr); } if (BOTH(11)) GRID_BAR(); }
    if (IN(12)) {
        REPS(12) { PHASE_IDS(); peer_f_phase(VB, (const unsigned short*)(ws + WS_IDS16), (const unsigned short*)(ws + WS_AW16), ws + WS_Z, sl_, rk_ * NWAVES + wave_, nwv_, lane_); }
        if (BOTH(12)) GRID_BAR();
    }
    if (IN(13)) { REPS(13) { PHASE_IDS(); KA_PTR(); ln_rows_bf16_to_f32(ws + WS_X18, (const float*)(ws + WS_SX1), (const unsigned char*)ZE, ws + WS_Z, KOUT(), KIN(25), KIN(26), gw, NGW, lane_); } }
#undef IN
#undef BOTH
#undef GRID_BAR
}

extern "C" void kernel_launch(void* const* d_in, const int* in_sizes, int n_in, void* d_out, int out_size, void* d_ws, size_t ws_size, hipStream_t stream) {
    static int grid = 0;
    if (grid == 0) {
        if (n_in != 28 || in_sizes[0] != T * DM || out_size != T * DM || ws_size < WS_END) {
            fprintf(stderr, "kernel_launch: shape mismatch: n_in %d in0 %d out %d ws %zu (need %zu); nothing launched\n", n_in, n_in > 0 ? in_sizes[0] : -1, out_size, ws_size, (size_t)WS_END); grid = -1; return; }
        int dev = 0, cus = 0, per_cu = 0;
        if (hipGetDevice(&dev) != hipSuccess || hipDeviceGetAttribute(&cus, hipDeviceAttributeMultiprocessorCount, dev) != hipSuccess) { fprintf(stderr, "kernel_launch: device query failed\n"); grid = -1; return; }
        if (hipFuncSetAttribute((const void*)mk_fwd, hipFuncAttributeMaxDynamicSharedMemorySize, LDS_BYTES) != hipSuccess) { fprintf(stderr, "kernel_launch: hipFuncSetAttribute failed\n"); grid = -1; return; }
        if (hipOccupancyMaxActiveBlocksPerMultiprocessor(&per_cu, (const void*)mk_fwd, NWAVES * 64, LDS_BYTES) != hipSuccess || per_cu < 1)
            fprintf(stderr, "kernel_launch: note: occupancy query reports %d workgroups per CU\n", per_cu);
        (void)hipGetLastError();
        grid = cus;
    }
    if (grid < 0) return;
    if (hipMemsetAsync((char*)d_ws + WS_CTL, 0, CTL_ZERO_BYTES, stream) != hipSuccess) { fprintf(stderr, "kernel_launch: memset failed\n"); return; }
    Args a{};
    for (int i = 0; i < 28; ++i) a.in[i] = (const float*)d_in[i];
    a.out = (float*)d_out; a.ws = (unsigned char*)d_ws;
    for (int li = 0; li < N_LAUNCHES; ++li) {
        a.ph_lo = (N_LAUNCHES == 1) ? 0 : li; a.ph_hi = (N_LAUNCHES == 1) ? N_PHASES : li + 1; a.li = li; a.pad = 0;
        hipLaunchKernelGGL(mk_fwd, dim3(grid), dim3(NWAVES * 64), LDS_BYTES, stream, a);
        const hipError_t le = hipPeekAtLastError();
        if (le != hipSuccess) { fprintf(stderr, "kernel_launch: launch %d failed: %s\n", li, hipGetErrorName(le)); break; }
    }
}
```

```cpp
#include <hip/hip_runtime.h>
#include <cstdio>
#include <cstdint>
#include <type_traits>

#ifndef MK_N_LAUNCHES
#define MK_N_LAUNCHES 1
#endif

namespace pg8 {
#define PG8_LAS __attribute__((address_space(3)))
typedef unsigned short bf16_t;
typedef short bf16x8 __attribute__((ext_vector_type(8)));
typedef float f32x4 __attribute__((ext_vector_type(4)));
typedef unsigned u32x4 __attribute__((ext_vector_type(4)));
typedef int i32x4 __attribute__((ext_vector_type(4)));
constexpr int BM = 256, BK = 64, HALF = 128, HTB = HALF * BK * 2  , STAGE_BYTES = 8 * HTB, NXCD = 8, WGM = 8;

__host__ __device__ __forceinline__ int lds_byte(int r, int c) { const int st = (r >> 4) * 2 + (c >> 5), rr = r & 15, cc = c & 31, ob = rr * 64 + cc * 2; return st * 1024 + (ob ^ (((ob >> 9) & 1) << 5)); }
__host__ __device__ __forceinline__ void stage_rc(int b, int& R, int& C) { const int st = b / 1024, sb = b % 1024, swz = sb ^ (((sb >> 9) & 1) << 5); R = (st >> 1) * 16 + swz / 64; C = (st & 1) * 32 + (swz % 64) / 2; }
__host__ __device__ __forceinline__ int perm32(int rho) { const int n = rho >> 4, i = rho & 15; return 8 * (i >> 2) + 4 * n + (i & 3); }

struct Unit { int pm, pn; };
struct Gemm { const bf16_t* A; const bf16_t* Bt; int lda, ldb, K; unsigned a_pn_off, b_pn_step; };

struct StaticOrder {
    int nM, nN, nwg, G, c;
    __host__ __device__ void init(int M, int N, int G_, int c_) { nM = M / BM; nN = N / BM; nwg = nM * nN; G = G_; c = c_; }
    __host__ __device__ bool next(int i, Unit& u) const {
        const long L = (long)i * G + c; if (L >= nwg) return false;
        int wgid = (int)L; { const int q = nwg / NXCD, r = nwg % NXCD, xcd = wgid % NXCD, off = wgid / NXCD; wgid = (xcd < r ? xcd * (q + 1) : r * (q + 1) + (xcd - r) * q) + off; }
        const int nig = WGM * nN, gid = wgid / nig, fm = gid * WGM, gsz = (nM - fm) < WGM ? (nM - fm) : WGM;
        u.pm = fm + ((wgid % nig) % gsz); u.pn = (wgid % nig) / gsz; return true;
    }
    __device__ __forceinline__ void a_ready(const Unit&) const {}
    __device__ __forceinline__ void done(const Unit&) const {}
};

__device__ __forceinline__ unsigned cvt_pk_bf16(float lo, float hi) { unsigned r; asm volatile("v_cvt_pk_bf16_f32 %0, %1, %2" : "=v"(r) : "v"(lo), "v"(hi)); return r; }
__device__ __forceinline__ float bf_lo(unsigned w) { return __uint_as_float(w << 16); }
__device__ __forceinline__ float bf_hi(unsigned w) { return __uint_as_float(w & 0xffff0000u); }
__device__ __forceinline__ float sigm(float x) { return __builtin_amdgcn_rcpf(1.f + __builtin_amdgcn_exp2f(-1.4426950408889634f * x)); }
typedef float f32x2 __attribute__((ext_vector_type(2)));
__device__ __forceinline__ f32x2 gelu_pk(f32x2 v) {
    const f32x2 av = __builtin_elementwise_abs(v), d = av * 0.2316418882f + 1.0f;
    f32x2 t; t.x = __builtin_amdgcn_rcpf(d.x); t.y = __builtin_amdgcn_rcpf(d.y);
    f32x2 q = t * 0.5307027145f + (-0.7265760135f); q = q * t + 0.7107068705f; q = q * t + (-0.142248368f); q = q * t + 0.127414796f; q = q * t;
    const f32x2 s = (v * v) * (-0.72134752044f);
    f32x2 e; e.x = __builtin_amdgcn_exp2f(s.x); e.y = __builtin_amdgcn_exp2f(s.y);
    const f32x2 m = v * (q * e), r = v - m;
    f32x2 o; o.x = v.x < 0.f ? m.x : r.x; o.y = v.y < 0.f ? m.y : r.y; return o;
}
__device__ __forceinline__ u32x4 pack8(const f32x4 a, const f32x4 b) { u32x4 w; w.x = cvt_pk_bf16(a[0], a[1]); w.y = cvt_pk_bf16(a[2], a[3]); w.z = cvt_pk_bf16(b[0], b[1]); w.w = cvt_pk_bf16(b[2], b[3]); return w; }
__device__ __forceinline__ void unpack8(const u32x4 w, f32x4& a, f32x4& b) { a = (f32x4){bf_lo(w.x), bf_hi(w.x), bf_lo(w.y), bf_hi(w.y)}; b = (f32x4){bf_lo(w.z), bf_hi(w.z), bf_lo(w.w), bf_hi(w.w)}; }

template <class F, bool I8 = false> struct Row8 {
    static constexpr bool PERM = true, AFTER_DRAIN = false, INT8 = I8; F f; const float* rowscale; float wscale;
    typedef typename std::conditional<I8, i32x4, f32x4>::type acc_t;
    __device__ __forceinline__ void operator()(const acc_t (&acc)[2][2][4][2], const Unit& u, int wr, int wc, int fr, int fq) const {
        const int row0 = u.pm * BM + wr * 64 + fr, col0 = u.pn * BM + wc * 32 + 8 * fq;
        float rs[2][4]; typename F::Pre pre[2][4][2];
#pragma unroll
        for (int ai = 0; ai < 2; ++ai)
#pragma unroll
            for (int m = 0; m < 4; ++m) { const int row = row0 + ai * HALF + m * 16; rs[ai][m] = 1.f; if (I8) rs[ai][m] = rowscale[row] * wscale;
#pragma unroll
                for (int bj = 0; bj < 2; ++bj) pre[ai][m][bj] = f.load(row, col0 + bj * HALF); }
#pragma unroll
        for (int ai = 0; ai < 2; ++ai)
#pragma unroll
            for (int m = 0; m < 4; ++m) { const int row = row0 + ai * HALF + m * 16; const float r_ = rs[ai][m];
#pragma unroll
                for (int bj = 0; bj < 2; ++bj) { f32x4 v0, v1;
                    if constexpr (I8) { v0 = __builtin_convertvector(acc[ai][bj][m][0], f32x4) * r_; v1 = __builtin_convertvector(acc[ai][bj][m][1], f32x4) * r_; } else { v0 = acc[ai][bj][m][0]; v1 = acc[ai][bj][m][1]; }
                    f(row, col0 + bj * HALF, v0, v1, pre[ai][m][bj]); } }
    }
};

template <class Epi, class Sched, bool ALIGN_EPI = false, bool SP2 = false>
__device__ __forceinline__ void gemm_phase(PG8_LAS unsigned char* lds, const Gemm g, const Sched& S, const Epi& E, const int tid_in) {
    const int tid = tid_in, wid = __builtin_amdgcn_readfirstlane(tid >> 6), lane = tid & 63, wr = wid >> 2, wc = wid & 3, fr = lane & 15, fq = lane >> 4;
    const int K = g.K, nt = K / BK;
    unsigned voffA[2], voffB[2];
#pragma unroll
    for (int i = 0; i < 2; ++i) { int R, C; stage_rc(tid * 16 + i * 8192, R, C); const int Rb = Epi::PERM ? ((R & ~31) + perm32(R & 31)) : R;
        voffA[i] = (unsigned)(R * g.lda + C) * 2u; voffB[i] = (unsigned)(Rb * g.ldb + C) * 2u; }
    const size_t kstep = (size_t)(BK * 2);
    const size_t hstepA = (size_t)HALF * g.lda * 2, hstepB = (size_t)HALF * g.ldb * 2;
    const size_t tstepA = 2 * hstepA;
    const unsigned ldsw = (unsigned)wid * 1024u;
    const int aoff = lds_byte(wr * 64 + fr, fq * 8), boff = lds_byte(wc * 32 + fr, fq * 8);
#define PG8_SA(b, h) (((b) * 2 + (h)) * HTB)
#define PG8_SB(b, h) ((4 + (b) * 2 + (h)) * HTB)
#define PG8_STAGE(bufoff, gbase, voff) do { _Pragma("unroll") for (int _i = 0; _i < 2; ++_i) \
        __builtin_amdgcn_global_load_lds((const unsigned*)((const char*)(gbase) + (voff)[_i]), (PG8_LAS unsigned*)(lds + (bufoff) + ldsw + _i * 8192), 16, 0, 0); } while (0)
#define PG8_LDA(dst, b, h) do { _Pragma("unroll") for (int m = 0; m < 4; ++m) _Pragma("unroll") for (int k = 0; k < 2; ++k) dst[m][k] = *(const PG8_LAS bf16x8*)(lds + PG8_SA(b, h) + aoff + m * 2048 + k * 1024); } while (0)
#define PG8_LDB(dst, b, h) do { _Pragma("unroll") for (int n = 0; n < 2; ++n) _Pragma("unroll") for (int k = 0; k < 2; ++k) dst[n][k] = *(const PG8_LAS bf16x8*)(lds + PG8_SB(b, h) + boff + n * 2048 + k * 1024); } while (0)
#define PG8_MMA(ai, bj, At, Bt) do { __builtin_amdgcn_s_setprio(1); _Pragma("unroll") for (int k = 0; k < 2; ++k) _Pragma("unroll") for (int m = 0; m < 4; ++m) _Pragma("unroll") for (int n = 0; n < 2; ++n) \
        { if constexpr (Epi::INT8) acc[ai][bj][m][n] = __builtin_amdgcn_mfma_i32_16x16x64_i8(__builtin_bit_cast(i32x4, Bt[n][k]), __builtin_bit_cast(i32x4, At[m][k]), acc[ai][bj][m][n], 0, 0, 0); \
          else acc[ai][bj][m][n] = __builtin_amdgcn_mfma_f32_16x16x32_bf16(Bt[n][k], At[m][k], acc[ai][bj][m][n], 0, 0, 0); } __builtin_amdgcn_s_setprio(0); } while (0)
#define PG8_WAIT_V(n) asm volatile("s_waitcnt vmcnt(" #n ")" ::: "memory")
#define PG8_WAIT_L(n) asm volatile("s_waitcnt lgkmcnt(" #n ")" ::: "memory")
#define PG8_BAR __builtin_amdgcn_s_barrier()
#define PG8_SCHED __builtin_amdgcn_sched_barrier(0)
#define PG8_UA(u) ((const char*)g.A + (size_t)(u).pm * tstepA + (size_t)(u).pn * g.a_pn_off * 2)
#define PG8_UB(u) ((const char*)g.Bt + (size_t)(u).pn * g.b_pn_step * 2)
    Unit cur, nxt; int ui = 0;
    if (!S.next(0, cur)) return;
    typename Epi::acc_t acc[2][2][4][2];
#pragma unroll
    for (int a = 0; a < 2; ++a)
#pragma unroll
        for (int b = 0; b < 2; ++b)
#pragma unroll
            for (int m = 0; m < 4; ++m)
#pragma unroll
                for (int n = 0; n < 2; ++n) acc[a][b][m][n] = (typename Epi::acc_t){};
    bf16x8 At[4][2], B0[2][2], B1[2][2];
    const char* cA = PG8_UA(cur); const char* cB = PG8_UB(cur);
    S.a_ready(cur);
    if constexpr (SP2) {
        PG8_STAGE(PG8_SB(0, 0), cB, voffB); PG8_STAGE(PG8_SB(0, 1), cB + hstepB, voffB); PG8_STAGE(PG8_SA(0, 0), cA, voffA); PG8_STAGE(PG8_SA(0, 1), cA + hstepA, voffA);
        if (wr == 1) PG8_BAR;
        PG8_WAIT_V(2); PG8_BAR;
        PG8_STAGE(PG8_SB(1, 0), cB + kstep, voffB); PG8_STAGE(PG8_SA(1, 0), cA + kstep, voffA); PG8_STAGE(PG8_SB(1, 1), cB + hstepB + kstep, voffB);
        PG8_WAIT_V(6); PG8_BAR;
    } else {
        PG8_STAGE(PG8_SB(0, 0), cB, voffB); PG8_STAGE(PG8_SA(0, 0), cA, voffA); PG8_STAGE(PG8_SB(0, 1), cB + hstepB, voffB); PG8_STAGE(PG8_SA(0, 1), cA + hstepA, voffA);
        if (wr == 1) PG8_BAR;
        PG8_WAIT_V(4); PG8_BAR;
        PG8_STAGE(PG8_SB(1, 0), cB + kstep, voffB); PG8_STAGE(PG8_SA(1, 0), cA + kstep, voffA); PG8_STAGE(PG8_SB(1, 1), cB + hstepB + kstep, voffB);
        PG8_WAIT_V(6); PG8_BAR;
    }
    for (;;) {
        const bool has_next = S.next(ui + 1, nxt);
        const char* nA = has_next ? PG8_UA(nxt) : cA; const char* nB = has_next ? PG8_UB(nxt) : cB;
        for (int t = 0; t < nt; t += 2) {
            const bool last = (t == nt - 2);
            const char* a1 = cA + (size_t)(t + 1) * kstep;
            const char* a2 = last ? nA : cA + (size_t)(t + 2) * kstep; const char* b2 = last ? nB : cB + (size_t)(t + 2) * kstep;
            const char* a3 = a2 + kstep; const char* b3 = b2 + kstep;
            if (last && has_next) S.a_ready(nxt);
            if constexpr (SP2) {
            PG8_LDB(B0, 0, 0); PG8_LDB(B1, 0, 1); PG8_SCHED; PG8_LDA(At, 0, 0); PG8_STAGE(PG8_SA(1, 1), a1 + hstepA, voffA);
            PG8_WAIT_V(8); PG8_WAIT_L(0); PG8_BAR; PG8_MMA(0, 0, At, B0); PG8_MMA(0, 1, At, B1); PG8_BAR; PG8_SCHED;
            PG8_LDA(At, 0, 1); PG8_STAGE(PG8_SB(0, 0), b2, voffB); PG8_STAGE(PG8_SB(0, 1), b2 + hstepB, voffB); PG8_STAGE(PG8_SA(0, 0), a2, voffA);
            PG8_WAIT_V(8); PG8_WAIT_L(0); PG8_BAR; PG8_MMA(1, 0, At, B0); PG8_MMA(1, 1, At, B1); PG8_BAR; PG8_SCHED;
            PG8_LDB(B0, 1, 0); PG8_LDB(B1, 1, 1); PG8_SCHED; PG8_LDA(At, 1, 0); PG8_STAGE(PG8_SA(0, 1), a2 + hstepA, voffA);
            PG8_WAIT_V(8); PG8_WAIT_L(0); PG8_BAR; PG8_MMA(0, 0, At, B0); PG8_MMA(0, 1, At, B1); PG8_BAR; PG8_SCHED;
            PG8_LDA(At, 1, 1); PG8_STAGE(PG8_SB(1, 0), b3, voffB); PG8_STAGE(PG8_SB(1, 1), b3 + hstepB, voffB); PG8_STAGE(PG8_SA(1, 0), a3, voffA);
            PG8_WAIT_V(8); PG8_WAIT_L(0); PG8_BAR; PG8_MMA(1, 0, At, B0); PG8_MMA(1, 1, At, B1); PG8_BAR; PG8_SCHED;
            } else {
            PG8_LDB(B0, 0, 0); PG8_SCHED; PG8_LDA(At, 0, 0); PG8_STAGE(PG8_SA(1, 1), a1 + hstepA, voffA);
            PG8_WAIT_L(8); PG8_BAR; PG8_WAIT_L(0); PG8_MMA(0, 0, At, B0); PG8_BAR; PG8_SCHED;
            PG8_LDB(B1, 0, 1); PG8_STAGE(PG8_SB(0, 0), b2, voffB);
            PG8_BAR; PG8_WAIT_L(0); PG8_MMA(0, 1, At, B1); PG8_BAR;
            PG8_LDA(At, 0, 1); PG8_STAGE(PG8_SA(0, 0), a2, voffA);
            PG8_BAR; PG8_WAIT_L(0); PG8_MMA(1, 0, At, B0); PG8_BAR; PG8_SCHED;
            PG8_STAGE(PG8_SB(0, 1), b2 + hstepB, voffB);
            PG8_WAIT_V(6); PG8_BAR; PG8_MMA(1, 1, At, B1); PG8_BAR;
            PG8_LDB(B0, 1, 0); PG8_SCHED; PG8_LDA(At, 1, 0); PG8_STAGE(PG8_SA(0, 1), a2 + hstepA, voffA);
            PG8_WAIT_L(8); PG8_BAR; PG8_WAIT_L(0); PG8_MMA(0, 0, At, B0); PG8_BAR; PG8_SCHED;
            PG8_LDB(B1, 1, 1); PG8_STAGE(PG8_SB(1, 0), b3, voffB);
            PG8_BAR; PG8_WAIT_L(0); PG8_MMA(0, 1, At, B1); PG8_BAR;
            PG8_LDA(At, 1, 1); PG8_STAGE(PG8_SA(1, 0), a3, voffA);
            PG8_BAR; PG8_WAIT_L(0); PG8_MMA(1, 0, At, B0); PG8_BAR; PG8_SCHED;
            PG8_STAGE(PG8_SB(1, 1), b3 + hstepB, voffB);
            PG8_WAIT_V(6); PG8_BAR; PG8_MMA(1, 1, At, B1); PG8_BAR;
            }
        }
        if constexpr (ALIGN_EPI) { if (wr == 0) PG8_BAR; }
        if constexpr (!Epi::AFTER_DRAIN) { E(acc, cur, wr, wc, fr, fq); S.done(cur); }
        if (!has_next) break;
#pragma unroll
        for (int a = 0; a < 2; ++a)
#pragma unroll
            for (int b = 0; b < 2; ++b)
#pragma unroll
                for (int m = 0; m < 4; ++m)
#pragma unroll
                    for (int n = 0; n < 2; ++n) acc[a][b][m][n] = (typename Epi::acc_t){};
        cur = nxt; cA = nA; cB = nB; ++ui;
        if constexpr (ALIGN_EPI) { if (wr == 1) PG8_BAR; }
    }
    PG8_WAIT_V(0);
    if constexpr (!ALIGN_EPI) { if (wr == 0) PG8_BAR; }
    PG8_BAR;
#undef PG8_SA
#undef PG8_SB
#undef PG8_STAGE
#undef PG8_LDA
#undef PG8_LDB
#undef PG8_MMA
#undef PG8_WAIT_V
#undef PG8_WAIT_L
#undef PG8_BAR
#undef PG8_SCHED
#undef PG8_UA
#undef PG8_UB
}
}
namespace attn {
using bf16x8 = __attribute__((ext_vector_type(8))) short;
using s16x4  = __attribute__((ext_vector_type(4))) short;
using f32x16 = __attribute__((ext_vector_type(16))) float;
using f32x4  = __attribute__((ext_vector_type(4))) float;
using u32x4  = __attribute__((ext_vector_type(4))) unsigned;
constexpr int SEQ = 8192, LD = 1024, KVBLK = 64, QBLK = 32, NHEAD = 8, NQB = SEQ / 128;
constexpr float SC = 0.125f * 1.4426950408889634f;
constexpr float L2E = 1.4426950408889634f;
constexpr float THR = 16.f;
constexpr int SHM_V = 16384, SHM_K = 16384;
constexpr int OFF_V = 0, OFF_K = 2 * SHM_V, OFF_WS = OFF_K + 2 * SHM_K, OFF_TB = OFF_WS + 8 * 256 + 0, TB_N = 256;
constexpr int STG_LD = 132, STG_BYTES = 32 * STG_LD * 4;
constexpr int LDS_BYTES = OFF_TB + TB_N * 4;
static_assert(4 * STG_BYTES <= OFF_TB, "combine stage must not reach the bias table");
#define KSWZ(row, colB) ((row) * 256 + ((colB) ^ (((row) & 7) << 4)))
#define SBAR() __builtin_amdgcn_sched_barrier(0)
__device__ __forceinline__ int crow(int r, int hi) { return (r & 3) + 8 * (r >> 2) + 4 * hi; }
__device__ __forceinline__ unsigned cvtpk(float lo, float hi) { unsigned r; asm volatile("v_cvt_pk_bf16_f32 %0, %1, %2" : "=v"(r) : "v"(lo), "v"(hi)); return r; }

__device__ __forceinline__ int t5_bucket(int rel) {
  const int n = rel < 0 ? -rel : rel; int b;
  if (n < 8) b = n; else if (n < 12) b = 8; else if (n < 16) b = 9; else if (n < 23) b = 10; else if (n < 32) b = 11; else if (n < 46) b = 12; else if (n < 64) b = 13; else if (n < 91) b = 14; else b = 15;
  return b + (rel > 0 ? 16 : 0);
}

__device__ __forceinline__ void partialSM(f32x16& p0, f32x16& p1, float& m_reg, float& mn, float& alpha, int j, int c, float cb, const float* tq, int hi) {
  if (j >= c - 2) {
    if (j > c) {
#pragma unroll
      for (int r = 0; r < 16; ++r) { p0[r] = -1e30f; p1[r] = -1e30f; }
    } else {
      const float* t = tq + 64 * j;
#pragma unroll
      for (int r = 0; r < 16; ++r) { p0[r] = fmaf(p0[r], SC, t[crow(r, hi)]); p1[r] = fmaf(p1[r], SC, t[32 + crow(r, hi)]); }
    }
    float pmax = p0[0];
#pragma unroll
    for (int r = 1; r < 16; ++r) pmax = fmaxf(pmax, p0[r]);
#pragma unroll
    for (int r = 0; r < 16; ++r) pmax = fmaxf(pmax, p1[r]);
    { auto rr = __builtin_amdgcn_permlane32_swap(__float_as_uint(pmax), __float_as_uint(pmax), false, false); pmax = fmaxf(__uint_as_float(rr[0]), __uint_as_float(rr[1])); }
    if (__builtin_expect(__all(pmax - m_reg <= THR), 1)) { mn = m_reg; alpha = 1.f; }
    else { mn = fmaxf(m_reg, pmax); alpha = __builtin_amdgcn_exp2f(m_reg - mn); m_reg = mn; }
#pragma unroll
    for (int r = 0; r < 16; ++r) { p0[r] -= mn; p1[r] -= mn; }
  } else {
    float pmax = p0[0];
#pragma unroll
    for (int r = 1; r < 16; ++r) pmax = fmaxf(pmax, p0[r]);
#pragma unroll
    for (int r = 0; r < 16; ++r) pmax = fmaxf(pmax, p1[r]);
    { auto rr = __builtin_amdgcn_permlane32_swap(__float_as_uint(pmax), __float_as_uint(pmax), false, false); pmax = fmaxf(__uint_as_float(rr[0]), __uint_as_float(rr[1])); }
    pmax = fmaf(pmax, SC, cb);
    if (__builtin_expect(__all(pmax - m_reg <= THR), 1)) { mn = m_reg; alpha = 1.f; }
    else { mn = fmaxf(m_reg, pmax); alpha = __builtin_amdgcn_exp2f(m_reg - mn); m_reg = mn; }
    const float off = cb - mn;
#pragma unroll
    for (int r = 0; r < 16; ++r) { p0[r] = fmaf(p0[r], SC, off); p1[r] = fmaf(p1[r], SC, off); }
  }
#pragma unroll
  for (int r = 0; r < 16; ++r) p0[r] = __builtin_amdgcn_exp2f(p0[r]);
}
__device__ __forceinline__ void finishSM(f32x16& p0, f32x16& p1, float alpha, float& l_reg, bf16x8& pa0, bf16x8& pa1, bf16x8& pa2, bf16x8& pa3) {
#pragma unroll
  for (int r = 0; r < 16; ++r) p1[r] = __builtin_amdgcn_exp2f(p1[r]);
  float ps = 0;
#pragma unroll
  for (int r = 0; r < 16; ++r) ps += p0[r];
#pragma unroll
  for (int r = 0; r < 16; ++r) ps += p1[r];
  { auto rr = __builtin_amdgcn_permlane32_swap(__float_as_uint(ps), __float_as_uint(ps), false, false); ps = __uint_as_float(rr[0]) + __uint_as_float(rr[1]); }
  l_reg = l_reg * alpha + ps;
#define PK4(P, BASE, OUT) do { unsigned a0 = cvtpk(P[BASE + 0], P[BASE + 1]), a1 = cvtpk(P[BASE + 2], P[BASE + 3]);   \
    unsigned b0 = cvtpk(P[BASE + 4], P[BASE + 5]), b1 = cvtpk(P[BASE + 6], P[BASE + 7]);                              \
    auto r0 = __builtin_amdgcn_permlane32_swap(a0, b0, false, false); auto r1 = __builtin_amdgcn_permlane32_swap(a1, b1, false, false); \
    u32x4 w = {r0[0], r1[0], r0[1], r1[1]}; OUT = *reinterpret_cast<bf16x8*>(&w); } while (0)
  PK4(p0, 0, pa0); PK4(p0, 8, pa1); PK4(p1, 0, pa2); PK4(p1, 8, pa3);
#undef PK4
}
__device__ __forceinline__ void qkt(f32x16& p0, f32x16& p1, const char* Ks, const bf16x8* qr, int r32, int hi, int sm) {
  p0 = f32x16{}; p1 = f32x16{};
#pragma unroll
  for (int d0 = 0; d0 < 4; ++d0) { const int cb = (sm * 64 + d0 * 16 + hi * 8) * 2;
    const bf16x8 b0 = *reinterpret_cast<const bf16x8*>(Ks + KSWZ(r32, cb));
    const bf16x8 b1 = *reinterpret_cast<const bf16x8*>(Ks + KSWZ(32 + r32, cb));
    p0 = __builtin_amdgcn_mfma_f32_32x32x16_bf16(b0, qr[d0], p0, 0, 0, 0);
    p1 = __builtin_amdgcn_mfma_f32_32x32x16_bf16(b1, qr[d0], p1, 0, 0, 0); }
}
__device__ __forceinline__ int v_st(int k, int c) { const int kk = (k & ~0xC) | ((k & 4) << 1) | ((k & 8) >> 1); return ((kk >> 3) * 4 + (c >> 5)) * 512 + ((kk & 7) * 32 + (c & 31)) * 2; }
__device__ __forceinline__ int v_rd_base(int lane) { return ((lane & 3) << 3) | (((lane >> 2) & 3) << 6) | (((lane >> 4) & 1) << 5) | (((lane >> 5) & 1) << 8); }
constexpr int v_rd_off(int d0, int ks, int half) { return d0 * 512 + ks * 4096 + half * 2048; }
template <int OFF> __device__ __forceinline__ s16x4 tr_read(int vb) { s16x4 r; asm volatile("ds_read_b64_tr_b16 %0, %1 offset:%2" : "=&v"(r) : "v"(vb), "i"(OFF) : "memory"); return r; }
template <int D0> __device__ __forceinline__ void pv_one(f32x16& od, int vb, bf16x8 pa0, bf16x8 pa1, bf16x8 pa2, bf16x8 pa3) {
  const s16x4 l0 = tr_read<v_rd_off(D0, 0, 0)>(vb), h0 = tr_read<v_rd_off(D0, 0, 1)>(vb), l1 = tr_read<v_rd_off(D0, 1, 0)>(vb), h1 = tr_read<v_rd_off(D0, 1, 1)>(vb);
  const s16x4 l2 = tr_read<v_rd_off(D0, 2, 0)>(vb), h2 = tr_read<v_rd_off(D0, 2, 1)>(vb), l3 = tr_read<v_rd_off(D0, 3, 0)>(vb), h3 = tr_read<v_rd_off(D0, 3, 1)>(vb);
  asm volatile("s_waitcnt lgkmcnt(0)" ::: "memory"); SBAR();
#define PK(L, H) (bf16x8){L[0], L[1], L[2], L[3], H[0], H[1], H[2], H[3]}
  od = __builtin_amdgcn_mfma_f32_32x32x16_bf16(pa0, PK(l0, h0), od, 0, 0, 0);
  od = __builtin_amdgcn_mfma_f32_32x32x16_bf16(pa1, PK(l1, h1), od, 0, 0, 0);
  od = __builtin_amdgcn_mfma_f32_32x32x16_bf16(pa2, PK(l2, h2), od, 0, 0, 0);
  od = __builtin_amdgcn_mfma_f32_32x32x16_bf16(pa3, PK(l3, h3), od, 0, 0, 0);
#undef PK
}
__device__ __forceinline__ void pv_d0(f32x16* o, int vb, bf16x8 pa0, bf16x8 pa1, bf16x8 pa2, bf16x8 pa3) {
  pv_one<0>(o[0], vb, pa0, pa1, pa2, pa3); pv_one<1>(o[1], vb, pa0, pa1, pa2, pa3); pv_one<2>(o[2], vb, pa0, pa1, pa2, pa3); pv_one<3>(o[3], vb, pa0, pa1, pa2, pa3);
}

struct Params { const unsigned short* Q; const unsigned short* K; const unsigned short* V; unsigned char* O8; float* OS; const float* rel_bias; const float* subln_g; float lam; float inv_s, s; };

__device__ __forceinline__ void attn_unit(const Params& P, int b, int h, int qb, char* lds, int tid_in) {
  const int tid = tid_in, wid = __builtin_amdgcn_readfirstlane(tid >> 6), lane = tid & 63, r32 = lane & 31, hi = lane >> 5;
  const int sm = wid >> 2, wq = wid & 3;
  unsigned short* V_lds = (unsigned short*)(lds + OFF_V); unsigned short* K_lds = (unsigned short*)(lds + OFF_K);
  float* ws = (float*)(lds + OFF_WS) + wid * 64; float* li_l = ws; float* al_l = ws + 32;
  float* tb = (float*)(lds + OFF_TB);
  const long rowbase = (long)b * SEQ; const int q0 = qb * 128;
  const unsigned short* Kh = P.K + rowbase * LD + h * 128; const unsigned short* Vh = P.V + rowbase * LD + h * 128;
  if (tid < TB_N) tb[tid] = P.rel_bias[t5_bucket(tid - 191) * NHEAD + h] * L2E;
  const float cb = P.rel_bias[15 * NHEAD + h] * L2E;
  float m_reg = -1e30f, l_reg = 0; f32x16 o[4] = {}; bf16x8 qr[4];
  const int qpos = q0 + wq * QBLK + r32;
  const int c = (q0 + wq * QBLK) >> 6;
  const float* tq = tb + 191 - qpos;
  const unsigned short* Qw = P.Q + (rowbase + qpos) * LD + h * 128 + sm * 64 + hi * 8;
#pragma unroll
  for (int d0 = 0; d0 < 4; ++d0) qr[d0] = *reinterpret_cast<const bf16x8*>(Qw + d0 * 16);
  const int sr = tid >> 4, sc = (tid & 15) * 8, vst0 = v_st(sr, sc), vst1 = v_st(32 + sr, sc);
  const int vb0 = (int)(uintptr_t)V_lds + v_rd_base(lane);
  struct { bf16x8 vs0, vs1, ks0, ks1; } sr_[2];
#define SLOAD(i, k0) do { sr_[i].vs0 = *reinterpret_cast<const bf16x8*>(&Vh[(long)((k0) + sr) * LD + sc]); sr_[i].vs1 = *reinterpret_cast<const bf16x8*>(&Vh[(long)((k0) + 32 + sr) * LD + sc]); \
    sr_[i].ks0 = *reinterpret_cast<const bf16x8*>(&Kh[(long)((k0) + sr) * LD + sc]); sr_[i].ks1 = *reinterpret_cast<const bf16x8*>(&Kh[(long)((k0) + 32 + sr) * LD + sc]); } while (0)
#define SWRITE(bb, i) do { *(bf16x8*)((char*)V_lds + (bb) * SHM_V + vst0) = sr_[i].vs0;          \
    *(bf16x8*)((char*)V_lds + (bb) * SHM_V + vst1) = sr_[i].vs1; const int kc = sc * 2;               \
    *(bf16x8*)((char*)K_lds + (bb) * SHM_K + KSWZ(sr, kc)) = sr_[i].ks0;                       \
    *(bf16x8*)((char*)K_lds + (bb) * SHM_K + KSWZ(32 + sr, kc)) = sr_[i].ks1; } while (0)
#define SWAIT() asm volatile("s_waitcnt vmcnt(4)" ::: "memory")
#define RESC(a) do { if (__any((a) < 1.f)) { if (hi == 0) al_l[r32] = (a); asm volatile("s_waitcnt lgkmcnt(0)" ::: "memory"); \
    _Pragma("unroll") for (int d = 0; d < 4; ++d) _Pragma("unroll") for (int r = 0; r < 16; ++r) o[d][r] *= al_l[crow(r, hi)]; } } while (0)
  f32x16 pA0, pA1, pB0, pB1; float mnA, mnB, alA, alB; bf16x8 pa0, pa1, pa2, pa3; const int NT = 2 * qb + 2;
  constexpr int SE = 0, SO = 1;
  SLOAD(SE, 0); asm volatile("s_waitcnt vmcnt(0)" ::: "memory"); SWRITE(0, SE); __syncthreads();
  qkt(pA0, pA1, (const char*)K_lds, qr, r32, hi, sm); partialSM(pA0, pA1, m_reg, mnA, alA, 0, c, cb, tq, hi);
  SLOAD(SO, KVBLK); if (2 < NT) SLOAD(SE, 2 * KVBLK);
  SWAIT(); SWRITE(1, SO); __syncthreads();
  for (int j = 1; j + 1 < NT; j += 2) {
    SBAR(); qkt(pB0, pB1, (const char*)K_lds + SHM_K, qr, r32, hi, sm);
    finishSM(pA0, pA1, alA, l_reg, pa0, pa1, pa2, pa3); SBAR();
    SLOAD(SO, (j + 2) * KVBLK); SBAR();
    pv_d0(o, vb0, pa0, pa1, pa2, pa3); partialSM(pB0, pB1, m_reg, mnB, alB, j, c, cb, tq, hi);
    __syncthreads(); SWAIT(); SWRITE(0, SE);
    RESC(alB); __syncthreads();
    SBAR(); qkt(pA0, pA1, (const char*)K_lds, qr, r32, hi, sm);
    finishSM(pB0, pB1, alB, l_reg, pa0, pa1, pa2, pa3); SBAR();
    if (j + 3 < NT) SLOAD(SE, (j + 3) * KVBLK); SBAR();
    pv_d0(o, vb0 + SHM_V, pa0, pa1, pa2, pa3); partialSM(pA0, pA1, m_reg, mnA, alA, j + 1, c, cb, tq, hi);
    __syncthreads(); SWAIT(); SWRITE(1, SO);
    RESC(alA); __syncthreads();
  }
  SBAR(); qkt(pB0, pB1, (const char*)K_lds + SHM_K, qr, r32, hi, sm);
  finishSM(pA0, pA1, alA, l_reg, pa0, pa1, pa2, pa3); SBAR();
  pv_d0(o, vb0, pa0, pa1, pa2, pa3); partialSM(pB0, pB1, m_reg, mnB, alB, NT - 1, c, cb, tq, hi);
  __syncthreads(); RESC(alB);
  finishSM(pB0, pB1, alB, l_reg, pa0, pa1, pa2, pa3); SBAR();
  pv_d0(o, vb0 + SHM_V, pa0, pa1, pa2, pa3);
  if (hi == 0) li_l[r32] = l_reg; asm volatile("s_waitcnt lgkmcnt(0)" ::: "memory");
  float rli[16];
  const float fac = sm ? P.lam : 1.f;
#pragma unroll
  for (int r = 0; r < 16; ++r) rli[r] = __builtin_amdgcn_rcpf(li_l[crow(r, hi)]) * fac;
  __syncthreads();
  float* stg = (float*)lds + wq * (32 * STG_LD);
  if (sm == 1) {
#pragma unroll
    for (int d0 = 0; d0 < 4; ++d0)
#pragma unroll
      for (int r = 0; r < 16; ++r) stg[crow(r, hi) * STG_LD + d0 * 32 + r32] = o[d0][r] * rli[r];
  }
  __syncthreads();
  if (sm == 0) {
#pragma unroll
    for (int d0 = 0; d0 < 4; ++d0)
#pragma unroll
      for (int r = 0; r < 16; ++r) { float* p = &stg[crow(r, hi) * STG_LD + d0 * 32 + r32]; *p = o[d0][r] * rli[r] - *p; }
    asm volatile("s_waitcnt lgkmcnt(0)" ::: "memory");
    const float* rp = stg + r32 * STG_LD + hi * 64;
    f32x4 v[16]; float ss = 0.f;
#pragma unroll
    for (int i = 0; i < 16; ++i) { v[i] = *(const f32x4*)(rp + 4 * i); ss += (v[i].x * v[i].x + v[i].y * v[i].y) + (v[i].z * v[i].z + v[i].w * v[i].w); }
    { auto rr = __builtin_amdgcn_permlane32_swap(__float_as_uint(ss), __float_as_uint(ss), false, false); ss = __uint_as_float(rr[0]) + __uint_as_float(rr[1]); }
    const float rs = 0.8f / sqrtf(ss * (1.f / 128.f) + 1e-5f);
    unsigned char* Ow = P.O8 + (rowbase + q0 + wq * QBLK + r32) * LD + h * 128 + hi * 64;
    const float* gp = P.subln_g + hi * 64; const float rq = rs * P.inv_s;
#pragma unroll
    for (int i = 0; i < 4; ++i) { u32x4 w;
#pragma unroll
      for (int q = 0; q < 4; ++q) { const f32x4 g = *(const f32x4*)(gp + 16 * i + 4 * q); const f32x4 a = v[4 * i + q] * rq * g;
        w[q] = ((unsigned)((int)__builtin_rintf(a.x)) & 255u) | (((unsigned)((int)__builtin_rintf(a.y)) & 255u) << 8) | (((unsigned)((int)__builtin_rintf(a.z)) & 255u) << 16) | (((unsigned)((int)__builtin_rintf(a.w)) & 255u) << 24); }
      *(u32x4*)(Ow + 16 * i) = w; }
    if (h == 0 && hi == 0) P.OS[rowbase + q0 + wq * QBLK + r32] = P.s;
  }
  __syncthreads();
#undef SLOAD
#undef SWRITE
#undef SWAIT
#undef RESC
}

constexpr int SLOT2 = 16384, L2_K = 0, L2_V = 3 * SLOT2, L2_WS = 6 * SLOT2, L2_TB = L2_WS + 8 * 256, LDS_BYTES2 = L2_TB + TB_N * 4;
static_assert(4 * STG_BYTES <= L2_WS && LDS_BYTES2 <= 131072, "combine stage must stay below the per-wave words; the body's LDS must fit the ring");
#define PIN(x) asm volatile("" : "+v"(x))
#define MFMA32(a, b, c) __builtin_amdgcn_mfma_f32_32x32x16_bf16(a, b, c, 0, 0, 0)
#define WAIT_BAR(N) asm volatile("s_waitcnt vmcnt(" #N ") lgkmcnt(0)\n\ts_barrier" ::: "memory")
__device__ __forceinline__ void glds16(unsigned voff, const void* sbase, unsigned lds_base) {
    unsigned sv; asm volatile("s_mov_b32 %0, m0\n\ts_mov_b32 m0, %2\n\ts_nop 0\n\tglobal_load_lds_dwordx4 %1, %3\n\ts_mov_b32 m0, %0" : "=&s"(sv) : "v"(voff), "s"(lds_base), "s"(sbase) : "memory"); }
typedef __attribute__((address_space(3))) const char* lds_cptr;
typedef short v4i16_t __attribute__((ext_vector_type(4)));
__device__ __forceinline__ void kload2(bf16x8* kf, lds_cptr kp, int d0) { kf[2 * d0] = *(const __attribute__((address_space(3))) bf16x8*)(kp + d0 * 2048); kf[2 * d0 + 1] = *(const __attribute__((address_space(3))) bf16x8*)(kp + d0 * 2048 + 512); }
__device__ __forceinline__ s16x4 vtr(lds_cptr p) { return __builtin_bit_cast(s16x4, __builtin_amdgcn_ds_read_tr16_b64_v4i16((__attribute__((address_space(3))) v4i16_t*)p)); }
#define MX3(a, b, c) __builtin_fmaxf(__builtin_fmaxf((a), (b)), (c))
__device__ __forceinline__ float rowmax(const f32x16& p0, const f32x16& p1) {
    float a = MX3(p0[0], p0[1], p1[0]), b = MX3(p0[2], p0[3], p1[1]); a = MX3(a, p1[2], p1[3]);
#pragma unroll
    for (int r = 4; r < 16; r += 4) { a = MX3(a, p0[r], p0[r + 1]); b = MX3(b, p0[r + 2], p0[r + 3]); a = MX3(a, p1[r], p1[r + 1]); b = MX3(b, p1[r + 2], p1[r + 3]); }
    float m = __builtin_fmaxf(a, b); auto rr = __builtin_amdgcn_permlane32_swap(__float_as_uint(m), __float_as_uint(m), false, false);
    return __builtin_fmaxf(__uint_as_float(rr[0]), __uint_as_float(rr[1])); }
template <bool REL> __device__ __forceinline__ void band_xform(f32x16& p0, f32x16& p1, int j, int c, float cb, const __attribute__((address_space(3))) float* tq, int hi) {
  if (j > c) {
#pragma unroll
    for (int r = 0; r < 16; ++r) { p0[r] = -INFINITY; p1[r] = -INFINITY; }
  } else if (j >= c - 2) { const __attribute__((address_space(3))) float* t = tq + 64 * j; const float sub = REL ? cb : 0.f;
#pragma unroll
    for (int r = 0; r < 16; ++r) { p0[r] += t[crow(r, hi)] - sub; p1[r] += t[32 + crow(r, hi)] - sub; }
  } else if (!REL) {
#pragma unroll
    for (int r = 0; r < 16; ++r) { p0[r] += cb; p1[r] += cb; }
  }
}
__device__ __forceinline__ void attn_unit2(const Params& P, int b, int h, int qb, char* lds, int tid_in) {
  const int tid = tid_in, wid = __builtin_amdgcn_readfirstlane(tid >> 6), lane = tid & 63, r32 = lane & 31, hi = lane >> 5;
  const int sm = wid >> 2, wq = wid & 3;
  const long rowbase = (long)b * SEQ; const int q0 = qb * 128, NT = 2 * qb + 2;
  const int qpos = q0 + wq * QBLK + r32, c = (q0 + wq * QBLK) >> 6;
  float* wsf = (float*)(lds + L2_WS) + wid * 64; float* tb = (float*)(lds + L2_TB);
  if (tid < TB_N) tb[tid] = P.rel_bias[t5_bucket(tid - 191) * NHEAD + h] * L2E;
  const float cb = P.rel_bias[15 * NHEAD + h] * L2E;
  const __attribute__((address_space(3))) float* tq = (const __attribute__((address_space(3))) float*)tb + 191 - qpos;
  const unsigned short* Qw = P.Q + (rowbase + qpos) * LD + h * 128 + sm * 64 + hi * 8;
  const unsigned lds0 = (unsigned)(uintptr_t)lds;
  const char* kbase = (const char*)(P.K + rowbase * LD + h * 128 + wid * 16);
  const char* vbase = (const char*)(P.V + rowbase * LD + h * 128 + (long)(32 * (wid & 1)) * LD + (wid >> 1) * 32);
  const unsigned koff = (unsigned)lane * (LD * 2), voff = (unsigned)(lane >> 2) * (LD * 2) + (lane & 3) * 16;
  const unsigned kdst = lds0 + L2_K + wid * 2048, vdst = lds0 + L2_V + wid * 2048;
#define RFL(x) ((unsigned)__builtin_amdgcn_readfirstlane((int)(x)))
#define DMA_K(t, slot) do { const char* g_ = kbase + (long)(t) * (KVBLK * LD * 2); glds16(koff, g_, RFL(kdst + (slot))); glds16(koff, g_ + 16, RFL(kdst + (slot) + 1024)); } while (0)
#define DMA_V(t, slot) do { const char* g_ = vbase + (long)(t) * (KVBLK * LD * 2); glds16(voff, g_, RFL(vdst + (slot))); glds16(voff, g_ + 16 * LD * 2, RFL(vdst + (slot) + 1024)); } while (0)
  const lds_cptr vp0 = (lds_cptr)lds + L2_V + ((lane >> 4) & 1) * 32 + (lane & 3) * 8 + (4 * hi + ((lane & 15) >> 2)) * 64;
  const lds_cptr kp0 = (lds_cptr)lds + L2_K + (8 * sm + hi) * 1024 + r32 * 16;
  DMA_K(0, 0); DMA_V(0, 0); DMA_K(1, SLOT2);
  bf16x8 qr[4];
#pragma unroll
  for (int d0 = 0; d0 < 4; ++d0) qr[d0] = *reinterpret_cast<const bf16x8*>(Qw + d0 * 16);
  float mhat = 0.f, l_reg = 0.f; f32x16 o[4] = {}; const f32x16 zero16 = {};
  bool resc = false;
  f32x16 pA0, pA1, pB0, pB1; bf16x8 kf[8]; s16x4 vlo[4], vhi[4]; u32x4 pw0, pw1, pw2, pw3;
  int sl_prev = 0, sl_cur = 0, sl_next = SLOT2;
#define ROT() do { sl_prev = sl_cur; sl_cur = sl_next; sl_next = (sl_next == 2 * SLOT2) ? 0 : sl_next + SLOT2; } while (0)
#define RESC2() do { if (resc) { _Pragma("unroll") for (int d_ = 0; d_ < 4; ++d_) _Pragma("unroll") for (int r = 0; r < 16; ++r) o[d_][r] *= wsf[crow(r, hi)]; } } while (0)
  DMA_K(2, 2 * SLOT2);
  WAIT_BAR(6);
#pragma unroll
  for (int d0 = 0; d0 < 4; ++d0) kload2(kf, kp0, d0);
  pA0 = MFMA32(kf[0], qr[0], zero16); pA1 = MFMA32(kf[1], qr[0], zero16); pA0 = MFMA32(kf[2], qr[1], pA0); pA1 = MFMA32(kf[3], qr[1], pA1);
  pA0 = MFMA32(kf[4], qr[2], pA0); pA1 = MFMA32(kf[5], qr[2], pA1); pA0 = MFMA32(kf[6], qr[3], pA0); pA1 = MFMA32(kf[7], qr[3], pA1);
  band_xform<false>(pA0, pA1, 0, c, cb, tq, hi);
  { mhat = rowmax(pA0, pA1); const float nmh = -mhat;
#pragma unroll
    for (int r = 0; r < 16; ++r) { pA0[r] = __builtin_amdgcn_exp2f(pA0[r] + nmh); pA1[r] = __builtin_amdgcn_exp2f(pA1[r] + nmh); } }
  f32x16 negm;
#pragma unroll
  for (int r = 0; r < 16; ++r) negm[r] = cb - mhat;
  PIN(negm);
  WAIT_BAR(0);
  DMA_K(3, 0); DMA_V(1, SLOT2); ROT();
#pragma unroll
  for (int d0 = 0; d0 < 4; ++d0) kload2(kf, kp0 + sl_cur, d0);
  if (NT == 2) { WAIT_BAR(0); } else { WAIT_BAR(4); }
#define PKW(P_, i) cvtpk(P_[i], P_[i + 1])
#define PAF(k) __builtin_bit_cast(bf16x8, pw##k)
#define VFR(i) (bf16x8){vlo[i][0], vlo[i][1], vlo[i][2], vlo[i][3], vhi[i][0], vhi[i][1], vhi[i][2], vhi[i][3]}
#define VRDS(slot, qd, ks) do { vlo[slot] = vtr(vp_ + ((qd) * 4096 + (ks) * 1024)); vhi[slot] = vtr(vp_ + ((qd) * 4096 + (ks) * 1024 + 512)); } while (0)
#define KRD(G, d0) do { if (G) { kload2(kf, kp0 + sl_next, d0); SBAR(); } } while (0)
#define GAPA(MF, a0, a1, a2, a3, W0, W1, PW) do { MF; sacc += a0; sacc += a1; sacc += a2; sacc += a3; W0; W1; PIN(PW); PIN(sacc); SBAR(); } while (0)
#define EX(BAND_, v) __builtin_amdgcn_exp2f(v)
#define GAPB(BAND_, MF, X, i) do { MF; X[i] = EX(BAND_, X[i]); X[i + 1] = EX(BAND_, X[i + 1]); PIN(X); SBAR(); } while (0)
#define STEP(C0, C1, P0, P1, t, BAND_, GK, GV, GL) do { SBAR(); \
    const lds_cptr vp_ = vp0 + sl_prev; \
    float sacc = P0[0] + P0[1]; \
                          GAPA(C0 = MFMA32(kf[0], qr[0], negm), P0[2], P0[3], P0[4], P0[5],     pw0[0] = PKW(P0, 0),  pw0[1] = PKW(P0, 2),  pw0); \
                          GAPA(C1 = MFMA32(kf[1], qr[0], negm), P0[6], P0[7], P0[8], P0[9],     pw0[2] = PKW(P0, 4),  pw0[3] = PKW(P0, 6),  pw0); \
                          GAPA(C0 = MFMA32(kf[2], qr[1], C0),    P0[10], P0[11], P0[12], P0[13], pw1[0] = PKW(P0, 8),  pw1[1] = PKW(P0, 10), pw1); \
                          GAPA(C1 = MFMA32(kf[3], qr[1], C1),    P0[14], P0[15], P1[0], P1[1],   pw1[2] = PKW(P0, 12), pw1[3] = PKW(P0, 14), pw1); \
    VRDS(0, 0, 0); SBAR(); GAPA(C0 = MFMA32(kf[4], qr[2], C0),    P1[2], P1[3], P1[4], P1[5],     pw2[0] = PKW(P1, 0),  pw2[1] = PKW(P1, 2),  pw2); \
    VRDS(1, 1, 0); SBAR(); GAPA(C1 = MFMA32(kf[5], qr[2], C1),    P1[6], P1[7], P1[8], P1[9],     pw2[2] = PKW(P1, 4),  pw2[3] = PKW(P1, 6),  pw2); \
    VRDS(2, 2, 0); SBAR(); GAPA(C0 = MFMA32(kf[6], qr[3], C0),    P1[10], P1[11], P1[12], P1[13], pw3[0] = PKW(P1, 8),  pw3[1] = PKW(P1, 10), pw3); \
    VRDS(3, 3, 0); SBAR(); GAPA(C1 = MFMA32(kf[7], qr[3], C1),    P1[14], P1[15], 0.f, 0.f,       pw3[2] = PKW(P1, 12), pw3[3] = PKW(P1, 14), pw3); \
    l_reg += sacc; \
    if (GK) DMA_K((t) + 3, sl_cur); if (GV) DMA_V((t) + 1, sl_next); \
    if (BAND_) band_xform<true>(C0, C1, (t), c, cb, tq, hi); \
    { const float rm = rowmax(C0, C1); resc = false;                                                             \
      if (__builtin_expect(__any(rm > THR), 0)) { const float dl = __builtin_fmaxf(rm, 0.f); mhat += dl;            \
          _Pragma("unroll") for (int r = 0; r < 16; ++r) { C0[r] -= dl; C1[r] -= dl; } \
          _Pragma("unroll") for (int r = 0; r < 16; ++r) negm[r] = cb - mhat; PIN(negm); \
          const float f = __builtin_amdgcn_exp2f(-dl); l_reg *= f; if (hi == 0) wsf[r32] = f; resc = true; } } \
    SBAR(); \
      \
    GAPB(BAND_, o[0] = MFMA32(PAF(0), VFR(0), o[0]), C0, 0);  VRDS(0, 0, 1); SBAR(); \
    GAPB(BAND_, o[1] = MFMA32(PAF(0), VFR(1), o[1]), C0, 2);  VRDS(1, 1, 1); SBAR(); \
    GAPB(BAND_, o[2] = MFMA32(PAF(0), VFR(2), o[2]), C0, 4);  VRDS(2, 2, 1); SBAR(); \
    GAPB(BAND_, o[3] = MFMA32(PAF(0), VFR(3), o[3]), C0, 6);  VRDS(3, 3, 1); SBAR(); \
    GAPB(BAND_, o[0] = MFMA32(PAF(1), VFR(0), o[0]), C0, 8);  VRDS(0, 0, 2); SBAR(); \
    GAPB(BAND_, o[1] = MFMA32(PAF(1), VFR(1), o[1]), C0, 10); VRDS(1, 1, 2); SBAR(); \
    GAPB(BAND_, o[2] = MFMA32(PAF(1), VFR(2), o[2]), C0, 12); VRDS(2, 2, 2); SBAR(); \
    GAPB(BAND_, o[3] = MFMA32(PAF(1), VFR(3), o[3]), C0, 14); VRDS(3, 3, 2); SBAR(); \
    GAPB(BAND_, o[0] = MFMA32(PAF(2), VFR(0), o[0]), C1, 0);  VRDS(0, 0, 3); SBAR(); \
    GAPB(BAND_, o[1] = MFMA32(PAF(2), VFR(1), o[1]), C1, 2);  VRDS(1, 1, 3); SBAR(); \
    GAPB(BAND_, o[2] = MFMA32(PAF(2), VFR(2), o[2]), C1, 4);  VRDS(2, 2, 3); SBAR(); \
    GAPB(BAND_, o[3] = MFMA32(PAF(2), VFR(3), o[3]), C1, 6);  VRDS(3, 3, 3); SBAR(); \
    KRD(GL, 0); GAPB(BAND_, o[0] = MFMA32(PAF(3), VFR(0), o[0]), C1, 8); \
    KRD(GL, 1); GAPB(BAND_, o[1] = MFMA32(PAF(3), VFR(1), o[1]), C1, 10); \
    KRD(GL, 2); GAPB(BAND_, o[2] = MFMA32(PAF(3), VFR(2), o[2]), C1, 12); \
    KRD(GL, 3); GAPB(BAND_, o[3] = MFMA32(PAF(3), VFR(3), o[3]), C1, 14); \
    } while (0)
  int t = 1;
  for (; t + 5 < NT; t += 2) {
    STEP(pB0, pB1, pA0, pA1, t, false, true, true, true);     WAIT_BAR(4); RESC2(); ROT();
    STEP(pA0, pA1, pB0, pB1, t + 1, false, true, true, true); WAIT_BAR(4); RESC2(); ROT();
  }
#define ENDW(tt) do { if ((tt) + 3 < NT) { WAIT_BAR(4); } else if ((tt) + 2 < NT) { WAIT_BAR(2); } else { WAIT_BAR(0); } } while (0)
  for (; t + 1 < NT; t += 2) {
    STEP(pB0, pB1, pA0, pA1, t, true, (t + 3 < NT), (t + 1 < NT), (t + 1 < NT));         ENDW(t);     RESC2(); ROT();
    STEP(pA0, pA1, pB0, pB1, t + 1, true, (t + 4 < NT), (t + 2 < NT), (t + 2 < NT));     ENDW(t + 1); RESC2(); ROT();
  }
  STEP(pB0, pB1, pA0, pA1, NT - 1, true, false, false, false); RESC2();
  { float sacc = pB0[0] + pB0[1];
#pragma unroll
    for (int r = 2; r < 16; ++r) sacc += pB0[r];
#pragma unroll
    for (int r = 0; r < 16; ++r) sacc += pB1[r];
    l_reg += sacc;
    pw0 = (u32x4){PKW(pB0, 0), PKW(pB0, 2), PKW(pB0, 4), PKW(pB0, 6)}; pw1 = (u32x4){PKW(pB0, 8), PKW(pB0, 10), PKW(pB0, 12), PKW(pB0, 14)};
    pw2 = (u32x4){PKW(pB1, 0), PKW(pB1, 2), PKW(pB1, 4), PKW(pB1, 6)}; pw3 = (u32x4){PKW(pB1, 8), PKW(pB1, 10), PKW(pB1, 12), PKW(pB1, 14)};
    const lds_cptr vp_ = vp0 + sl_cur;
#pragma unroll
    for (int ks = 0; ks < 4; ++ks) {
      VRDS(0, 0, ks); VRDS(1, 1, ks); VRDS(2, 2, ks); VRDS(3, 3, ks);
      const bf16x8 pa = ks == 0 ? PAF(0) : ks == 1 ? PAF(1) : ks == 2 ? PAF(2) : PAF(3);
      o[0] = MFMA32(pa, VFR(0), o[0]); o[1] = MFMA32(pa, VFR(1), o[1]); o[2] = MFMA32(pa, VFR(2), o[2]); o[3] = MFMA32(pa, VFR(3), o[3]); } }
  { auto rr = __builtin_amdgcn_permlane32_swap(__float_as_uint(l_reg), __float_as_uint(l_reg), false, false); l_reg = __uint_as_float(rr[0]) + __uint_as_float(rr[1]); }
  float* li_l = wsf + 32;
  if (hi == 0) li_l[r32] = l_reg; asm volatile("s_waitcnt lgkmcnt(0)" ::: "memory");
  float rli[16];
  const float fac = sm ? P.lam : 1.f;
#pragma unroll
  for (int r = 0; r < 16; ++r) rli[r] = __builtin_amdgcn_rcpf(li_l[crow(r, hi)]) * fac;
  WAIT_BAR(0);
  float* stg = (float*)lds + wq * (32 * STG_LD);
  if (sm == 1) {
#pragma unroll
    for (int d0 = 0; d0 < 4; ++d0)
#pragma unroll
      for (int r = 0; r < 16; ++r) stg[crow(r, hi) * STG_LD + d0 * 32 + r32] = o[d0][r] * rli[r];
  }
  __syncthreads();
  if (sm == 0) {
#pragma unroll
    for (int d0 = 0; d0 < 4; ++d0)
#pragma unroll
      for (int r = 0; r < 16; ++r) { float* p = &stg[crow(r, hi) * STG_LD + d0 * 32 + r32]; *p = o[d0][r] * rli[r] - *p; }
    asm volatile("s_waitcnt lgkmcnt(0)" ::: "memory");
    const float* rp = stg + r32 * STG_LD + hi * 64;
    f32x4 v[16]; float ss = 0.f;
#pragma unroll
    for (int i = 0; i < 16; ++i) { v[i] = *(const f32x4*)(rp + 4 * i); ss += (v[i].x * v[i].x + v[i].y * v[i].y) + (v[i].z * v[i].z + v[i].w * v[i].w); }
    { auto rr = __builtin_amdgcn_permlane32_swap(__float_as_uint(ss), __float_as_uint(ss), false, false); ss = __uint_as_float(rr[0]) + __uint_as_float(rr[1]); }
    const float rs = 0.8f / sqrtf(ss * (1.f / 128.f) + 1e-5f);
    unsigned char* Ow = P.O8 + (rowbase + q0 + wq * QBLK + r32) * LD + h * 128 + hi * 64;
    const float* gp = P.subln_g + hi * 64; const float rq = rs * P.inv_s;
#pragma unroll
    for (int i = 0; i < 4; ++i) { u32x4 w;
#pragma unroll
      for (int q = 0; q < 4; ++q) { const f32x4 g = *(const f32x4*)(gp + 16 * i + 4 * q); const f32x4 a = v[4 * i + q] * rq * g;
        w[q] = ((unsigned)((int)__builtin_rintf(a.x)) & 255u) | (((unsigned)((int)__builtin_rintf(a.y)) & 255u) << 8) | (((unsigned)((int)__builtin_rintf(a.z)) & 255u) << 16) | (((unsigned)((int)__builtin_rintf(a.w)) & 255u) << 24); }
      *(u32x4*)(Ow + 16 * i) = w; }
    if (h == 0 && hi == 0) { float sv; asm volatile("v_mov_b32 %0, %1" : "=v"(sv) : "s"(P.s)); P.OS[rowbase + q0 + wq * QBLK + r32] = sv; }
  }
  __syncthreads();
#undef RFL
#undef DMA_K
#undef DMA_V
#undef ROT
#undef RESC2
#undef PKW
#undef PAF
#undef VFR
#undef VRDS
#undef KRD
#undef GAPA
#undef EX
#undef GAPB
#undef STEP
#undef ENDW
}
#undef SBAR
}
constexpr int NWAVES = 8;
constexpr int BATCH = 4, SEQ = 8192, DM = 2048, T = BATCH * SEQ;
constexpr int IN_COLS = 8192, PW_ = 1024, NEXP = 16384, PLE = 256;
constexpr float LN_EPS = 1e-5f;
constexpr float ALPHA = 1.189207115002721f;
constexpr int N_PHASES = 14;
constexpr int N_LAUNCHES = MK_N_LAUNCHES;
static_assert(N_LAUNCHES == 1, "one launch only (the prologue has an internal grid barrier)");

constexpr size_t MiB = 1u << 20;
constexpr size_t WS_CTL = 0, CTL_ZERO_BYTES = 64 * 1024;
constexpr size_t WS_WBP = 2 * MiB, WS_WBA = 6 * MiB, WS_WOUT = 10 * MiB, WS_WQG = 18 * MiB, WS_PLEW = 34 * MiB, WS_POOLW = 35 * MiB;
constexpr size_t WS_WIN = 36 * MiB, WS_U = 68 * MiB, WS_V = 92 * MiB, WS_X6 = 116 * MiB;
constexpr size_t WS_XN = 196 * MiB, WS_XN8 = WS_XN, WS_YP8 = WS_XN + 64 * MiB;
constexpr size_t WS_PB = 324 * MiB;
constexpr size_t WS_XP = 340 * MiB, WS_Q = 404 * MiB, WS_YP = 532 * MiB;
constexpr size_t WS_K = 596 * MiB, WS_VV = 660 * MiB;
constexpr size_t WS_G0 = 724 * MiB, WS_G1 = 852 * MiB;
constexpr size_t WS_END = 980 * MiB;
constexpr size_t WS_YA = WS_XP  , WS_MERGED = WS_K  , WS_MERGED2 = WS_K  , WS_Z1 = WS_Q  , WS_X1 = WS_G0, WS_PWB = WS_G1, WS_QP = WS_XN, WS_ZE = WS_K;
constexpr size_t WS_WFOLD = WS_YP  ;
constexpr size_t WS_IDS = WS_YP, WS_GATES = WS_YP + 16 * MiB, WS_IDS16 = WS_YP + 32 * MiB  , WS_AW16 = WS_YP + 40 * MiB  , WS_IDT = WS_YP + 48 * MiB  ;
constexpr size_t WS_WIN8 = WS_WIN  , WS_SXN = WS_WIN + 16 * MiB  , WS_SX1 = WS_WIN + 17 * MiB  , WS_WG8 = WS_WQG + 8 * MiB  ;
constexpr size_t WS_MIX = WS_G1 + 64 * MiB  , WS_X18 = WS_XP  ;
constexpr size_t WS_YA8 = WS_G0 + 64 * MiB  , WS_M28 = WS_XP  ;
constexpr size_t WS_SYP = WS_WIN + 18 * MiB, WS_SYA = WS_WIN + 19 * MiB, WS_SM2 = WS_WIN + 20 * MiB;
constexpr int CW_WMAX_IN = 8192, CW_WMAX_G = 8256, CW_WMAX_BP = 8320, CW_WMAX_BA = 8384, CW_WMAX_O = 8448, CW_WMAX_Q = 8512, CW_WMAX_F = 8576;
constexpr size_t WS_HP = WS_XN  , WS_AW = WS_XP  , WS_Z = WS_Q  ;
constexpr int CW_TMO = 0, CW_CODE = 1, CW_BAR = 4096;

constexpr int RING_OFF = 0, RING_BYTES = 131072;
constexpr int LDSCTL_OFF = RING_BYTES, MISC_OFF = LDSCTL_OFF + 320;
constexpr int LDS_BYTES = 147456;
static_assert(MISC_OFF + 128 <= LDS_BYTES && attn::LDS_BYTES <= RING_BYTES, "LDS map");

#define GAS __attribute__((address_space(1)))
#define LAS __attribute__((address_space(3)))
typedef unsigned short bf16;
typedef unsigned v4u __attribute__((ext_vector_type(4)));
typedef float f32x4 __attribute__((ext_vector_type(4)));
typedef float f32x16 __attribute__((ext_vector_type(16)));
typedef short bf16x8 __attribute__((ext_vector_type(8)));
typedef __bf16 bf16x2_t __attribute__((ext_vector_type(2)));
typedef GAS unsigned gu32;
#define RLX_AGENT __ATOMIC_RELAXED, __HIP_MEMORY_SCOPE_AGENT
#define LDS_WAIT() asm volatile("s_waitcnt lgkmcnt(0)" ::: "memory")
#define VM_WAIT() asm volatile("s_waitcnt vmcnt(0)" ::: "memory")
__device__ __forceinline__ unsigned f2bf(float f) { unsigned u = __builtin_bit_cast(unsigned, f); return (u + 0x7fffu + ((u >> 16) & 1u)) >> 16; }
__device__ __forceinline__ unsigned pk2(float lo, float hi) { return f2bf(lo) | (f2bf(hi) << 16); }
using pg8::bf_lo; using pg8::bf_hi;

#define XB_TMO      128
#define XB_XCNT(j)  (256  + 64 * (j))
#define XB_XSUB(j)  (1280 + 64 * (j))
#define XB_XGEN(j)  (2304 + 64 * (j))
#define XB_TOP      3328
#define XB_TOPGEN   3392
#define XCD_BAR_WORDS 3456
#define XB_SPIN_CAP (1u << 18)

__device__ __forceinline__ unsigned xb_ld(unsigned* p)              { return __hip_atomic_load(p, __ATOMIC_RELAXED, __HIP_MEMORY_SCOPE_AGENT); }
__device__ __forceinline__ unsigned xb_add(unsigned* p, unsigned v) { return __hip_atomic_fetch_add(p, v, __ATOMIC_RELAXED, __HIP_MEMORY_SCOPE_AGENT); }
__device__ __forceinline__ unsigned xb_xcc_id() { return (unsigned)__builtin_amdgcn_s_getreg((3 << 11) | 20) & 0xFu; }
#define XB_SPIN(cond, bar) do { unsigned _sp = 0; while (cond) { __builtin_amdgcn_s_sleep(1); \
    if ((++_sp & 255u) == 0u) { if (xb_ld(&(bar)[XB_TMO])) break; if (_sp > XB_SPIN_CAP) { atomicAdd(&(bar)[XB_TMO], 1u); break; } } } } while (0)

struct XcdBarrier {
    unsigned* bar; unsigned x;
    volatile LAS unsigned* st;
};
__device__ __forceinline__ XcdBarrier xcd_barrier_post(unsigned* bar, volatile LAS unsigned* st) {
    XcdBarrier b; b.bar = bar; b.x = xb_xcc_id(); b.st = st;
    if (threadIdx.x == 0) (void)xb_add(&bar[XB_XCNT(b.x)], 1u);
    return b;
}
__device__ __forceinline__ void xcd_barrier_complete(unsigned* bar, unsigned x, unsigned& nloc, unsigned& nx) {
    const unsigned G = gridDim.x * gridDim.y * gridDim.z;
    unsigned sum, cnt, mine, sp = 0u;
    for (;;) {
        sum = 0u; cnt = 0u; mine = 0u;
#pragma unroll
        for (unsigned j = 0; j < 16; ++j) { const unsigned c = xb_ld(&bar[XB_XCNT(j)]); sum += c; cnt += (c > 0u) ? 1u : 0u; mine = (j == x) ? c : mine; }
        if (sum == G) break;
        __builtin_amdgcn_s_sleep(1);
        if ((++sp & 255u) == 0u) { if (xb_ld(&bar[XB_TMO])) break; if (sp > XB_SPIN_CAP) { atomicAdd(&bar[XB_TMO], 1u); break; } }
    }
    nloc = mine > 0u ? mine : 1u; nx = cnt > 0u ? cnt : 1u;
}
__device__ __forceinline__ void xcd_barrier(const XcdBarrier& b, const bool is_t0  ) {
    asm volatile("s_waitcnt vmcnt(0)" ::: "memory");
    __syncthreads();
    if (is_t0) {
        unsigned* bar = b.bar;
        __builtin_amdgcn_s_waitcnt(0);
        unsigned nloc = b.st[0], nx = b.st[1];
        if (nloc == 0u) { xcd_barrier_complete(bar, b.x, nloc, nx); b.st[0] = nloc; b.st[1] = nx; }
        const unsigned old = xb_add(&bar[XB_XSUB(b.x)], 1u);
        const unsigned gen = old / nloc;
        if (old + 1u == (gen + 1u) * nloc) {
            __builtin_amdgcn_fence(__ATOMIC_RELEASE, "agent");
            asm volatile("s_waitcnt vmcnt(0)" ::: "memory");
            const unsigned og = xb_add(&bar[XB_TOP], 1u);
            const unsigned tg = og / nx;
            if (og + 1u == (tg + 1u) * nx) xb_add(&bar[XB_TOPGEN], 1u);
            else XB_SPIN(xb_ld(&bar[XB_TOPGEN]) == tg, bar);
            __builtin_amdgcn_fence(__ATOMIC_ACQUIRE, "agent");
            xb_add(&bar[XB_XGEN(b.x)], 1u);
            asm volatile("s_waitcnt vmcnt(0)" ::: "memory");
        } else {
            XB_SPIN(xb_ld(&bar[XB_XGEN(b.x)]) == gen, bar);
            __builtin_amdgcn_fence(__ATOMIC_ACQUIRE, "agent");
            asm volatile("s_waitcnt vmcnt(0)" ::: "memory");
        }
    }
    __syncthreads();
}

__device__ __forceinline__ void xcd_barrier_arrive(const XcdBarrier& b, const bool is_t0) {
    asm volatile("s_waitcnt vmcnt(0)" ::: "memory");
    __syncthreads();
    if (is_t0) {
        unsigned* bar = b.bar;
        __builtin_amdgcn_s_waitcnt(0);
        unsigned nloc = b.st[0], nx = b.st[1];
        if (nloc == 0u) { xcd_barrier_complete(bar, b.x, nloc, nx); b.st[0] = nloc; b.st[1] = nx; }
        const unsigned old = xb_add(&bar[XB_XSUB(b.x)], 1u);
        const unsigned gen = old / nloc;
        b.st[2] = gen;
        if (old + 1u == (gen + 1u) * nloc) {
            __builtin_amdgcn_fence(__ATOMIC_RELEASE, "agent");
            asm volatile("s_waitcnt vmcnt(0)" ::: "memory");
            xb_add(&bar[XB_XGEN(b.x)], 1u);
            const unsigned og = xb_add(&bar[XB_TOP], 1u);
            const unsigned tg = og / nx;
            if (og + 1u == (tg + 1u) * nx) xb_add(&bar[XB_TOPGEN], 1u);
        }
    }
}
__device__ __forceinline__ void xcd_barrier_wait(const XcdBarrier& b, const bool is_t0) {
    if (is_t0) {
        unsigned* bar = b.bar; const unsigned gen = b.st[2];
        XB_SPIN(xb_ld(&bar[XB_TOPGEN]) <= gen, bar);
        __builtin_amdgcn_fence(__ATOMIC_ACQUIRE, "agent");
        asm volatile("s_waitcnt vmcnt(0)" ::: "memory");
    }
    __syncthreads();
}

__device__ __forceinline__ int lane_id_now() { int l; asm volatile("v_mbcnt_lo_u32_b32 %0, -1, 0\n\tv_mbcnt_hi_u32_b32 %0, -1, %0" : "=v"(l)); return l; }
struct Frame {
    LAS unsigned char* lds;
    volatile LAS unsigned* MISC;
    gu32* ctl;
    int tid, lane, wave;
    int vcu, G;
};
__device__ __forceinline__ float wave_sum(float v) {
#pragma unroll
    for (int o = 1; o < 64; o <<= 1) v += __shfl_xor(v, o);
    return v;
}
__device__ __forceinline__ void p0_transpose_item(const float* W, int K, int N, bf16* WT, int row_off, LAS float* scr, int item, int lane) {
    const int nblk = N / 32, kb = item / nblk, nb = item % nblk, k0 = 64 * kb, n0 = 32 * nb;
    { float v[32];
#pragma unroll
      for (int i = 0; i < 32; ++i) { const int kk = 2 * i + (lane >> 5); v[i] = ((const GAS float*)W)[(size_t)(k0 + kk) * N + n0 + (lane & 31)]; }
#pragma unroll
      for (int i = 0; i < 32; ++i) { const int kk = 2 * i + (lane >> 5); scr[kk * 33 + (lane & 31)] = v[i]; } }
    LDS_WAIT(); asm volatile("" ::: "memory");
    const int c = lane & 7;
#pragma unroll
    for (int j = 0; j < 4; ++j) { const int n = (lane >> 3) + 8 * j; const LAS float* s = scr + (8 * c) * 33 + n;
        v4u o; o.x = pk2(s[0 * 33], s[1 * 33]); o.y = pk2(s[2 * 33], s[3 * 33]); o.z = pk2(s[4 * 33], s[5 * 33]); o.w = pk2(s[6 * 33], s[7 * 33]);
        *(GAS v4u*)(WT + (size_t)(row_off + n0 + n) * K + k0 + 8 * c) = o; }
    LDS_WAIT(); asm volatile("" ::: "memory");
}
__device__ __forceinline__ float wave_max(float v) {
#pragma unroll
    for (int o = 1; o < 64; o <<= 1) v = fmaxf(v, __shfl_xor(v, o));
    return v;
}
__device__ __forceinline__ unsigned q8(float v) { return (unsigned)((int)__builtin_rintf(v)) & 0xFFu; }
__device__ __forceinline__ void ln0_rows(int lane, const float* x, const float* g, const float* bta, unsigned char* o8, float* oscale, int gw, int ngw) {
    int m = gw; if (m >= T) return;
    f32x4 gg[8], bb[8], v[8];
#pragma unroll
    for (int j = 0; j < 8; ++j) { gg[j] = ((const GAS f32x4*)g)[lane + 64 * j]; bb[j] = ((const GAS f32x4*)bta)[lane + 64 * j]; v[j] = ((const GAS f32x4*)(x + (size_t)m * DM))[lane + 64 * j]; }
#pragma unroll 1
    for (;;) {
        const int mn = m + ngw; const bool has = mn < T; f32x4 nv[8];
        { const GAS f32x4* xr = (const GAS f32x4*)(x + (size_t)(has ? mn : m) * DM) + lane;
#pragma unroll
          for (int j = 0; j < 8; ++j) nv[j] = xr[64 * j]; }
        float s = 0.f;
#pragma unroll
        for (int j = 0; j < 8; ++j) s += (v[j].x + v[j].y) + (v[j].z + v[j].w);
        const float mean = wave_sum(s) * (1.f / DM); float s2 = 0.f;
#pragma unroll
        for (int j = 0; j < 8; ++j) { v[j] = v[j] - mean; s2 += (v[j].x * v[j].x + v[j].y * v[j].y) + (v[j].z * v[j].z + v[j].w * v[j].w); }
        const float rstd = 1.f / sqrtf(wave_sum(s2) * (1.f / DM) + LN_EPS);
        float am = 0.f;
#pragma unroll
        for (int j = 0; j < 8; ++j) { v[j] = v[j] * rstd * gg[j] + bb[j];
            am = fmaxf(fmaxf(am, fmaxf(fabsf(v[j].x), fabsf(v[j].y))), fmaxf(fabsf(v[j].z), fabsf(v[j].w))); }
        am = fmaxf(wave_max(am), 1e-20f); const float inv = 127.f / am;
        GAS unsigned* q = (GAS unsigned*)(o8 + (size_t)m * DM) + lane;
#pragma unroll
        for (int j = 0; j < 8; ++j) q[64 * j] = q8(v[j].x * inv) | (q8(v[j].y * inv) << 8) | (q8(v[j].z * inv) << 16) | (q8(v[j].w * inv) << 24);
        if (lane == 0) oscale[m] = am * (1.f / 127.f);
        if (!has) break;
#pragma unroll
        for (int j = 0; j < 8; ++j) v[j] = nv[j];
        m = mn;
    }
}
__device__ __forceinline__ void p0_transpose_item_i8(const float* W, int K, int N, unsigned char* WT, LAS float* scr, int item, int lane, float inv) {
    const int nblk = N / 32, kb = item / nblk, nb = item % nblk, k0 = 64 * kb, n0 = 32 * nb;
    { float v[32];
#pragma unroll
      for (int i = 0; i < 32; ++i) { const int kk = 2 * i + (lane >> 5); v[i] = ((const GAS float*)W)[(size_t)(k0 + kk) * N + n0 + (lane & 31)]; }
#pragma unroll
      for (int i = 0; i < 32; ++i) { const int kk = 2 * i + (lane >> 5); scr[kk * 33 + (lane & 31)] = v[i]; } }
    LDS_WAIT(); asm volatile("" ::: "memory");
    const int c = lane & 7;
#pragma unroll
    for (int j = 0; j < 4; ++j) { const int n = (lane >> 3) + 8 * j; const LAS float* sp = scr + (8 * c) * 33 + n;
        const unsigned lo = q8(sp[0 * 33] * inv) | (q8(sp[1 * 33] * inv) << 8) | (q8(sp[2 * 33] * inv) << 16) | (q8(sp[3 * 33] * inv) << 24);
        const unsigned hi = q8(sp[4 * 33] * inv) | (q8(sp[5 * 33] * inv) << 8) | (q8(sp[6 * 33] * inv) << 16) | (q8(sp[7 * 33] * inv) << 24);
        *(GAS unsigned long long*)(WT + (size_t)(n0 + n) * K + k0 + 8 * c) = (unsigned long long)lo | ((unsigned long long)hi << 32); }
    LDS_WAIT(); asm volatile("" ::: "memory");
}
__device__ __forceinline__ void absmax_stream(const float* src, size_t n4, gu32* word, size_t gtid, size_t nthr, int lane) {
    float m = 0.f; size_t i = gtid;
    for (; i + 3 * nthr < n4; i += 4 * nthr) { f32x4 a[4];
#pragma unroll
        for (int u = 0; u < 4; ++u) a[u] = ((const GAS f32x4*)src)[i + u * nthr];
#pragma unroll
        for (int u = 0; u < 4; ++u) m = fmaxf(fmaxf(m, fmaxf(fabsf(a[u].x), fabsf(a[u].y))), fmaxf(fabsf(a[u].z), fabsf(a[u].w))); }
    for (; i < n4; i += nthr) { const f32x4 a = ((const GAS f32x4*)src)[i]; m = fmaxf(fmaxf(m, fmaxf(fabsf(a.x), fabsf(a.y))), fmaxf(fabsf(a.z), fabsf(a.w))); }
    m = wave_max(m);
    if (lane == 0) __hip_atomic_fetch_max(word, __float_as_uint(m), RLX_AGENT);
}
__device__ __forceinline__ void cvt_stream(const float* src, bf16* dst, size_t n8, size_t gtid, size_t nthr) {
    size_t i = gtid;
    for (; i + 3 * nthr < n8; i += 4 * nthr) { f32x4 a[4], b[4];
#pragma unroll
        for (int u = 0; u < 4; ++u) { a[u] = ((const GAS f32x4*)src)[2 * (i + u * nthr)]; b[u] = ((const GAS f32x4*)src)[2 * (i + u * nthr) + 1]; }
#pragma unroll
        for (int u = 0; u < 4; ++u) { v4u o; o.x = pk2(a[u].x, a[u].y); o.y = pk2(a[u].z, a[u].w); o.z = pk2(b[u].x, b[u].y); o.w = pk2(b[u].z, b[u].w); ((GAS v4u*)dst)[i + u * nthr] = o; } }
    for (; i < n8; i += nthr) { const f32x4 a = ((const GAS f32x4*)src)[2 * i], b = ((const GAS f32x4*)src)[2 * i + 1];
        v4u o; o.x = pk2(a.x, a.y); o.y = pk2(a.z, a.w); o.z = pk2(b.x, b.y); o.w = pk2(b.z, b.w); ((GAS v4u*)dst)[i] = o; }
}

struct Args { const float* in[28]; float* out; unsigned char* ws; int ph_lo, ph_hi, li, pad; };
constexpr float F8_F = 16.f, F8_PW = 8.f, F8_M = 32.f;
typedef float f32x2c __attribute__((ext_vector_type(2)));
__device__ __forceinline__ unsigned pack_fp8x4(float a, float b, float c, float d) { int w = 0; w = __builtin_amdgcn_cvt_pk_fp8_f32(a, b, w, false); w = __builtin_amdgcn_cvt_pk_fp8_f32(c, d, w, true); return (unsigned)w; }
__device__ __forceinline__ f32x4 unpack_fp8x4(unsigned w) { const f32x2c lo = __builtin_amdgcn_cvt_pk_f32_fp8((int)w, false), hi = __builtin_amdgcn_cvt_pk_f32_fp8((int)w, true); return (f32x4){lo.x, lo.y, hi.x, hi.y}; }
__device__ __forceinline__ void pool_mix_quant_phase(const bf16* XP, unsigned char* M8, float* SM, LAS float* xch  , int bstart, int bstride, int tid) {
    const int wv = __builtin_amdgcn_readfirstlane(tid >> 6), lane = tid & 63, sb = wv >> 1, ch = (wv & 1) * 64 + lane, g = ch >> 5, w = 2 << g;
    int par = 0;
    for (int b = bstart; b < T / 128; b += bstride) {
        const int t0 = b * 128 + sb * 32, tt0 = t0 & (SEQ - 1);
        const GAS v4u* p = (const GAS v4u*)(XP + (size_t)t0 * PW_ + ch * 8);
        f32x4 s0 = {0.f, 0.f, 0.f, 0.f}, s1 = s0;
        v4u rin[8], rout[8];
#define PMQ_LOAD(c4_) _Pragma("unroll") for (int k = 0; k < 8; ++k) { const int r = 8 * (c4_) + k, tt = tt0 + r; rin[k] = p[(size_t)r * (PW_ / 8)]; \
            rout[k] = (tt - w + 1 >= 0) ? *(p + (ptrdiff_t)(r - w + 1) * (PW_ / 8)) : (v4u){0u, 0u, 0u, 0u}; }
        PMQ_LOAD(0)
        for (int k = 1; k < w; ++k) if (tt0 - k >= 0) { f32x4 a, bq; pg8::unpack8(*(p - (size_t)k * (PW_ / 8)), a, bq); s0 += a; s1 += bq; }
#pragma unroll 1
        for (int c4 = 0; c4 < 4; ++c4) {
            f32x4 o0[8], o1[8]; float m[8];
#pragma unroll
            for (int k = 0; k < 8; ++k) { const int r = 8 * c4 + k, tt = tt0 + r; f32x4 x0, x1; pg8::unpack8(rin[k], x0, x1); s0 += x0; s1 += x1;
                const int n = (tt + 1 < w) ? tt + 1 : w; const float inv = 1.f / (float)n;
                o0[k] = s0 * inv - x0; o1[k] = s1 * inv - x1;
                m[k] = fmaxf(fmaxf(fmaxf(fabsf(o0[k].x), fabsf(o0[k].y)), fmaxf(fabsf(o0[k].z), fabsf(o0[k].w))), fmaxf(fmaxf(fabsf(o1[k].x), fabsf(o1[k].y)), fmaxf(fabsf(o1[k].z), fabsf(o1[k].w))));
                { f32x4 a, bq; pg8::unpack8(rout[k], a, bq); s0 -= a; s1 -= bq; } }
            if (c4 < 3) { PMQ_LOAD(c4 + 1) }
#pragma unroll
            for (int k = 0; k < 8; ++k) m[k] = wave_max(m[k]);
            LAS float* mine = xch + (par * 8 + wv) * 8; const LAS float* other = xch + (par * 8 + (wv ^ 1)) * 8;
            if (lane == 0) { *(LAS f32x4*)mine = (f32x4){m[0], m[1], m[2], m[3]}; *(LAS f32x4*)(mine + 4) = (f32x4){m[4], m[5], m[6], m[7]}; }
            __syncthreads();
            const f32x4 pa = *(const LAS f32x4*)other, pb = *(const LAS f32x4*)(other + 4);
#pragma unroll
            for (int k = 0; k < 8; ++k) { const float am = fmaxf(fmaxf(m[k], k < 4 ? pa[k & 3] : pb[k & 3]), 1e-20f), inv = 127.f / am; const int r = 8 * c4 + k;
                const f32x4 a = o0[k] * inv, bq = o1[k] * inv;
                *(GAS unsigned long long*)(M8 + (size_t)(t0 + r) * PW_ + ch * 8) = (unsigned long long)(q8(a.x) | (q8(a.y) << 8) | (q8(a.z) << 16) | (q8(a.w) << 24)) | ((unsigned long long)(q8(bq.x) | (q8(bq.y) << 8) | (q8(bq.z) << 16) | (q8(bq.w) << 24)) << 32);
                if ((wv & 1) == 0 && lane == 0) SM[t0 + r] = am * (1.f / 127.f); }
            par ^= 1;
        }
#undef PMQ_LOAD
    }
}
template <int NC, int R> __device__ __forceinline__ void quant_rows(const bf16* X, unsigned char* X8, float* XS, int gw, int ngw, int lane) {
    constexpr int NV = NC / 512;
    for (int t0 = gw; t0 < T; t0 += R * ngw) {
        v4u raw[R][NV];
#pragma unroll
        for (int r = 0; r < R; ++r) { const int t = (t0 + r * ngw < T) ? t0 + r * ngw : t0; const GAS v4u* xr = (const GAS v4u*)(X + (size_t)t * NC) + lane;
#pragma unroll
            for (int j = 0; j < NV; ++j) raw[r][j] = xr[64 * j]; }
#pragma unroll
        for (int r = 0; r < R; ++r) { const int t = t0 + r * ngw; if (t >= T) break;
            f32x4 v[2 * NV]; float am = 0.f;
#pragma unroll
            for (int j = 0; j < NV; ++j) pg8::unpack8(raw[r][j], v[2 * j], v[2 * j + 1]);
#pragma unroll
            for (int j = 0; j < 2 * NV; ++j) am = fmaxf(fmaxf(am, fmaxf(fabsf(v[j].x), fabsf(v[j].y))), fmaxf(fabsf(v[j].z), fabsf(v[j].w)));
            am = fmaxf(wave_max(am), 1e-20f); const float inv = 127.f / am;
            GAS unsigned long long* qr = (GAS unsigned long long*)(X8 + (size_t)t * NC) + lane;
#pragma unroll
            for (int j = 0; j < NV; ++j) { const f32x4 a = v[2 * j] * inv, b = v[2 * j + 1] * inv;
                qr[64 * j] = (unsigned long long)(q8(a.x) | (q8(a.y) << 8) | (q8(a.z) << 16) | (q8(a.w) << 24)) | ((unsigned long long)(q8(b.x) | (q8(b.y) << 8) | (q8(b.z) << 16) | (q8(b.w) << 24)) << 32); }
            if (lane == 0) XS[t] = am * (1.f / 127.f); }
    }
}
typedef float v16f_t __attribute__((ext_vector_type(16)));
typedef unsigned v6u_t __attribute__((ext_vector_type(6)));
typedef unsigned v2u_t __attribute__((ext_vector_type(2)));
constexpr int SLICE_ROWB = 192;
template <int R> __device__ __forceinline__ void quant_rows_sum8(const unsigned char* A8, const unsigned char* B8, unsigned char* X8, float* XS, int gw, int ngw, int lane) {
    int t0 = gw; if (t0 >= T) return;
    v2u_t ra[R][4], rb[R][4];
#define QRS_LOAD(da, db, tb) _Pragma("unroll") for (int r = 0; r < R; ++r) { const int t = ((tb) + r * ngw < T) ? (tb) + r * ngw : (tb); \
        _Pragma("unroll") for (int j = 0; j < 4; ++j) { const size_t o = (size_t)t * DM + j * 512 + lane * 8; da[r][j] = *(const GAS v2u_t*)(A8 + o); db[r][j] = *(const GAS v2u_t*)(B8 + o); } }
    QRS_LOAD(ra, rb, t0)
#pragma unroll 1
    for (;;) {
        const int tn = t0 + R * ngw; const bool has = tn < T; const int tl = has ? tn : t0; v2u_t na[R][4], nb[R][4];
        QRS_LOAD(na, nb, tl)
#pragma unroll
        for (int r = 0; r < R; ++r) { const int t = t0 + r * ngw; if (t >= T) break;
            f32x4 v[8]; float am = 0.f;
#pragma unroll
            for (int j = 0; j < 4; ++j) { v[2 * j] = unpack_fp8x4(ra[r][j].x) + unpack_fp8x4(rb[r][j].x); v[2 * j + 1] = unpack_fp8x4(ra[r][j].y) + unpack_fp8x4(rb[r][j].y); }
#pragma unroll
            for (int j = 0; j < 8; ++j) am = fmaxf(fmaxf(am, fmaxf(fabsf(v[j].x), fabsf(v[j].y))), fmaxf(fabsf(v[j].z), fabsf(v[j].w)));
            am = fmaxf(wave_max(am), 1e-20f); const float inv = 127.f / am;
            GAS unsigned long long* qr = (GAS unsigned long long*)(X8 + (size_t)t * DM) + lane;
#pragma unroll
            for (int j = 0; j < 4; ++j) { const f32x4 a = v[2 * j] * inv, b = v[2 * j + 1] * inv;
                qr[64 * j] = (unsigned long long)(q8(a.x) | (q8(a.y) << 8) | (q8(a.z) << 16) | (q8(a.w) << 24)) | ((unsigned long long)(q8(b.x) | (q8(b.y) << 8) | (q8(b.z) << 16) | (q8(b.w) << 24)) << 32); }
            if (lane == 0) XS[t] = am * (1.f / (127.f * F8_M)); }
        if (!has) break;
#pragma unroll
        for (int r = 0; r < R; ++r)
#pragma unroll
            for (int j = 0; j < 4; ++j) { ra[r][j] = na[r][j]; rb[r][j] = nb[r][j]; }
        t0 = tn;
    }
#undef QRS_LOAD
}
__device__ __forceinline__ void ln_rows_bf16(const bf16* Z, unsigned char* X8, unsigned char* X6, float* XS, const float* g, const float* bta, int gw, int ngw, int lane) {
    int t = gw; if (t >= T) return;
    f32x4 gg[8], bb[8]; v4u zw[4];
    { const GAS f32x4* gp = (const GAS f32x4*)(g + lane * 32); const GAS f32x4* bp = (const GAS f32x4*)(bta + lane * 32); const GAS v4u* zr = (const GAS v4u*)(Z + (size_t)t * DM + lane * 32);
#pragma unroll
      for (int j = 0; j < 8; ++j) { gg[j] = gp[j]; bb[j] = bp[j]; }
#pragma unroll
      for (int j = 0; j < 4; ++j) zw[j] = zr[j]; }
#pragma unroll 1
    for (;;) {
        const int tn = t + ngw; const bool has = tn < T; v4u nz[4];
        { const GAS v4u* zr = (const GAS v4u*)(Z + (size_t)(has ? tn : t) * DM + lane * 32);
#pragma unroll
          for (int j = 0; j < 4; ++j) nz[j] = zr[j]; }
        f32x4 v[8]; float s = 0.f;
#pragma unroll
        for (int j = 0; j < 4; ++j) pg8::unpack8(zw[j], v[2 * j], v[2 * j + 1]);
#pragma unroll
        for (int j = 0; j < 8; ++j) s += (v[j].x + v[j].y) + (v[j].z + v[j].w);
        const float mean = wave_sum(s) * (1.f / DM); float s2 = 0.f;
#pragma unroll
        for (int j = 0; j < 8; ++j) { v[j] = v[j] - mean; s2 += (v[j].x * v[j].x + v[j].y * v[j].y) + (v[j].z * v[j].z + v[j].w * v[j].w); }
        const float rstd = 1.f / sqrtf(wave_sum(s2) * (1.f / DM) + LN_EPS);
        float am = 0.f;
#pragma unroll
        for (int j = 0; j < 8; ++j) v[j] = v[j] * rstd * gg[j] + bb[j];
#pragma unroll
        for (int j = 0; j < 8; ++j) am = fmaxf(fmaxf(am, fmaxf(fabsf(v[j].x), fabsf(v[j].y))), fmaxf(fabsf(v[j].z), fabsf(v[j].w)));
        am = fmaxf(wave_max(am), 1e-20f); const float inv = 127.f / am, inv6 = 7.5f / am;
        GAS v4u* qr = (GAS v4u*)(X8 + (size_t)t * DM + lane * 32);
#pragma unroll
        for (int j = 0; j < 2; ++j) { v4u o;
#pragma unroll
            for (int i = 0; i < 4; ++i) { const f32x4 a = v[4 * j + i] * inv; o[i] = q8(a.x) | (q8(a.y) << 8) | (q8(a.z) << 16) | (q8(a.w) << 24); }
            qr[j] = o; }
        v16f_t lo, hi;
#pragma unroll
        for (int j = 0; j < 8; ++j) { const f32x4 a = v[j] * inv6; lo[2 * j] = a.x; hi[2 * j] = a.y; lo[2 * j + 1] = a.z; hi[2 * j + 1] = a.w; }
        const v6u_t p6 = __builtin_amdgcn_cvt_scalef32_2xpk16_fp6_f32(lo, hi, 1.0f);
        { const int sl = lane >> 3, jb = lane & 7, cb = jb >> 2, gq = jb & 3; unsigned char* r6 = X6 + ((size_t)sl * T + t) * SLICE_ROWB + gq * 16;
          *(GAS v4u*)(r6 + cb * 64) = (v4u){p6[0], p6[1], p6[2], p6[3]}; *(GAS v2u_t*)(r6 + 128 + cb * 8) = (v2u_t){p6[4], p6[5]}; }
        if (lane == 0) XS[t] = am * (1.f / 127.f);
        if (!has) break;
#pragma unroll
        for (int j = 0; j < 4; ++j) zw[j] = nz[j];
        t = tn;
    }
}

namespace psel {
constexpr float NEG = -3.0e38f;
#define PKSWZ(row, colB) ((row) * 256 + ((colB) ^ (((row) & 7) << 4)))
__device__ __forceinline__ int crow(int r, int hi) { return (r & 3) + 8 * (r >> 2) + 4 * hi; }
#define CE_DESC(a, b) do { const float hi_ = fmaxf(a, b), lo_ = fminf(a, b); a = hi_; b = lo_; } while (0)
__device__ __forceinline__ void sort16_desc(float (&x)[16]) {
    CE_DESC(x[0], x[13]); CE_DESC(x[1], x[12]); CE_DESC(x[2], x[15]); CE_DESC(x[3], x[14]); CE_DESC(x[4], x[8]); CE_DESC(x[5], x[6]); CE_DESC(x[7], x[11]); CE_DESC(x[9], x[10]);
    CE_DESC(x[0], x[5]); CE_DESC(x[1], x[7]); CE_DESC(x[2], x[9]); CE_DESC(x[3], x[4]); CE_DESC(x[6], x[13]); CE_DESC(x[8], x[14]); CE_DESC(x[10], x[15]); CE_DESC(x[11], x[12]);
    CE_DESC(x[0], x[1]); CE_DESC(x[2], x[3]); CE_DESC(x[4], x[5]); CE_DESC(x[6], x[8]); CE_DESC(x[7], x[9]); CE_DESC(x[10], x[11]); CE_DESC(x[12], x[13]); CE_DESC(x[14], x[15]);
    CE_DESC(x[0], x[2]); CE_DESC(x[1], x[3]); CE_DESC(x[4], x[10]); CE_DESC(x[5], x[11]); CE_DESC(x[6], x[7]); CE_DESC(x[8], x[9]); CE_DESC(x[12], x[14]); CE_DESC(x[13], x[15]);
    CE_DESC(x[1], x[2]); CE_DESC(x[3], x[12]); CE_DESC(x[4], x[6]); CE_DESC(x[5], x[7]); CE_DESC(x[8], x[10]); CE_DESC(x[9], x[11]); CE_DESC(x[13], x[14]);
    CE_DESC(x[1], x[4]); CE_DESC(x[2], x[6]); CE_DESC(x[5], x[8]); CE_DESC(x[7], x[10]); CE_DESC(x[9], x[13]); CE_DESC(x[11], x[14]);
    CE_DESC(x[2], x[4]); CE_DESC(x[3], x[6]); CE_DESC(x[9], x[12]); CE_DESC(x[11], x[13]);
    CE_DESC(x[3], x[5]); CE_DESC(x[6], x[8]); CE_DESC(x[7], x[9]); CE_DESC(x[10], x[12]);
    CE_DESC(x[3], x[4]); CE_DESC(x[5], x[6]); CE_DESC(x[7], x[8]); CE_DESC(x[9], x[10]); CE_DESC(x[11], x[12]);
    CE_DESC(x[6], x[7]); CE_DESC(x[8], x[9]);
}
__device__ __forceinline__ void merge16_desc(float (&a)[16], const float (&b)[16]) {
#pragma unroll
    for (int i = 0; i < 16; ++i) a[i] = fmaxf(a[i], b[15 - i]);
#pragma unroll
    for (int j = 8; j > 0; j >>= 1)
#pragma unroll
        for (int i = 0; i < 16; ++i) { const int l = i ^ j; if (l > i) CE_DESC(a[i], a[l]); }
}
__device__ __forceinline__ void load_keys(char* lds, const float* k1, const float* k2, int tid) {
#pragma unroll
    for (int i = 0; i < 8; ++i) { const int e = tid + 512 * i, which = e >> 11, rem = e & 2047, row = rem >> 4, cg = rem & 15;
        const GAS f32x4* s = (const GAS f32x4*)((which ? k2 : k1) + row * 128 + cg * 8); const f32x4 a = s[0], b = s[1];
        *(v4u*)(lds + which * 32768 + PKSWZ(row, cg * 16)) = pg8::pack8(a, b); }
}
__device__ __forceinline__ void half_top16(const char* klds, const int (&kofs)[4], const bf16* qb, int hi, float (&out)[16]) {
    bf16x8 bq[8];
#pragma unroll
    for (int ks = 0; ks < 8; ++ks) bq[ks] = *(const GAS bf16x8*)(qb + ks * 16);
    f32x16 acc[4] = {};
#pragma unroll
    for (int ks = 0; ks < 8; ++ks)
#pragma unroll
        for (int rb = 0; rb < 4; ++rb) { const bf16x8 a = *reinterpret_cast<const bf16x8*>(klds + kofs[ks & 3] + rb * 8192 + (ks >> 2) * 128);
            acc[rb] = __builtin_amdgcn_mfma_f32_32x32x16_bf16(a, bq[ks], acc[rb], 0, 0, 0); }
    float g0[16], g1[16], g2[16], g3[16];
#pragma unroll
    for (int r = 0; r < 16; ++r) { const int kb = (r & 3) + 8 * (r >> 2);
        g0[r] = __uint_as_float((__float_as_uint(acc[0][r]) & 0xFFFFFF80u) | (unsigned)(127 ^ kb)); g1[r] = __uint_as_float((__float_as_uint(acc[1][r]) & 0xFFFFFF80u) | (unsigned)(127 ^ (32 + kb)));
        g2[r] = __uint_as_float((__float_as_uint(acc[2][r]) & 0xFFFFFF80u) | (unsigned)(127 ^ (64 + kb))); g3[r] = __uint_as_float((__float_as_uint(acc[3][r]) & 0xFFFFFF80u) | (unsigned)(127 ^ (96 + kb))); }
    sort16_desc(g0); sort16_desc(g1); sort16_desc(g2); sort16_desc(g3);
    merge16_desc(g0, g1); merge16_desc(g2, g3); merge16_desc(g0, g2);
    const unsigned hx = (unsigned)hi << 2; float pr[16];
#pragma unroll
    for (int i = 0; i < 16; ++i) { g0[i] = __uint_as_float(__float_as_uint(g0[i]) ^ hx); pr[i] = __shfl_xor(g0[i], 32); }
    merge16_desc(g0, pr);
#pragma unroll
    for (int i = 0; i < 16; ++i) out[i] = g0[i];
}
__device__ __forceinline__ void select_task(const char* lds, const bf16* QP, int t0, int lane, unsigned short* IDS16, unsigned short* GATES16, unsigned short* IDT) {
    const int r32 = lane & 31, hi = lane >> 5; const int tok = t0 + (r32 >> 3), head = r32 & 7;
    const bf16* qrow = QP + (size_t)tok * DM + head * 256 + hi * 8;
    float o1[16], o2[16];
    int kofs[4];
#pragma unroll
    for (int q = 0; q < 4; ++q) { kofs[q] = r32 * 256 + ((q * 32 + hi * 16) ^ ((r32 & 7) << 4)); asm volatile("" : "+v"(kofs[q])); }
    half_top16(lds, kofs, qrow, hi, o1);
    half_top16(lds + 32768, kofs, qrow + 128, hi, o2);
    float c1[16], c2[16]; unsigned k1p[4] = {0u, 0u, 0u, 0u}, k2p[4] = {0u, 0u, 0u, 0u};
#pragma unroll
    for (int a = 0; a < 16; ++a) { const unsigned b1 = __float_as_uint(o1[a]), b2 = __float_as_uint(o2[a]); c1[a] = __uint_as_float(b1 & 0xFFFFFF80u); c2[a] = __uint_as_float(b2 & 0xFFFFFF80u);
        k1p[a >> 2] |= (127u - (b1 & 0x7Fu)) << ((a & 3) * 8); k2p[a >> 2] |= (127u - (b2 & 0x7Fu)) << ((a & 3) * 8); }
#define CAND(a, b) __uint_as_float((__float_as_uint(c1[a] + c2[b]) & 0xFFFFFF00u) | (unsigned)(((15 - (a)) << 4) | (15 - (b))))
    float L0[16], L1[16], T2[16], S[16], T3[16], L4[16], T4[16], L6[16], L7[16];
#pragma unroll
    for (int b = 0; b < 16; ++b) { L0[b] = CAND(0, b); L1[b] = b < 8 ? CAND(1, b & 7) : NEG; T2[b] = b < 5 ? CAND(2, b < 5 ? b : 0) : NEG; S[b] = b < 8 ? CAND(8 + (b & 7), 0) : NEG;
        T3[b] = b < 4 ? CAND(3, b & 3) : NEG; L4[b] = b < 3 ? CAND(4, b < 3 ? b : 0) : NEG; T4[b] = b < 2 ? CAND(5, b & 1) : NEG; L6[b] = b < 2 ? CAND(6, b & 1) : NEG; L7[b] = b < 2 ? CAND(7, b & 1) : NEG; }
#undef CAND
    merge16_desc(L0, L1); merge16_desc(T2, S); merge16_desc(T3, L4); merge16_desc(T4, L6); merge16_desc(T3, T4); merge16_desc(T3, L7); merge16_desc(T2, T3); merge16_desc(L0, T2);
    int oid[16]; float e[16]; float sum = 0.f; const float mx = L0[0];
#pragma unroll
    for (int i = 0; i < 16; ++i) { const unsigned bits = __float_as_uint(L0[i]); const int a = 15 - (int)((bits >> 4) & 15u), b = 15 - (int)(bits & 15u);
        const unsigned w1 = (a >> 2) == 0 ? k1p[0] : (a >> 2) == 1 ? k1p[1] : (a >> 2) == 2 ? k1p[2] : k1p[3]; const unsigned w2 = (b >> 2) == 0 ? k2p[0] : (b >> 2) == 1 ? k2p[1] : (b >> 2) == 2 ? k2p[2] : k2p[3];
        oid[i] = (int)((w1 >> ((a & 3) * 8)) & 0xFFu) * 128 + (int)((w2 >> ((b & 3) * 8)) & 0xFFu);
        e[i] = __builtin_amdgcn_exp2f((L0[i] - mx) * 1.4426950408889634f); sum += e[i]; }
    const float inv = 1.f / sum;
    if (hi == 0) {
        GAS v4u* ip16 = (GAS v4u*)(IDS16 + (size_t)tok * 128 + head * 16); GAS v4u* gp16 = (GAS v4u*)(GATES16 + (size_t)tok * 128 + head * 16);
#pragma unroll
        for (int i = 0; i < 2; ++i) { v4u iw, gw_;
#pragma unroll
            for (int q = 0; q < 4; ++q) { const int a = 8 * i + 2 * q; iw[q] = (unsigned)oid[a] | ((unsigned)oid[a + 1] << 16);
                typedef _Float16 h2v __attribute__((ext_vector_type(2))); const h2v gh = {(_Float16)(e[a] * inv), (_Float16)(e[a + 1] * inv)}; gw_[q] = __builtin_bit_cast(unsigned, gh); }
            ip16[i] = iw; gp16[i] = gw_; }
        GAS unsigned short* it = (GAS unsigned short*)(IDT + (size_t)tok * 128 + head);
#pragma unroll
        for (int i = 0; i < 16; ++i) it[8 * i] = (unsigned short)oid[i]; }
}
}

#ifndef U_FP4
#define U_FP4 1
#endif
constexpr float U_SCALE = U_FP4 ? 96.f : 64.f, V_SCALE = 2.f;
constexpr size_t SLICE_BYTES = (size_t)NEXP * SLICE_ROWB;
constexpr int SLICE_ROWB_U = U_FP4 ? 128 : SLICE_ROWB;
constexpr size_t SLICE_BYTES_U = (size_t)NEXP * SLICE_ROWB_U;
typedef float v32f_t __attribute__((ext_vector_type(32)));
typedef __bf16 v32bf_t __attribute__((ext_vector_type(32)));
typedef unsigned v16u_t __attribute__((ext_vector_type(16)));
#define FP6_INTERLEAVED 1
template <int CTRL> __device__ __forceinline__ float dpp_add(float x) { return x + __uint_as_float(__builtin_amdgcn_update_dpp(0u, __float_as_uint(x), CTRL, 0xF, 0xF, true)); }
__device__ __forceinline__ size_t slice_off16(int id, int j) { return (size_t)id * SLICE_ROWB + j * 16; }
__device__ __forceinline__ size_t slice_off8(int id, int j) { return (size_t)id * SLICE_ROWB + 128 + j * 8; }
typedef int v8i_t __attribute__((ext_vector_type(8)));
typedef _Float16 h2_t __attribute__((ext_vector_type(2)));
constexpr int NPC = U_FP4 ? 2 : 3;
template <int H0> __device__ __forceinline__ void rows4_issue(v4u (&R)[4 * NPC]  , const unsigned char* Uq  , const int (&idv)[8]  ) {
#pragma unroll
    for (int h = 0; h < 4; ++h) { const GAS v4u* p = (const GAS v4u*)(Uq + (size_t)(unsigned)idv[H0 + h] * SLICE_ROWB_U);
#pragma unroll
        for (int k = 0; k < NPC; ++k) R[NPC * h + k] = p[4 * k]; }
}
__device__ __forceinline__ v8i_t fp6_operand(const v6u_t a) { return (v8i_t){(int)a[0], (int)a[1], (int)a[2], (int)a[3], (int)a[4], (int)a[5], 0, 0}; }
__device__ __forceinline__ unsigned bperm(int addr, unsigned v) { return (unsigned)__builtin_amdgcn_ds_bpermute(addr, (int)v); }
__device__ __forceinline__ void rows4_compute(const v4u (&R)[4 * NPC], const v6u_t (&b)[2], float scale, unsigned short* hp_tok  , int r, int g, int pa  ) {
    const v8i_t B0 = fp6_operand(b[0]), B1 = fp6_operand(b[1]);
    f32x4 C[4];
#pragma unroll
    for (int h = 0; h < 4; ++h) { unsigned d[4 * NPC];
#pragma unroll
        for (int k = 0; k < NPC; ++k) { const v4u w = R[NPC * h + k]; d[4 * k] = bperm(pa, w.x); d[4 * k + 1] = bperm(pa, w.y); d[4 * k + 2] = bperm(pa, w.z); d[4 * k + 3] = bperm(pa, w.w); }
#if U_FP4
        const v8i_t A0 = {(int)d[0], (int)d[1], (int)d[2], (int)d[3], 0, 0, 0, 0}, A1 = {(int)d[4], (int)d[5], (int)d[6], (int)d[7], 0, 0, 0, 0};
        C[h] = __builtin_amdgcn_mfma_scale_f32_16x16x128_f8f6f4(A0, B0, (f32x4){0.f, 0.f, 0.f, 0.f}, 4, 2, 0, 0, 0, 0);
        C[h] = __builtin_amdgcn_mfma_scale_f32_16x16x128_f8f6f4(A1, B1, C[h], 4, 2, 0, 0, 0, 0); }
#else
        const v8i_t A0 = {(int)d[0], (int)d[1], (int)d[2], (int)d[3], (int)d[8 % (4 * NPC)], (int)d[9 % (4 * NPC)], 0, 0}, A1 = {(int)d[4], (int)d[5], (int)d[6], (int)d[7], (int)d[10 % (4 * NPC)], (int)d[11 % (4 * NPC)], 0, 0};
        C[h] = __builtin_amdgcn_mfma_scale_f32_16x16x128_f8f6f4(A0, B0, (f32x4){0.f, 0.f, 0.f, 0.f}, 2, 2, 0, 0, 0, 0);
        C[h] = __builtin_amdgcn_mfma_scale_f32_16x16x128_f8f6f4(A1, B1, C[h], 2, 2, 0, 0, 0, 0); }
#endif
    f32x4 o = C[0]; o = (r == 1) ? C[1] : o; o = (r == 2) ? C[2] : o; o = (r == 3) ? C[3] : o;
    if (r < 4) { const f32x4 v = o * scale; const h2_t lo = {(_Float16)v.x, (_Float16)v.y}, hi = {(_Float16)v.z, (_Float16)v.w};
        *(GAS v2u_t*)(hp_tok + r * 16 + 4 * g) = (v2u_t){__builtin_bit_cast(unsigned, lo), __builtin_bit_cast(unsigned, hi)}; }
}
struct TokM { int idv[8]; v6u_t b[2]; float sc; };
__device__ __forceinline__ void tokm_load(TokM& k, const unsigned char* X6g  , const float* SX1, const unsigned short* IDS16, int t, int lane) {
    const GAS v4u* xb = (const GAS v4u*)(X6g + (size_t)t * SLICE_ROWB); { const v4u a = xb[0], b = xb[4], e = xb[8]; k.b[0] = (v6u_t){a.x, a.y, a.z, a.w, e.x, e.y}; k.b[1] = (v6u_t){b.x, b.y, b.z, b.w, e.z, e.w}; }
    const v4u iw = *(const GAS v4u*)(IDS16   + (size_t)t * 128 + (lane >> 2) * 8);
#pragma unroll
    for (int c = 0; c < 8; ++c) k.idv[c] = (int)((c & 1) ? iw[c >> 1] >> 16 : iw[c >> 1] & 0xFFFFu);
    k.sc = SX1[t] * (127.f / 7.5f);
}
__device__ __forceinline__ void peer_h_phase(const unsigned char* X6, const float* SX1, const unsigned char* U6s, const unsigned short* IDS, unsigned short* HP  , int s, int wv, int nwv, int lane) {
    const int r = lane & 15, g = lane >> 4, pa = 4 * (4 * r + g);
    const unsigned char* Uq = U6s + (size_t)s * SLICE_BYTES_U + (lane & 3) * 16; const unsigned char* X6g = X6 + (size_t)s * T * SLICE_ROWB + g * 16;
    int t = wv; if (t >= T) return;
    TokM cur; tokm_load(cur, X6g, SX1, IDS, t, lane);
    v4u ra[4 * NPC], rb[4 * NPC];
    rows4_issue<0>(ra, Uq, cur.idv);
#pragma unroll 1
    for (;;) {
        const int tn = t + nwv; const bool has = tn < T;
        TokM nxt = cur; if (has) tokm_load(nxt, X6g, SX1, IDS, tn, lane);
        rows4_issue<4>(rb, Uq, cur.idv);
        __builtin_amdgcn_sched_barrier(0);
        unsigned short* hp = HP + ((size_t)s * T + t) * 128;
        rows4_compute(ra, cur.b, cur.sc, hp, r, g, pa);
        __builtin_amdgcn_sched_barrier(0);
        if (has) rows4_issue<0>(ra, Uq, nxt.idv);
        __builtin_amdgcn_sched_barrier(0);
        rows4_compute(rb, cur.b, cur.sc, hp + 64, r, g, pa);
        if (!has) break;
        cur = nxt; t = tn;
    }
}
__device__ __forceinline__ void peer_a_phase(const unsigned* HP  , const unsigned* GATES16  , unsigned* AW16, size_t gtid, size_t nthr) {
    constexpr int UN = 16;
    for (size_t i0 = gtid; i0 < (size_t)T * 64; i0 += UN * nthr) {
        unsigned w[UN][8]; unsigned gw2[UN];
#pragma unroll
        for (int u = 0; u < UN; ++u) { const size_t i = (i0 + u * nthr < (size_t)T * 64) ? i0 + u * nthr : i0;
#pragma unroll
            for (int s = 0; s < 8; ++s) w[u][s] = *(const GAS unsigned*)(HP + (size_t)s * T * 64 + i);
            gw2[u] = *(const GAS unsigned*)(GATES16 + i); }
#pragma unroll
        for (int u = 0; u < UN; ++u) { const size_t i = i0 + u * nthr; if (i >= (size_t)T * 64) break;
            float h0 = 0.f, h1 = 0.f;
#pragma unroll
            for (int s = 0; s < 8; ++s) { const h2_t hw = __builtin_bit_cast(h2_t, w[u][s]); h0 += (float)hw.x; h1 += (float)hw.y; }
            const pg8::f32x2 ge = pg8::gelu_pk((pg8::f32x2){h0 * (1.f / U_SCALE), h1 * (1.f / U_SCALE)});
            const h2_t gt = __builtin_bit_cast(h2_t, gw2[u]); const h2_t o = {(_Float16)(ge.x * (float)gt.x * (1.f / V_SCALE)), (_Float16)(ge.y * (float)gt.y * (1.f / V_SCALE))};
            *(GAS unsigned*)(AW16 + i) = __builtin_bit_cast(unsigned, o); }
    }
}
constexpr int GF = 4;
typedef _Float16 v32h_t __attribute__((ext_vector_type(32)));
__device__ __forceinline__ v6u_t ld_slice_row(const unsigned char* slice, int id, int j) { const v4u a = *(const GAS v4u*)(slice + slice_off16(id, j)); const v2u_t b = *(const GAS v2u_t*)(slice + slice_off8(id, j));
    return (v6u_t){a.x, a.y, a.z, a.w, b.x, b.y}; }
template <int G0> __device__ __forceinline__ void rows_issue4(v6u_t (&r)[GF], const unsigned char* slice, const unsigned (&idp)[8], int j) {
#pragma unroll
    for (int q = 0; q < GF; ++q) { const int g = G0 + q; r[q] = ld_slice_row(slice, (int)((idp[g >> 1] >> (16 * (g & 1))) & 0xFFFFu), j); }
}
template <int G0> __device__ __forceinline__ void f_compute(const v6u_t (&r)[GF], const unsigned (&avp)[8], v32h_t& acc) {
#pragma unroll
    for (int q = 0; q < GF; ++q) { const int g = G0 + q; const v32h_t vf = __builtin_amdgcn_cvt_scalef32_pk32_f16_fp6(r[q], 1.0f); const unsigned aw = avp[g >> 1]; const _Float16 a = __builtin_bit_cast(_Float16, (unsigned short)((g & 1) ? (aw >> 16) : (aw & 0xFFFFu)));
        acc = __builtin_elementwise_fma(vf, (v32h_t)a, acc);
        __builtin_amdgcn_sched_barrier(0); }
}
__device__ __forceinline__ void ld8u(unsigned (&d)[8], const void* p) { const GAS v4u* r = (const GAS v4u*)p; const v4u a = r[0], b = r[1]; d[0] = a.x; d[1] = a.y; d[2] = a.z; d[3] = a.w; d[4] = b.x; d[5] = b.y; d[6] = b.z; d[7] = b.w; }
__device__ __forceinline__ void peer_f_phase(const unsigned char* V6s, const unsigned short* IDS16, const unsigned short* AW16, unsigned char* F8  , int s, int wv, int nwv, int lane) {
    const int e = lane >> 3, j = lane & 7; const unsigned char* Vs = V6s + (size_t)s * SLICE_BYTES;
    constexpr int n_oct = T >> 3; int oct = wv, c = 0; if (oct >= n_oct) return;
#define STEP_NEXT(oa, ca, ob, cb) do { ob = oa; cb = ca + 1; if (cb == 8) { cb = 0; ob = oa + nwv; } if (ob >= n_oct) { ob = oa; cb = ca; } } while (0)
#define STEP_OFS(o, cc) ((size_t)((o) * 8 + e) * 128 + (cc) * 16)
    int o1, c1; STEP_NEXT(oct, c, o1, c1);
    unsigned idn[8], idnn[8], avc[8], avn[8];
    { unsigned id0[8]; ld8u(id0, IDS16 + STEP_OFS(oct, c)); ld8u(avc, AW16 + STEP_OFS(oct, c)); ld8u(idn, IDS16 + STEP_OFS(o1, c1));
      v6u_t b0[GF], b1[GF], b2[GF], b3[GF];
      rows_issue4<0>(b0, Vs, id0, j); rows_issue4<4>(b1, Vs, id0, j); rows_issue4<8>(b2, Vs, id0, j); rows_issue4<12>(b3, Vs, id0, j);
      v32h_t acc = (v32h_t)(_Float16)0;
#pragma unroll 1
      for (;;) {
        const bool last = (o1 == oct && c1 == c);
        int o2, c2; STEP_NEXT(o1, c1, o2, c2);
        ld8u(idnn, IDS16 + STEP_OFS(o2, c2)); ld8u(avn, AW16 + STEP_OFS(o1, c1));
        const size_t zoff = (size_t)(oct * 8 + e) * DM + s * 256 + j * 32;
        __builtin_amdgcn_sched_barrier(0);
        f_compute<0>(b0, avc, acc);
        __builtin_amdgcn_sched_barrier(0);
        rows_issue4<0>(b0, Vs, idn, j);
        __builtin_amdgcn_sched_barrier(0);
        f_compute<4>(b1, avc, acc);
        __builtin_amdgcn_sched_barrier(0);
        rows_issue4<4>(b1, Vs, idn, j);
        __builtin_amdgcn_sched_barrier(0);
        f_compute<8>(b2, avc, acc);
        __builtin_amdgcn_sched_barrier(0);
        rows_issue4<8>(b2, Vs, idn, j);
        __builtin_amdgcn_sched_barrier(0);
        f_compute<12>(b3, avc, acc);
        __builtin_amdgcn_sched_barrier(0);
        rows_issue4<12>(b3, Vs, idn, j);
        __builtin_amdgcn_sched_barrier(0);
        if (c == 7) {
            GAS v4u* fo = (GAS v4u*)(F8 + zoff);
#pragma unroll
            for (int q = 0; q < 2; ++q) { v4u o;
#pragma unroll
                for (int i = 0; i < 4; ++i) { const int b = 16 * q + 4 * i; o[i] = pack_fp8x4((float)acc[b] * F8_F, (float)acc[b + 1] * F8_F, (float)acc[b + 2] * F8_F, (float)acc[b + 3] * F8_F); }
                fo[q] = o; }
            acc = (v32h_t)(_Float16)0;
        }
        if (last) break;
#pragma unroll
        for (int i = 0; i < 8; ++i) { idn[i] = idnn[i]; avc[i] = avn[i]; }
        oct = o1; c = c1; o1 = o2; c1 = c2;
      }
    }
#undef STEP_NEXT
#undef STEP_OFS
}
__device__ __forceinline__ void ln_rows_bf16_to_f32(const unsigned char* X8  , const float* SX, const unsigned char* GP8, const unsigned char* F8, float* out, const float* g, const float* bta, int gw, int ngw, int lane) {
    int t = gw; if (t >= T) return;
    f32x4 gg[8], bb[8]; v2u_t xw[4], gq[4], fw[4]; float sx;
#pragma unroll
    for (int q = 0; q < 4; ++q) { const GAS f32x4* gp = (const GAS f32x4*)(g + q * 512 + lane * 8); const GAS f32x4* bp = (const GAS f32x4*)(bta + q * 512 + lane * 8);
        gg[2 * q] = gp[0]; gg[2 * q + 1] = gp[1]; bb[2 * q] = bp[0]; bb[2 * q + 1] = bp[1];
        const size_t o = (size_t)t * DM + q * 512 + lane * 8; xw[q] = *(const GAS v2u_t*)(X8 + o); gq[q] = *(const GAS v2u_t*)(GP8 + o); fw[q] = *(const GAS v2u_t*)(F8 + o); }
    sx = SX[t];
#pragma unroll 1
    for (;;) {
        const int tn = t + ngw; const bool has = tn < T; const int tl = has ? tn : t; v2u_t nx[4], ng[4], nf[4];
#pragma unroll
        for (int q = 0; q < 4; ++q) { const size_t o = (size_t)tl * DM + q * 512 + lane * 8; nx[q] = *(const GAS v2u_t*)(X8 + o); ng[q] = *(const GAS v2u_t*)(GP8 + o); nf[q] = *(const GAS v2u_t*)(F8 + o); }
        const float nsx = SX[tl];
        f32x4 v[8]; float s = 0.f; const float sa = sx * ALPHA;
#pragma unroll
        for (int q = 0; q < 4; ++q) { const int xlo = (int)xw[q].x, xhi = (int)xw[q].y;
            const f32x4 g0 = unpack_fp8x4(gq[q].x), g1 = unpack_fp8x4(gq[q].y), f0 = unpack_fp8x4(fw[q].x), f1 = unpack_fp8x4(fw[q].y);
#pragma unroll
            for (int i = 0; i < 4; ++i) { v[2 * q][i] = (float)((xlo << (24 - 8 * i)) >> 24) * sa + g0[i] * (1.f / F8_PW) + f0[i] * (1.f / F8_F); v[2 * q + 1][i] = (float)((xhi << (24 - 8 * i)) >> 24) * sa + g1[i] * (1.f / F8_PW) + f1[i] * (1.f / F8_F); } }
#pragma unroll
        for (int q = 0; q < 8; ++q) s += (v[q].x + v[q].y) + (v[q].z + v[q].w);
        const float mean = wave_sum(s) * (1.f / DM); float s2 = 0.f;
#pragma unroll
        for (int q = 0; q < 8; ++q) { v[q] = v[q] - mean; s2 += (v[q].x * v[q].x + v[q].y * v[q].y) + (v[q].z * v[q].z + v[q].w * v[q].w); }
        const float rstd = 1.f / sqrtf(wave_sum(s2) * (1.f / DM) + LN_EPS);
#pragma unroll
        for (int q = 0; q < 4; ++q) { GAS f32x4* op = (GAS f32x4*)(out + (size_t)t * DM + q * 512 + lane * 8);
            op[0] = v[2 * q] * rstd * gg[2 * q] + bb[2 * q]; op[1] = v[2 * q + 1] * rstd * gg[2 * q + 1] + bb[2 * q + 1]; }
        if (!has) break;
#pragma unroll
        for (int q = 0; q < 4; ++q) { xw[q] = nx[q]; gq[q] = ng[q]; fw[q] = nf[q]; }
        sx = nsx; t = tn;
    }
}
template <bool MFMA_IMG> __device__ __forceinline__ void cvt_stream_fp6(const float* src, unsigned char* dst, float scale, size_t i0, size_t i1  , size_t gtid, size_t nthr) {
    for (size_t i = i0 + gtid; i < i1; i += nthr) { const GAS f32x4* sp = (const GAS f32x4*)src + 8 * i; v16f_t lo, hi;
#pragma unroll
        for (int q = 0; q < 8; ++q) { const f32x4 a = sp[q] * scale;
#pragma unroll
            for (int c = 0; c < 4; ++c) { const int el = 4 * q + c;
                if (FP6_INTERLEAVED) { if (el & 1) hi[el >> 1] = a[c]; else lo[el >> 1] = a[c]; } else { if (el < 16) lo[el] = a[c]; else hi[el - 16] = a[c]; } } }
        const v6u_t p = __builtin_amdgcn_cvt_scalef32_2xpk16_fp6_f32(lo, hi, 1.0f);
        const int row = (int)(i >> 6), blk = (int)(i & 63), sl = blk >> 3, jb = blk & 7; unsigned char* r = dst + (size_t)sl * SLICE_BYTES;
        if (MFMA_IMG) { unsigned char* rr = r + (size_t)row * SLICE_ROWB + (jb & 3) * 16; const int cb = jb >> 2;
            *(GAS v4u*)(rr + cb * 64) = (v4u){p[0], p[1], p[2], p[3]}; *(GAS v2u_t*)(rr + 128 + cb * 8) = (v2u_t){p[4], p[5]}; }
        else { *(GAS v4u*)(r + slice_off16(row, jb)) = (v4u){p[0], p[1], p[2], p[3]}; *(GAS v2u_t*)(r + slice_off8(row, jb)) = (v2u_t){p[4], p[5]}; } }
}
__device__ __forceinline__ void cvt_stream_fp4(const float* src, unsigned char* dst, float scale, size_t i0, size_t i1, size_t gtid, size_t nthr) {
    for (size_t i = i0 + gtid; i < i1; i += nthr) { const GAS f32x4* sp = (const GAS f32x4*)src + 8 * i; unsigned w[4] = {0u, 0u, 0u, 0u};
#pragma unroll
        for (int q = 0; q < 8; ++q) { const f32x4 a = sp[q] * scale;
            if (q & 1) { w[q >> 1] = __builtin_amdgcn_cvt_scalef32_pk_fp4_f32(w[q >> 1], a.x, a.y, 1.0f, 2); w[q >> 1] = __builtin_amdgcn_cvt_scalef32_pk_fp4_f32(w[q >> 1], a.z, a.w, 1.0f, 3); }
            else       { w[q >> 1] = __builtin_amdgcn_cvt_scalef32_pk_fp4_f32(w[q >> 1], a.x, a.y, 1.0f, 0); w[q >> 1] = __builtin_amdgcn_cvt_scalef32_pk_fp4_f32(w[q >> 1], a.z, a.w, 1.0f, 1); } }
        const int row = (int)(i >> 6), blk = (int)(i & 63), sl = blk >> 3, jb = blk & 7;
        *(GAS v4u*)(dst + (size_t)sl * SLICE_BYTES_U + (size_t)row * SLICE_ROWB_U + jb * 16) = (v4u){w[0], w[1], w[2], w[3]}; }
}

__device__ __forceinline__ void fold_pool_block(const float* WBP, const float* WG, const float* SCL, float* WF, gu32* amax_word, int blk, int lane) {
    const int g = blk >> 9, i0 = ((blk >> 6) & 7) * 32, n0 = (blk & 63) * 32, r = lane & 31, h = lane >> 5;
    const GAS float* ap = (const GAS float*)WBP + (size_t)(g * 256 + 8 * h) * DM + n0 + r;
    const GAS float* bp = (const GAS float*)WG + (size_t)g * 65536 + (size_t)(i0 + r) * 256 + 8 * h;
    const GAS float* sp = (const GAS float*)SCL + g * 256 + 8 * h;
    f32x16 acc = {};
#pragma unroll 4
    for (int ks = 0; ks < 16; ++ks) {
        f32x4 a0, a1;
#pragma unroll
        for (int jj = 0; jj < 4; ++jj) { a0[jj] = ap[(size_t)(16 * ks + jj) * DM]; a1[jj] = ap[(size_t)(16 * ks + 4 + jj) * DM]; }
        const f32x4 b0 = *(const GAS f32x4*)(bp + 16 * ks) * *(const GAS f32x4*)(sp + 16 * ks), b1 = *(const GAS f32x4*)(bp + 16 * ks + 4) * *(const GAS f32x4*)(sp + 16 * ks + 4);
        acc = __builtin_amdgcn_mfma_f32_32x32x16_bf16(__builtin_bit_cast(bf16x8, pg8::pack8(a0, a1)), __builtin_bit_cast(bf16x8, pg8::pack8(b0, b1)), acc, 0, 0, 0);
    }
    float m = 0.f;
#pragma unroll
    for (int q = 0; q < 16; ++q) { const int row = (q & 3) + 8 * (q >> 2) + 4 * h; *((GAS float*)WF + (size_t)(n0 + row) * PW_ + g * 256 + i0 + r) = acc[q]; m = fmaxf(m, fabsf(acc[q])); }
    m = wave_max(m);
    if (lane == 0) __hip_atomic_fetch_max(amax_word, __float_as_uint(m), RLX_AGENT);
}
__device__ __forceinline__ void quant_fold(const float* WF, unsigned char* W8, float inv, size_t gtid, size_t nthr) {
    for (size_t i = gtid; i < (size_t)DM * PW_ / 16; i += nthr) { const GAS f32x4* sp = (const GAS f32x4*)WF + 4 * i; v4u o;
#pragma unroll
        for (int q = 0; q < 4; ++q) { const f32x4 a = sp[q] * inv; o[q] = q8(a.x) | (q8(a.y) << 8) | (q8(a.z) << 16) | (q8(a.w) << 24); }
        ((GAS v4u*)W8)[i] = o; }
}

struct FInProj { bf16 *XP, *Q, *K, *V; unsigned char *G0, *G1; const float* gate_b; int col0;
    struct Pre { f32x4 b0, b1; };
    __device__ __forceinline__ Pre load(int, int col_) const { const int col = col_ + col0, gc = col >= 4096 ? col - 4096 : 0;
        const float* gb = gate_b + gc; Pre p; p.b0 = *(const GAS f32x4*)gb; p.b1 = *(const GAS f32x4*)(gb + 4); return p; }
    __device__ __forceinline__ void operator()(int row, int col_, const f32x4 v0, const f32x4 v1, const Pre& pr) const {
        const int col = col_ + col0, t = col >> 10;
        if (t < 4) { bf16* base = t == 0 ? XP : t == 1 ? Q : t == 2 ? K : V; const float qs = t == 1 ? attn::SC : 1.f;
            *(GAS v4u*)(base + (size_t)row * 1024 + (col & 1023)) = pg8::pack8(v0 * qs, v1 * qs); }
        else { unsigned char* base = t < 6 ? G0 : G1; const int c = col & 2047; const f32x4 b0 = pr.b0, b1 = pr.b1; unsigned lo = 0u, hi = 0u;
#pragma unroll
            for (int i = 0; i < 4; ++i) { lo |= ((unsigned)__builtin_rintf(pg8::sigm(v0[i] + b0[i]) * 255.f)) << (8 * i); hi |= ((unsigned)__builtin_rintf(pg8::sigm(v1[i] + b1[i]) * 255.f)) << (8 * i); }
            *(GAS unsigned long long*)(base + (size_t)row * DM + c) = (unsigned long long)lo | ((unsigned long long)hi << 32); } } };
struct FGate8 { const unsigned char* G; unsigned char* M8;
    typedef unsigned long long Pre;
    __device__ __forceinline__ Pre load(int row, int col) const { return *(const GAS unsigned long long*)(G + (size_t)row * DM + col); }
    __device__ __forceinline__ void operator()(int row, int col, const f32x4 v0, const f32x4 v1, const Pre gw) const {
        const size_t off = (size_t)row * DM + col; const unsigned lo = (unsigned)gw, hi = (unsigned)(gw >> 32);
        f32x4 o0, o1;
#pragma unroll
        for (int i = 0; i < 4; ++i) { o0[i] = (float)((lo >> (8 * i)) & 255u) * (F8_M / 255.f) * v0[i]; o1[i] = (float)((hi >> (8 * i)) & 255u) * (F8_M / 255.f) * v1[i]; }
        *(GAS v2u_t*)(M8 + off) = (v2u_t){pack_fp8x4(o0.x, o0.y, o0.z, o0.w), pack_fp8x4(o1.x, o1.y, o1.z, o1.w)}; } };
struct FResid { const unsigned char* X8; const float* SX; bf16* Z;
    struct Pre { unsigned long long xw; float sx; };
    __device__ __forceinline__ Pre load(int row, int col) const { Pre p; p.xw = *(const GAS unsigned long long*)(X8 + (size_t)row * DM + col); p.sx = SX[row]; return p; }
    __device__ __forceinline__ void operator()(int row, int col, const f32x4 v0, const f32x4 v1, const Pre& pr) const {
        const size_t off = (size_t)row * DM + col; const unsigned long long xw = pr.xw; const int xlo = (int)(unsigned)xw, xhi = (int)(unsigned)(xw >> 32); const float sa = pr.sx * ALPHA;
        f32x4 o0, o1;
#pragma unroll
        for (int i = 0; i < 4; ++i) { o0[i] = (float)((xlo << (24 - 8 * i)) >> 24) * sa + v0[i]; o1[i] = (float)((xhi << (24 - 8 * i)) >> 24) * sa + v1[i]; }
        *(GAS v4u*)(Z + off) = pg8::pack8(o0, o1); } };
struct NoPre {};
struct FStore { bf16* O; int ldc; typedef NoPre Pre;
    __device__ __forceinline__ Pre load(int, int) const { return Pre{}; }
    __device__ __forceinline__ void operator()(int row, int col, const f32x4 v0, const f32x4 v1, const Pre&) const { *(GAS v4u*)(O + (size_t)row * ldc + col) = pg8::pack8(v0, v1); } };
struct FStore8 { unsigned char* O; int ldc; float scale;
    typedef NoPre Pre;
    __device__ __forceinline__ Pre load(int, int) const { return Pre{}; }
    __device__ __forceinline__ void operator()(int row, int col, const f32x4 v0, const f32x4 v1, const Pre&) const { const f32x4 a = v0 * scale, b = v1 * scale;
        *(GAS v2u_t*)(O + (size_t)row * ldc + col) = (v2u_t){pack_fp8x4(a.x, a.y, a.z, a.w), pack_fp8x4(b.x, b.y, b.z, b.w)}; } };
struct FGateE { const unsigned char* PW8; unsigned char* GP8;
    typedef v2u_t Pre;
    __device__ __forceinline__ Pre load(int row, int col) const { return *(const GAS v2u_t*)(PW8 + (size_t)row * DM + col); }
    __device__ __forceinline__ void operator()(int row, int col, const f32x4 v0, const f32x4 v1, const Pre pw) const {
        const size_t off = (size_t)row * DM + col; const f32x4 p0 = unpack_fp8x4(pw.x), p1 = unpack_fp8x4(pw.y);
        f32x4 o0, o1;
#pragma unroll
        for (int i = 0; i < 4; ++i) { o0[i] = pg8::sigm(v0[i]) * p0[i]; o1[i] = pg8::sigm(v1[i]) * p1[i]; }
        *(GAS v2u_t*)(GP8 + off) = (v2u_t){pack_fp8x4(o0.x, o0.y, o0.z, o0.w), pack_fp8x4(o1.x, o1.y, o1.z, o1.w)}; } };
#ifndef REP_PH
#define REP_PH -1
#endif
#ifndef REP_N
#define REP_N 2
#endif
#define REPS(k) _Pragma("unroll") for (int rep_ = 0; rep_ < ((k) == REP_PH ? REP_N : 1); ++rep_)
__global__ void __launch_bounds__(NWAVES * 64, 2) mk_fwd(Args args) {
    extern __shared__ __attribute__((aligned(16))) unsigned char lds[];
    Frame F;
    F.lds = (LAS unsigned char*)lds;
    F.MISC = (volatile LAS unsigned*)(F.lds + MISC_OFF);
    F.tid = threadIdx.x; F.lane = F.tid & 63; F.wave = __builtin_amdgcn_readfirstlane(F.tid >> 6);
#define TID_NOW() (F.wave * 64 + lane_id_now())
    F.G = gridDim.x; { const int bx = blockIdx.x; F.vcu = (F.G % 8 == 0) ? (bx % 8) * (F.G / 8) + bx / 8 : bx; }
    unsigned char* ws = args.ws;
    F.ctl = (gu32*)(ws + WS_CTL);
    for (int u = F.tid; u < (LDS_BYTES - LDSCTL_OFF) / 4; u += NWAVES * 64) ((LAS unsigned*)(F.lds + LDSCTL_OFF))[u] = 0u;
    __syncthreads();
    XcdBarrier bar; bar.bar = (unsigned*)(F.ctl + CW_BAR); bar.x = 0; bar.st = nullptr;
    if (N_LAUNCHES == 1) bar = xcd_barrier_post((unsigned*)(F.ctl + CW_BAR), F.MISC + 8);
#define GRID_BAR() do { if (N_LAUNCHES == 1) xcd_barrier(bar, TID_NOW() == 0); } while (0)
#define GRID_ARRIVE() do { if (N_LAUNCHES == 1) xcd_barrier_arrive(bar, TID_NOW() == 0); } while (0)
#define GRID_WAIT() do { if (N_LAUNCHES == 1) xcd_barrier_wait(bar, TID_NOW() == 0); } while (0)
    const int lo = args.ph_lo, hi = args.ph_hi;
#ifdef PH_ONLY
#define IN(k) ((k) == PH_ONLY)
#else
#define IN(k) (lo <= (k) && (k) < hi)
#endif
#define BOTH(k) (IN(k) && IN((k) + 1))
    const int NGW = F.G * NWAVES; const size_t nthr = (size_t)F.G * (NWAVES * 64);
#define PHASE_IDS() int tid_ = TID_NOW(); asm volatile("" : "+v"(tid_)); const int lane_ = tid_ & 63; const int wave_ = __builtin_amdgcn_readfirstlane(tid_ >> 6); \
    const int gw = F.vcu * NWAVES + wave_; const size_t gtid = (size_t)F.vcu * (NWAVES * 64) + tid_; (void)lane_; (void)gw; (void)gtid
#define KA_PTR() const __attribute__((address_space(4))) char* ka_ = (const __attribute__((address_space(4))) char*)__builtin_amdgcn_kernarg_segment_ptr(); asm volatile("" : "+s"(ka_))
#define KIN(i) (*(const float* const __attribute__((address_space(4)))*)(ka_ + 8 * (i)))
#define KOUT() (*(float* const __attribute__((address_space(4)))*)(ka_ + 8 * 28))
    bf16* WBP_T = (bf16*)(ws + WS_WBP); bf16* WBA_T = (bf16*)(ws + WS_WBA); bf16* WOUT_T = (bf16*)(ws + WS_WOUT); bf16* WQG_T = (bf16*)(ws + WS_WQG);
    bf16* PLEW_T = (bf16*)(ws + WS_PLEW); bf16* POOLW_T = (bf16*)(ws + WS_POOLW); unsigned char* UB = ws + WS_U; unsigned char* VB = ws + WS_V;
    bf16* XN = (bf16*)(ws + WS_XN); bf16* PB = (bf16*)(ws + WS_PB); bf16* XP = (bf16*)(ws + WS_XP); bf16* QB = (bf16*)(ws + WS_Q); bf16* MIX = (bf16*)(ws + WS_MIX); bf16* YP = (bf16*)(ws + WS_YP);
    bf16* KB = (bf16*)(ws + WS_K); bf16* VVB = (bf16*)(ws + WS_VV); bf16* G0 = (bf16*)(ws + WS_G0); bf16* G1 = (bf16*)(ws + WS_G1);
    bf16* YA = (bf16*)(ws + WS_YA); bf16* MERGED = (bf16*)(ws + WS_MERGED); bf16* MERGED2 = (bf16*)(ws + WS_MERGED2); bf16* Z1 = (bf16*)(ws + WS_Z1); bf16* X1 = (bf16*)(ws + WS_X1); bf16* PWB = (bf16*)(ws + WS_PWB);
    bf16* QP = (bf16*)(ws + WS_QP); bf16* ZE = (bf16*)(ws + WS_ZE); int* IDS = (int*)(ws + WS_IDS); float* GATES = (float*)(ws + WS_GATES);

#define INV_SCALE(cw) (127.f / fmaxf(__uint_as_float(__hip_atomic_load(F.ctl + (cw), RLX_AGENT)), 1e-20f))
#define XPOSE_I8(idx, K_, N_, dst, cw) do { PHASE_IDS(); KA_PTR(); const float inv_ = INV_SCALE(cw); LAS float* scr_ = (LAS float*)(F.lds + RING_OFF + wave_ * 16384); \
        for (int it_ = gw; it_ < ((K_) / 64) * ((N_) / 32); it_ += NGW) p0_transpose_item_i8(KIN(idx), K_, N_, dst, scr_, it_, lane_, inv_); } while (0)
#define TABLE_PART(IMG, idx, dst, scale, part, nparts) do { PHASE_IDS(); KA_PTR(); constexpr size_t nb_ = (size_t)NEXP * DM / 32; \
        if (IMG && U_FP4) cvt_stream_fp4(KIN(idx), dst, scale, nb_ * (part) / (nparts), nb_ * ((part) + 1) / (nparts), gtid, nthr); \
        else cvt_stream_fp6<IMG>(KIN(idx), dst, scale, nb_ * (part) / (nparts), nb_ * ((part) + 1) / (nparts), gtid, nthr); } while (0)
    if (IN(0)) {
        { PHASE_IDS(); KA_PTR();
          absmax_stream(KIN(4), (size_t)DM * IN_COLS / 4, F.ctl + CW_WMAX_IN, gtid, nthr, lane_); absmax_stream(KIN(24), (size_t)DM * DM / 4, F.ctl + CW_WMAX_G, gtid, nthr, lane_);
          absmax_stream(KIN(13), (size_t)PW_ * DM / 4, F.ctl + CW_WMAX_BA, gtid, nthr, lane_); absmax_stream(KIN(15), (size_t)DM * DM / 4, F.ctl + CW_WMAX_O, gtid, nthr, lane_);
          absmax_stream(KIN(18), (size_t)DM * DM / 4, F.ctl + CW_WMAX_Q, gtid, nthr, lane_);
          }
        GRID_ARRIVE();
        { PHASE_IDS(); KA_PTR();
          ln0_rows(lane_, KIN(0), KIN(2), KIN(3), ws + WS_XN8, (float*)(ws + WS_SXN), gw, NGW); }
        GRID_WAIT();
        constexpr int I_IN = (DM / 64) * (IN_COLS / 32), I_BR = (PW_ / 64) * (DM / 32), I_SQ = (DM / 64) * (DM / 32), I_PLE = (PLE / 64) * (DM / 32), I_PG = (256 / 64) * (256 / 32);
        { PHASE_IDS(); KA_PTR();
          const float inv_win = 127.f / fmaxf(__uint_as_float(__hip_atomic_load(F.ctl + CW_WMAX_IN, RLX_AGENT)), 1e-20f);
          LAS float* scr = (LAS float*)(F.lds + RING_OFF + wave_ * 16384);
          for (int it = gw; it < I_IN; it += NGW) p0_transpose_item_i8(KIN(4), DM, IN_COLS, ws + WS_WIN8, scr, it, lane_, inv_win); }
        GRID_ARRIVE();
        XPOSE_I8(13, PW_, DM, (unsigned char*)WBA_T, CW_WMAX_BA);
        { PHASE_IDS(); KA_PTR(); LAS float* scr = (LAS float*)(F.lds + RING_OFF + wave_ * 16384);
          for (int it = gw; it < I_PLE; it += NGW) p0_transpose_item(KIN(23), PLE, DM, PLEW_T, 0, scr, it, lane_);
          for (int blk = gw; blk < 4 * 8 * 64; blk += NGW) fold_pool_block(KIN(12), KIN(5), KIN(6), (float*)(ws + WS_WFOLD), F.ctl + CW_WMAX_F, blk, lane_);
          cvt_stream(KIN(1), PB, (size_t)T * PLE / 8, gtid, nthr); }
        if (BOTH(0)) GRID_WAIT();
    }
    if (IN(1)) {
#define P1_HALF(part) do { pg8::Gemm g{(const bf16*)(ws + WS_XN8), (const bf16*)(ws + WS_WIN8 + (size_t)(part) * (IN_COLS / 2) * DM), DM / 2, DM / 2, DM / 2, 0u, 256u * (DM / 2)}; pg8::StaticOrder S; S.init(T, IN_COLS / 2, F.G, (int)blockIdx.x); \
            const float s_win = __uint_as_float(__hip_atomic_load(F.ctl + CW_WMAX_IN, RLX_AGENT)) * (1.f / 127.f); \
            KA_PTR(); pg8::Row8<FInProj, true> E{{XP, QB, KB, VVB, (unsigned char*)G0, (unsigned char*)G1, KIN(14), (part) * (IN_COLS / 2)}, (const float*)(ws + WS_SXN), s_win}; \
            pg8::gemm_phase<pg8::Row8<FInProj, true>, pg8::StaticOrder, true, true>(F.lds + RING_OFF, g, S, E, TID_NOW()); } while (0)
        P1_HALF(0);
        GRID_ARRIVE();
        P1_HALF(1);
        if (BOTH(1)) GRID_WAIT();
    }
    if (IN(2)) { REPS(2) { PHASE_IDS(); pool_mix_quant_phase(XP, ws + WS_YP8, (float*)(ws + WS_SYP), (LAS float*)(F.lds + RING_OFF), F.vcu, F.G, tid_); } }
    if (IN(3)) {
        GRID_ARRIVE();
        { PHASE_IDS(); quant_fold((const float*)(ws + WS_WFOLD), (unsigned char*)WBP_T, INV_SCALE(CW_WMAX_F), gtid, nthr); }
        REPS(3) { int tl = TID_NOW(); asm volatile("" : "+v"(tl)); const int ll = tl & 63; KA_PTR();
          float d1 = KIN(7)[ll] * KIN(8)[ll], d2 = KIN(9)[ll] * KIN(10)[ll]; d1 = wave_sum(d1); d2 = wave_sum(d2);
          const float lam = expf(d1) - expf(d2) + 0.2f;
          float gm = fmaxf(fabsf(KIN(11)[ll]), fabsf(KIN(11)[64 + ll])); gm = fmaxf(wave_max(gm), 1e-20f); const float s_ya = gm * (0.8f * 11.313708499f / 127.f);
#define UNIFORM_F(x) __uint_as_float((unsigned)__builtin_amdgcn_readfirstlane((int)__float_as_uint(x)))
          const float lam_u = UNIFORM_F(lam), s_ya_u = UNIFORM_F(s_ya), inv_s_u = UNIFORM_F(1.f / s_ya);
          const attn::Params AP{QB, KB, VVB, ws + WS_YA8, (float*)(ws + WS_SYA), KIN(27), KIN(11), lam_u, inv_s_u, s_ya_u};
          for (int n = F.vcu; n < BATCH * attn::NHEAD * attn::NQB; n += F.G) { const int v = n & 255, i = n >> 8, bh = v >> 3, s = v & 7;
              const int qb = 8 * i + ((i & 1) ? 7 - s : s);
              int tlu = tl; asm volatile("" : "+v"(tlu));
              attn::attn_unit2(AP, bh >> 3, bh & 7, qb, (char*)lds + RING_OFF, tlu); }
          }
        GRID_WAIT();
        GRID_ARRIVE(); XPOSE_I8(15, DM, DM, (unsigned char*)WOUT_T, CW_WMAX_O); TABLE_PART(true, 21, UB, U_SCALE, 0, 2); GRID_WAIT();
    }
    if (IN(4)) {
        REPS(4) {
        pg8::Gemm g{(const bf16*)(ws + WS_YP8), WBP_T, PW_ / 2, PW_ / 2, PW_ / 2, 0u, 256u * (PW_ / 2)}; pg8::StaticOrder S; S.init(T, DM, F.G, (int)blockIdx.x);
        const float s_w = __uint_as_float(__hip_atomic_load(F.ctl + CW_WMAX_F, RLX_AGENT)) * (1.f / 127.f);
        pg8::Row8<FGate8, true> E{{(const unsigned char*)G0, ws + WS_MERGED}, (const float*)(ws + WS_SYP), s_w};
        pg8::gemm_phase<pg8::Row8<FGate8, true>, pg8::StaticOrder, true, true>(F.lds + RING_OFF, g, S, E, TID_NOW());
        }
        if (BOTH(4)) __syncthreads();
    }
    if (IN(5)) {
        REPS(5) {
        pg8::Gemm g{(const bf16*)(ws + WS_YA8), WBA_T, PW_ / 2, PW_ / 2, PW_ / 2, 0u, 256u * (PW_ / 2)}; pg8::StaticOrder S; S.init(T, DM, F.G, (int)blockIdx.x);
        const float s_w = __uint_as_float(__hip_atomic_load(F.ctl + CW_WMAX_BA, RLX_AGENT)) * (1.f / 127.f);
        pg8::Row8<FGate8, true> E{{(const unsigned char*)G1, ws + WS_MERGED + 64 * MiB}, (const float*)(ws + WS_SYA), s_w};
        pg8::gemm_phase<pg8::Row8<FGate8, true>, pg8::StaticOrder, true, true>(F.lds + RING_OFF, g, S, E, TID_NOW());
        }
        GRID_ARRIVE(); XPOSE_I8(18, DM, DM, (unsigned char*)WQG_T, CW_WMAX_Q); TABLE_PART(true, 21, UB, U_SCALE, 1, 2); GRID_WAIT();
    }
    if (IN(6)) {
        REPS(36) { PHASE_IDS(); quant_rows_sum8<2>(ws + WS_MERGED, ws + WS_MERGED + 64 * MiB, ws + WS_M28, (float*)(ws + WS_SM2), gw, NGW, lane_); }
        GRID_ARRIVE(); XPOSE_I8(24, DM, DM, ws + WS_WG8, CW_WMAX_G); GRID_WAIT();
        REPS(6) {
        pg8::Gemm g{(const bf16*)(ws + WS_M28), WOUT_T, DM / 2, DM / 2, DM / 2, 0u, 256u * (DM / 2)}; pg8::StaticOrder S; S.init(T, DM, F.G, (int)blockIdx.x);
        const float s_w = __uint_as_float(__hip_atomic_load(F.ctl + CW_WMAX_O, RLX_AGENT)) * (1.f / 127.f);
        pg8::Row8<FResid, true> E{{ws + WS_XN8, (const float*)(ws + WS_SXN), Z1}, (const float*)(ws + WS_SM2), s_w};
        pg8::gemm_phase<pg8::Row8<FResid, true>, pg8::StaticOrder, true, true>(F.lds + RING_OFF, g, S, E, TID_NOW());
        }
        GRID_ARRIVE(); TABLE_PART(false, 22, VB, V_SCALE, 0, 3); GRID_WAIT();
    }
    if (IN(7)) {
        REPS(7) {
        { PHASE_IDS(); KA_PTR(); ln_rows_bf16(Z1, ws + WS_X18, ws + WS_X6, (float*)(ws + WS_SX1), KIN(16), KIN(17), gw, NGW, lane_); }
        GRID_ARRIVE();
        pg8::Gemm g{PB, PLEW_T, PLE, PLE, PLE, 0u, 256u * PLE}; pg8::StaticOrder S; S.init(T, DM, F.G, (int)blockIdx.x);
        pg8::Row8<FStore8> E{{(unsigned char*)PWB, DM, F8_PW}};
        pg8::gemm_phase<pg8::Row8<FStore8>, pg8::StaticOrder, true, true>(F.lds + RING_OFF, g, S, E, TID_NOW());
        }
        if (BOTH(7)) GRID_WAIT();
    }
    if (IN(8)) {
        REPS(8) {
        { pg8::Gemm g{(const bf16*)(ws + WS_X18), WQG_T, DM / 2, DM / 2, DM / 2, 0u, 256u * (DM / 2)}; pg8::StaticOrder S; S.init(T, DM, F.G, (int)blockIdx.x);
          const float s_wq = __uint_as_float(__hip_atomic_load(F.ctl + CW_WMAX_Q, RLX_AGENT)) * (1.f / 127.f);
          pg8::Row8<FStore, true> E{{QP, DM}, (const float*)(ws + WS_SX1), s_wq};
          pg8::gemm_phase<pg8::Row8<FStore, true>, pg8::StaticOrder, true, true>(F.lds + RING_OFF, g, S, E, TID_NOW()); }
        GRID_ARRIVE();
        { pg8::Gemm g{(const bf16*)(ws + WS_X18), (const bf16*)(ws + WS_WG8), DM / 2, DM / 2, DM / 2, 0u, 256u * (DM / 2)}; pg8::StaticOrder S; S.init(T, DM, F.G, (int)blockIdx.x);
          const float s_wg = __uint_as_float(__hip_atomic_load(F.ctl + CW_WMAX_G, RLX_AGENT)) * (1.f / 127.f);
          pg8::Row8<FGateE, true> E{{(const unsigned char*)PWB, (unsigned char*)ZE}, (const float*)(ws + WS_SX1), s_wg};
          pg8::gemm_phase<pg8::Row8<FGateE, true>, pg8::StaticOrder, true, true>(F.lds + RING_OFF, g, S, E, TID_NOW()); }
        }
        if (BOTH(8)) GRID_WAIT();
    }
    if (IN(9)) {
        REPS(9) {
        PHASE_IDS(); KA_PTR();
        psel::load_keys((char*)lds + RING_OFF, KIN(19), KIN(20), tid_);
        __syncthreads();
        for (int task = gw; task < T / 4; task += NGW) psel::select_task((const char*)lds + RING_OFF, QP, task * 4, lane_, (unsigned short*)(ws + WS_IDS16), (unsigned short*)(ws + WS_GATES), (unsigned short*)(ws + WS_IDT));
        __syncthreads();
        }
        GRID_ARRIVE(); TABLE_PART(false, 22, VB, V_SCALE, 1, 3); GRID_WAIT();
    }
    const int sl_ = (int)blockIdx.x & 7, rk_ = (int)blockIdx.x >> 3, nwv_ = ((F.G - sl_ + 7) >> 3) * NWAVES;
    if (IN(10)) {
        REPS(10) { PHASE_IDS(); peer_h_phase(ws + WS_X6, (const float*)(ws + WS_SX1), UB, (const unsigned short*)(ws + WS_IDT), (unsigned short*)(ws + WS_HP), sl_, rk_ * NWAVES + wave_, nwv_, lane_); }
        GRID_ARRIVE(); TABLE_PART(false, 22, VB, V_SCALE, 2, 3); GRID_WAIT();
    }
    if (IN(11)) { REPS(11) { PHASE_IDS(); peer_a_phase((const unsigned*)(ws + WS_HP), (const unsigned*)(ws + WS_GATES), (unsigned*)(ws + WS_AW16), gtid, nthr); } if (BOTH(11)) GRID_BAR(); }
    if (IN(12)) {
        REPS(12) { PHASE_IDS(); peer_f_phase(VB, (const unsigned short*)(ws + WS_IDS16), (const unsigned short*)(ws + WS_AW16), ws + WS_Z, sl_, rk_ * NWAVES + wave_, nwv_, lane_); }
        if (BOTH(12)) GRID_BAR();
    }
    if (IN(13)) { REPS(13) { PHASE_IDS(); KA_PTR(); ln_rows_bf16_to_f32(ws + WS_X18, (const float*)(ws + WS_SX1), (const unsigned char*)ZE, ws + WS_Z, KOUT(), KIN(25), KIN(26), gw, NGW, lane_); } }
#undef IN
#undef BOTH
#undef GRID_BAR
}

extern "C" void kernel_launch(void* const* d_in, const int* in_sizes, int n_in, void* d_out, int out_size, void* d_ws, size_t ws_size, hipStream_t stream) {
    static int grid = 0;
    if (grid == 0) {
        if (n_in != 28 || in_sizes[0] != T * DM || out_size != T * DM || ws_size < WS_END) {
            fprintf(stderr, "kernel_launch: shape mismatch: n_in %d in0 %d out %d ws %zu (need %zu); nothing launched\n", n_in, n_in > 0 ? in_sizes[0] : -1, out_size, ws_size, (size_t)WS_END); grid = -1; return; }
        int dev = 0, cus = 0, per_cu = 0;
        if (hipGetDevice(&dev) != hipSuccess || hipDeviceGetAttribute(&cus, hipDeviceAttributeMultiprocessorCount, dev) != hipSuccess) { fprintf(stderr, "kernel_launch: device query failed\n"); grid = -1; return; }
        if (hipFuncSetAttribute((const void*)mk_fwd, hipFuncAttributeMaxDynamicSharedMemorySize, LDS_BYTES) != hipSuccess) { fprintf(stderr, "kernel_launch: hipFuncSetAttribute failed\n"); grid = -1; return; }
        if (hipOccupancyMaxActiveBlocksPerMultiprocessor(&per_cu, (const void*)mk_fwd, NWAVES * 64, LDS_BYTES) != hipSuccess || per_cu < 1)
            fprintf(stderr, "kernel_launch: note: occupancy query reports %d workgroups per CU\n", per_cu);
        (void)hipGetLastError();
        grid = cus;
    }
    if (grid < 0) return;
    if (hipMemsetAsync((char*)d_ws + WS_CTL, 0, CTL_ZERO_BYTES, stream) != hipSuccess) { fprintf(stderr, "kernel_launch: memset failed\n"); return; }
    Args a{};
    for (int i = 0; i < 28; ++i) a.in[i] = (const float*)d_in[i];
    a.out = (float*)d_out; a.ws = (unsigned char*)d_ws;
    for (int li = 0; li < N_LAUNCHES; ++li) {
        a.ph_lo = (N_LAUNCHES == 1) ? 0 : li; a.ph_hi = (N_LAUNCHES == 1) ? N_PHASES : li + 1; a.li = li; a.pad = 0;
        hipLaunchKernelGGL(mk_fwd, dim3(grid), dim3(NWAVES * 64), LDS_BYTES, stream, a);
        const hipError_t le = hipPeekAtLastError();
        if (le != hipSuccess) { fprintf(stderr, "kernel_launch: launch %d failed: %s\n", li, hipGetErrorName(le)); break; }
    }
}
```
